# Optimizing an MI355X kernel written in HIP

```python
import jax
import jax.numpy as jnp
from jax import lax
import numpy as np

D_MODEL = 2048
BATCH = 1
SEQ = 16384
DEPTH = 2

RWKV_HEADS = 12
RWKV_HEAD = 64
RWKV_W = RWKV_HEADS * RWKV_HEAD
DECAY_LORA = 64
ICLR_LORA = 64
VRES_LORA = 32
GATE_LORA = 128
GN_EPS = 64e-5
LRU_BLOCKS = 6
LRU_BLOCK = 128
LRU_W = LRU_BLOCKS * LRU_BLOCK
CONV_W = 4
LRU_C = 8.0
MLA_HEADS = 4
QK_NOPE = 128
QK_ROPE = 64
V_HEAD = 128
Q_LORA = 384
KV_LORA = 128
MLA_W = MLA_HEADS * V_HEAD
ROPE_THETA = 10000.0
Q_BLOCK = 128
N_BRANCH = 3
N_EXPERTS = 16
EXPERT_FF = 1024
CAPACITY_FACTOR = 2
NORM_EPS = 1e-6

RWKV_SIZES = (RWKV_W, RWKV_W, RWKV_W, DECAY_LORA, DECAY_LORA, ICLR_LORA, ICLR_LORA, GATE_LORA)
RWKV_COLS = 3 * RWKV_W + 2 * DECAY_LORA + 2 * ICLR_LORA + GATE_LORA
REST_SIZES = (LRU_W, LRU_W, Q_LORA, KV_LORA, QK_ROPE, N_BRANCH * D_MODEL)
IN_COLS = RWKV_COLS + 2 * LRU_W + Q_LORA + KV_LORA + QK_ROPE + N_BRANCH * D_MODEL

kernel_name = "bidir_hybrid_rwkv7_rglru_mla_ecmoe"


def rmsnorm(x, g):
    xf = x.astype(jnp.float32)
    y = xf * lax.rsqrt(jnp.mean(xf * xf, axis=-1, keepdims=True) + NORM_EPS)
    return (y * g.astype(jnp.float32)).astype(x.dtype)


def split_cols(t, sizes):
    return jnp.split(t, np.cumsum(sizes)[:-1].tolist(), axis=-1)


def centred_token_shift(p, mu):
    prev = jnp.pad(p, ((0, 0), (1, 0), (0, 0)))[:, :-1]
    nxt = jnp.pad(p, ((0, 0), (0, 1), (0, 0)))[:, 1:]
    return p + mu[0] * (prev - p) + mu[1] * (nxt - p)


def rwkv7_scan(r, w, k, v, kk, a, reverse):
    B, _, H, N = r.shape

    def step(state, inp):
        r_t, w_t, k_t, v_t, kk_t, a_t = inp
        sa = jnp.einsum('bhij,bhj->bhi', state, -kk_t)
        state = (state * w_t[:, :, None, :]
                 + sa[..., None] * (kk_t * a_t)[:, :, None, :]
                 + v_t[..., None] * k_t[:, :, None, :])
        return state, jnp.einsum('bhij,bhj->bhi', state, r_t)

    xs = tuple(jnp.swapaxes(t, 0, 1) for t in (r, w, k, v, kk, a))
    state0 = jnp.zeros((B, H, N, N), jnp.float32)
    _, ys = lax.scan(step, state0, xs, reverse=reverse)
    return jnp.swapaxes(ys, 0, 1)


def rwkv7_mixer(r, k, v, wd, ad, gd, w0, w2, a0, a2, g2, k_k, k_a, r_k, lnx_w, lnx_b):
    B, S, _ = r.shape
    f32 = jnp.float32

    def heads(t):
        return t.astype(f32).reshape(B, S, RWKV_HEADS, RWKV_HEAD)

    r_h, v_h = heads(r), heads(v)
    kk = heads(k * k_k)
    kk = kk / jnp.maximum(jnp.sqrt(jnp.sum(kk * kk, axis=-1, keepdims=True)), 1e-12)
    ys, ks = [], []
    for d in range(2):
        w_log = -jax.nn.softplus(-(w0[d] + jnp.tanh(wd[d]) @ w2[d]).astype(f32)) - 0.5
        decay = heads(jnp.exp(-jnp.exp(w_log)))
        a = jax.nn.sigmoid((a0[d] + ad[d] @ a2[d]).astype(f32))
        k_d = heads(k.astype(f32) * (1.0 + (a - 1.0) * k_a.astype(f32)))
        ys.append(rwkv7_scan(r_h, decay, k_d, v_h, kk, heads(a), reverse=(d == 1)))
        ks.append(k_d)
    y = ys[0] + ys[1]
    mu = jnp.mean(y, axis=-1, keepdims=True)
    var = jnp.mean(jnp.square(y - mu), axis=-1, keepdims=True)
    y = ((y - mu) * lax.rsqrt(var + GN_EPS)).reshape(B, S, RWKV_W) * lnx_w.astype(f32) + lnx_b.astype(f32)
    bonus = jnp.sum(r_h * (ks[0] + ks[1]) * r_k.astype(f32), axis=-1, keepdims=True) * v_h
    g = (jax.nn.sigmoid(gd) @ g2).astype(f32)
    return ((y + bonus.reshape(B, S, RWKV_W)) * g).astype(r.dtype)


def linear_scan(a, b, reverse):
    def combine(left, right):
        a_l, b_l = left
        a_r, b_r = right
        return a_l * a_r, a_r * b_l + b_r

    _, h = lax.associative_scan(combine, (a, b), reverse=reverse, axis=1)
    return h


def rglru_mixer(xb, gb, conv_w, conv_b, wa, ba, wx, bx, lam):
    B, S, C = xb.shape
    f32 = jnp.float32
    xc = lax.conv_general_dilated(
        xb, conv_w[:, None, :], window_strides=(1,),
        padding=[((CONV_W - 1) // 2, CONV_W // 2)],
        dimension_numbers=('NWC', 'WIO', 'NWC'), feature_group_count=C) + conv_b
    xblk = xc.reshape(B, S, LRU_BLOCKS, LRU_BLOCK)
    xc32 = xc.astype(f32)
    hs = []
    for d in range(2):
        rg = jax.nn.sigmoid((jnp.einsum('bsgi,gij->bsgj', xblk, wa[d]).reshape(B, S, C) + ba[d]).astype(f32))
        ig = jax.nn.sigmoid((jnp.einsum('bsgi,gij->bsgj', xblk, wx[d]).reshape(B, S, C) + bx[d]).astype(f32))
        log_a = -LRU_C * rg * jax.nn.softplus(-lam[d].astype(f32))
        a_t = jnp.exp(log_a)
        b_t = jnp.sqrt(-jnp.expm1(2.0 * log_a)) * (ig * xc32)
        hs.append(linear_scan(a_t, b_t, reverse=(d == 1)))
    return ((hs[0] + hs[1]) * jax.nn.gelu(gb.astype(f32))).astype(xb.dtype)


def rope_tables(positions):
    inv = ROPE_THETA ** (-jnp.arange(0, QK_ROPE, 2, dtype=jnp.float32) / QK_ROPE)
    ang = positions.astype(jnp.float32)[..., None] * inv
    return jnp.cos(ang), jnp.sin(ang)


def apply_rope(t, cos, sin):
    half = t.shape[-1] // 2
    tf = t.astype(jnp.float32)
    t1, t2 = tf[..., :half], tf[..., half:]
    c, s = cos[:, :, None, :], sin[:, :, None, :]
    return jnp.concatenate([t1 * c - t2 * s, t1 * s + t2 * c], axis=-1).astype(t.dtype)


def bidirectional_attention(q, k, v, scale):
    B, S, H, Dq = q.shape
    nb = S // Q_BLOCK
    q_blocks = jnp.moveaxis(q.reshape(B, nb, Q_BLOCK, H, Dq), 1, 0)

    def attend(qb):
        s = jnp.einsum('bqhd,bkhd->bhqk', qb, k, preferred_element_type=jnp.float32) * scale
        p = jax.nn.softmax(s, axis=-1).astype(v.dtype)
        return jnp.einsum('bhqk,bkhd->bqhd', p, v)

    o = lax.map(attend, q_blocks)
    return jnp.moveaxis(o, 0, 1).reshape(B, S, H, v.shape[-1])


def mla_mixer(cq, ckv, kr, q_norm, kv_norm, w_uq, w_uk, w_uv, cos, sin):
    B, S, _ = cq.shape
    q = (rmsnorm(cq, q_norm) @ w_uq).reshape(B, S, MLA_HEADS, QK_NOPE + QK_ROPE)
    c_kv = rmsnorm(ckv, kv_norm)
    k_nope = (c_kv @ w_uk).reshape(B, S, MLA_HEADS, QK_NOPE)
    v = (c_kv @ w_uv).reshape(B, S, MLA_HEADS, V_HEAD)
    q = jnp.concatenate([q[..., :QK_NOPE], apply_rope(q[..., QK_NOPE:], cos, sin)], axis=-1)
    k_pe = apply_rope(kr[:, :, None, :], cos, sin)
    k = jnp.concatenate([k_nope, jnp.broadcast_to(k_pe, (B, S, MLA_HEADS, QK_ROPE))], axis=-1)
    o = bidirectional_attention(q, k, v, (QK_NOPE + QK_ROPE) ** -0.5)
    return o.reshape(B, S, MLA_W)


def expert_choice_moe(x, w_router, w_gate, w_up, w_down):
    B, S, D = x.shape
    cap = CAPACITY_FACTOR * S // N_EXPERTS
    aff = jax.nn.softmax((x @ w_router).astype(jnp.float32), axis=-1)
    gate, idx = lax.top_k(jnp.swapaxes(aff, 1, 2), cap)
    xs = jax.vmap(lambda xb, ib: xb[ib])(x, idx)
    hdn = jax.nn.silu(jnp.einsum('becd,edf->becf', xs, w_gate)) * jnp.einsum('becd,edf->becf', xs, w_up)
    ye = jnp.einsum('becf,efd->becd', hdn, w_down) * gate[..., None].astype(x.dtype)
    flat = (jnp.arange(B, dtype=jnp.int32)[:, None, None] * S + idx).reshape(-1)
    out = jnp.zeros((B * S, D), x.dtype).at[flat].add(ye.reshape(-1, D))
    return out.reshape(B, S, D)


def setup_inputs(seed: int = 0) -> dict:
    key = jax.random.key(seed)
    keys = iter(jax.random.split(key, 64))
    f32 = jnp.float32

    def normal(shape, scale):
        return jax.random.normal(next(keys), shape, f32) * scale

    def uniform(shape, lo, hi):
        return jax.random.uniform(next(keys), shape, f32, lo, hi)

    def gain(shape):
        return 1.0 + normal(shape, 0.02)

    L, D = DEPTH, D_MODEL
    u = uniform((L, 2, LRU_W), 0.9, 0.999)
    a_base = u ** (1.0 / LRU_C)
    return {
        'x': normal((BATCH, SEQ, D), 1.0),
        'positions': jnp.broadcast_to(jnp.arange(SEQ, dtype=jnp.int32), (BATCH, SEQ)),
        'norm_mix': gain((L, D)),
        'w_in': normal((L, D, IN_COLS), D ** -0.5),
        'rwkv_shift_mu': uniform((L, 2, RWKV_COLS), 0.0, 0.5),
        'rwkv_w0': uniform((L, 2, RWKV_W), -5.0, -0.5),
        'rwkv_w2': normal((L, 2, DECAY_LORA, RWKV_W), 0.1 * DECAY_LORA ** -0.5),
        'rwkv_a0': normal((L, 2, RWKV_W), 0.1),
        'rwkv_a2': normal((L, 2, ICLR_LORA, RWKV_W), ICLR_LORA ** -0.5),
        'rwkv_g2': normal((L, GATE_LORA, RWKV_W), GATE_LORA ** -0.5),
        'rwkv_k_k': 0.85 + normal((L, RWKV_W), 0.05),
        'rwkv_k_a': 1.0 + normal((L, RWKV_W), 0.05),
        'rwkv_r_k': normal((L, RWKV_HEADS, RWKV_HEAD), 0.1),
        'rwkv_lnx_w': gain((L, RWKV_W)),
        'rwkv_lnx_b': normal((L, RWKV_W), 0.01),
        'rwkv_vres_down': normal((L - 1, D, VRES_LORA), D ** -0.5),
        'rwkv_vres_up': normal((L - 1, VRES_LORA, RWKV_W), VRES_LORA ** -0.5),
        'rwkv_vres_b': 1.0 + normal((L - 1, RWKV_W), 0.1),
        'lru_conv_w': normal((L, CONV_W, LRU_W), 0.5),
        'lru_conv_b': normal((L, LRU_W), 0.01),
        'lru_wa': normal((L, 2, LRU_BLOCKS, LRU_BLOCK, LRU_BLOCK), LRU_BLOCK ** -0.5),
        'lru_ba': normal((L, 2, LRU_W), 0.01),
        'lru_wx': normal((L, 2, LRU_BLOCKS, LRU_BLOCK, LRU_BLOCK), LRU_BLOCK ** -0.5),
        'lru_bx': normal((L, 2, LRU_W), 0.01),
        'lru_lambda': jnp.log(a_base) - jnp.log1p(-a_base),
        'mla_q_norm': gain((L, Q_LORA)),
        'mla_kv_norm': gain((L, KV_LORA)),
        'mla_w_uq': normal((L, Q_LORA, MLA_HEADS * (QK_NOPE + QK_ROPE)), Q_LORA ** -0.5),
        'mla_w_uk': normal((L, KV_LORA, MLA_HEADS * QK_NOPE), KV_LORA ** -0.5),
        'mla_w_uv': normal((L, KV_LORA, MLA_HEADS * V_HEAD), KV_LORA ** -0.5),
        'wo_rwkv': normal((L, RWKV_W, D), RWKV_W ** -0.5),
        'wo_lru': normal((L, LRU_W, D), LRU_W ** -0.5),
        'wo_mla': normal((L, MLA_W, D), MLA_W ** -0.5),
        'w_out': normal((L, D, D), D ** -0.5),
        'norm_ffn': gain((L, D)),
        'w_router': normal((L, D, N_EXPERTS), D ** -0.5),
        'w_gate': normal((L, N_EXPERTS, D, EXPERT_FF), D ** -0.5),
        'w_up': normal((L, N_EXPERTS, D, EXPERT_FF), D ** -0.5),
        'w_down': normal((L, N_EXPERTS, EXPERT_FF, D), EXPERT_FF ** -0.5),
        'norm_final': gain((D,)),
    }


def reference(x, positions, norm_mix, w_in, rwkv_shift_mu, rwkv_w0, rwkv_w2, rwkv_a0, rwkv_a2,
              rwkv_g2, rwkv_k_k, rwkv_k_a, rwkv_r_k, rwkv_lnx_w, rwkv_lnx_b, rwkv_vres_down,
              rwkv_vres_up, rwkv_vres_b, lru_conv_w, lru_conv_b, lru_wa, lru_ba, lru_wx, lru_bx,
              lru_lambda, mla_q_norm, mla_kv_norm, mla_w_uq, mla_w_uk, mla_w_uv, wo_rwkv, wo_lru,
              wo_mla, w_out, norm_ffn, w_router, w_gate, w_up, w_down, norm_final):
    B, S, D = x.shape
    cos, sin = rope_tables(positions)
    v_first = None
    for l in range(DEPTH):
        xn = rmsnorm(x, norm_mix[l])
        h = xn @ w_in[l]
        h_rwkv = centred_token_shift(h[..., :RWKV_COLS], rwkv_shift_mu[l])
        r, k, v, wd_f, wd_b, ad_f, ad_b, gd = split_cols(h_rwkv, RWKV_SIZES)
        xb, gb, cq, ckv, kr, gates = split_cols(h[..., RWKV_COLS:], REST_SIZES)
        if l == 0:
            v_first = v
        else:
            vg = jax.nn.sigmoid(rwkv_vres_b[l - 1] + (xn @ rwkv_vres_down[l - 1]) @ rwkv_vres_up[l - 1])
            v = v + (v_first - v) * vg
        y_a = rwkv7_mixer(r, k, v, (wd_f, wd_b), (ad_f, ad_b), gd, rwkv_w0[l], rwkv_w2[l],
                          rwkv_a0[l], rwkv_a2[l], rwkv_g2[l], rwkv_k_k[l], rwkv_k_a[l],
                          rwkv_r_k[l], rwkv_lnx_w[l], rwkv_lnx_b[l])
        y_b = rglru_mixer(xb, gb, lru_conv_w[l], lru_conv_b[l], lru_wa[l], lru_ba[l],
                          lru_wx[l], lru_bx[l], lru_lambda[l])
        y_c = mla_mixer(cq, ckv, kr, mla_q_norm[l], mla_kv_norm[l], mla_w_uq[l],
                        mla_w_uk[l], mla_w_uv[l], cos, sin)
        g = jax.nn.sigmoid(gates).reshape(B, S, N_BRANCH, D)
        merged = (g[:, :, 0] * (y_a @ wo_rwkv[l])
                  + g[:, :, 1] * (y_b @ wo_lru[l])
                  + g[:, :, 2] * (y_c @ wo_mla[l]))
        x = x + merged @ w_out[l]
        x = x + expert_choice_moe(rmsnorm(x, norm_ffn[l]), w_router[l], w_gate[l], w_up[l], w_down[l])
    return rmsnorm(x, norm_final)
```

```cpp
#include <hip/hip_runtime.h>
#include <cstdio>
#include <cstdint>

#define LAS __attribute__((address_space(3)))
typedef unsigned short bf16_t;
typedef short bf16x8 __attribute__((ext_vector_type(8)));
typedef short s16x4 __attribute__((ext_vector_type(4)));
typedef float f32x4 __attribute__((ext_vector_type(4)));
typedef float f32x2 __attribute__((ext_vector_type(2)));
typedef float f32x16 __attribute__((ext_vector_type(16)));
typedef unsigned u32x4 __attribute__((ext_vector_type(4)));
typedef unsigned u32x2 __attribute__((ext_vector_type(2)));

constexpr int T = 16384, DM = 2048, DEPTH = 2;
constexpr int RW = 768, NH = 12, HD = 64;
constexpr int LW = 768;
constexpr int RWKV_COLS = 2688, IN_COLS = 10944;
constexpr int H1W = 4864, HGW = 6144, NWIN = H1W + HGW;
constexpr int NE = 16, FF = 1024, CAP = 2048;
constexpr int NCH = 256, CL = 64;
constexpr int NTHR = 512, NWAVE = 8;
constexpr int QW = 768, KVW = 192, OW = 512;
constexpr float QSCALE = 0.07216878364870322f * 1.4426950408889634f;

constexpr size_t MiB = 1u << 20;
constexpr size_t WS_CTL = 0, CTL_BYTES = 1 * MiB;
constexpr size_t WS_COS = 1 * MiB, WS_SIN = 3 * MiB;
constexpr size_t WS_VF = 5 * MiB;
constexpr size_t WS_AFF = 29 * MiB;
constexpr size_t WS_SLOT = 30 * MiB;
constexpr size_t WS_IDX = 31 * MiB;
constexpr size_t WS_GATEV = 31 * MiB + 512 * 1024;
constexpr size_t WS_LA = 32 * MiB, WS_LB = 32 * MiB + 1536 * 1024, WS_LH0 = 35 * MiB;
constexpr size_t WS_W = 37 * MiB;
constexpr size_t WS_WIN = WS_W, WS_WOUT = WS_W + 43 * MiB, WS_WOA = WS_W + 51 * MiB, WS_WOB = WS_W + 54 * MiB, WS_WOC = WS_W + 57 * MiB,
                 WS_WL1 = WS_W + 59 * MiB, WS_WL2 = WS_W + 60 * MiB + 512 * 1024, WS_WLRU = WS_W + 61 * MiB + 256 * 1024, WS_WQ = WS_W + 62 * MiB + 768 * 1024;
constexpr size_t WS_XN = 101 * MiB;
constexpr size_t WS_YA = 101 * MiB, WS_YB = 125 * MiB;
constexpr size_t WS_H1 = 165 * MiB;
constexpr size_t WS_AF = 165 * MiB;
constexpr size_t WS_YF = 213 * MiB;
constexpr size_t WS_HG = 317 * MiB;
constexpr size_t WS_R = 509 * MiB, WS_K = 533 * MiB, WS_V = 557 * MiB, WS_KK = 581 * MiB, WS_E = 605 * MiB  , WS_BV = 653 * MiB  , WS_KD = 701 * MiB  , WS_G = 749 * MiB;
constexpr size_t WS_MERGED = 509 * MiB;
constexpr size_t WS_LOGA = 773 * MiB  , WS_IG = 821 * MiB  , WS_XC = 869 * MiB, WS_GB = 893 * MiB;
constexpr size_t WS_AM = 917 * MiB, WS_KV = 929 * MiB, WS_Q = 935 * MiB, WS_O = 959 * MiB;
constexpr size_t WS_AL = 975 * MiB;
constexpr size_t WS_GT = 991 * MiB;
constexpr size_t WS_WY = 1087 * MiB;
constexpr size_t WS_END_MIX = 1135 * MiB;
constexpr size_t WS_WGU = 165 * MiB, WS_XS = 357 * MiB, WS_HDN = 485 * MiB;
constexpr size_t WS_WD = 581 * MiB;
constexpr size_t WS_SLAB = 773 * MiB;
constexpr size_t WS_NEED = 1136 * MiB;
constexpr size_t SZ24 = 24 * MiB;

constexpr int CW_BAR = 4096;
constexpr int LDS_BYTES = 147456;
constexpr int MISC_OFF = 131072 + 320;

typedef __bf16 bf16x2_t __attribute__((ext_vector_type(2)));
__device__ __forceinline__ unsigned f2bf(float f) { return (unsigned)__builtin_bit_cast(unsigned short, (__bf16)f); }
__device__ __forceinline__ float bf2f(unsigned b) { return __builtin_bit_cast(float, b << 16); }
__device__ __forceinline__ unsigned pk2(float lo, float hi) { const bf16x2_t v = __builtin_convertvector((f32x2){lo, hi}, bf16x2_t); return __builtin_bit_cast(unsigned, v); }
__device__ __forceinline__ unsigned cvtpk(float lo, float hi) { unsigned r; asm volatile("v_cvt_pk_bf16_f32 %0, %1, %2" : "=v"(r) : "v"(lo), "v"(hi)); return r; }
__device__ __forceinline__ float bflo(unsigned w) { return __builtin_bit_cast(float, w << 16); }
__device__ __forceinline__ float bfhi(unsigned w) { return __builtin_bit_cast(float, w & 0xffff0000u); }
__device__ __forceinline__ float sigmoidf_(float x) { return __builtin_amdgcn_rcpf(1.0f + __expf(-x)); }
__device__ __forceinline__ float softplusf_(float z) { return fmaxf(z, 0.f) + __logf(1.0f + __expf(-fabsf(z))); }
__device__ __forceinline__ unsigned vzero() { unsigned z; asm volatile("v_mov_b32 %0, 0" : "=v"(z)); return z; }
__device__ __forceinline__ int lane_now() { int z; asm volatile("v_mov_b32 %0, 0" : "=v"(z)); return (int)__builtin_amdgcn_mbcnt_hi(~0u, __builtin_amdgcn_mbcnt_lo(~0u, (unsigned)z)); }
__device__ __forceinline__ float shx(float v, int o, int lane) { return __builtin_bit_cast(float, __builtin_amdgcn_ds_bpermute((lane ^ o) << 2, __builtin_bit_cast(int, v))); }
__device__ __forceinline__ int shi(int v, int src) { return __builtin_amdgcn_ds_bpermute(src << 2, v); }
__device__ __forceinline__ float wave_sum(float v) { const int lane = lane_now();
#pragma unroll
    for (int o = 32; o >= 1; o >>= 1) v += shx(v, o, lane);
    return v;
}

#define XB_TMO      128
#define XB_XCNT(j)  (256  + 64 * (j))
#define XB_XSUB(j)  (1280 + 64 * (j))
#define XB_XGEN(j)  (2304 + 64 * (j))
#define XB_TOP      3328
#define XB_TOPGEN   3392
#define XCD_BAR_WORDS 3456
#define XB_SPIN_CAP (1u << 22)
__device__ __forceinline__ unsigned xb_ld(unsigned* p)              { return __hip_atomic_load(p, __ATOMIC_RELAXED, __HIP_MEMORY_SCOPE_AGENT); }
__device__ __forceinline__ unsigned xb_add(unsigned* p, unsigned v) { return __hip_atomic_fetch_add(p, v, __ATOMIC_RELAXED, __HIP_MEMORY_SCOPE_AGENT); }
__device__ __forceinline__ unsigned xb_xcc_id() { return (unsigned)__builtin_amdgcn_s_getreg((3 << 11) | 20) & 0xFu; }
#define XB_SPIN(cond, bar) do { unsigned _sp = 0; while (cond) { __builtin_amdgcn_s_sleep(1); \
    if ((++_sp & 255u) == 0u) { if (xb_ld(&(bar)[XB_TMO])) break; if (_sp > XB_SPIN_CAP) { atomicAdd(&(bar)[XB_TMO], 1u); break; } } } } while (0)
struct XcdBarrier { unsigned* bar; unsigned x; volatile LAS unsigned* st; };
__device__ __forceinline__ bool xb_leader(int wave) { int z; asm volatile("v_mov_b32 %0, 0" : "=v"(z)); const unsigned l = __builtin_amdgcn_mbcnt_hi(~0u, __builtin_amdgcn_mbcnt_lo(~0u, (unsigned)z)); return (l | (unsigned)(wave + z)) == 0u; }
__device__ __forceinline__ XcdBarrier xcd_barrier_post(unsigned* bar, volatile LAS unsigned* st, int wave) {
    XcdBarrier b; b.bar = bar; b.x = xb_xcc_id(); b.st = st;
    if (xb_leader(wave)) (void)xb_add(&bar[XB_XCNT(b.x)], 1u);
    return b;
}
__device__ __forceinline__ void xcd_barrier_complete(unsigned* bar, unsigned x, unsigned& nloc, unsigned& nx) {
    const unsigned G = gridDim.x * gridDim.y * gridDim.z;
    unsigned sum, cnt, mine, sp = 0u;
    for (;;) {
        sum = 0u; cnt = 0u; mine = 0u;
#pragma unroll
        for (unsigned j = 0; j < 16; ++j) { const unsigned c = xb_ld(&bar[XB_XCNT(j)]); sum += c; cnt += (c > 0u) ? 1u : 0u; mine = (j == x) ? c : mine; }
        if (sum == G) break;
        __builtin_amdgcn_s_sleep(1);
        if ((++sp & 255u) == 0u) { if (xb_ld(&bar[XB_TMO])) break; if (sp > XB_SPIN_CAP) { atomicAdd(&bar[XB_TMO], 1u); break; } }
    }
    nloc = mine > 0u ? mine : 1u; nx = cnt > 0u ? cnt : 1u;
}
__device__ __forceinline__ void xcd_barrier(const XcdBarrier& b, int wave) {
    asm volatile("s_waitcnt vmcnt(0)" ::: "memory");
    __syncthreads();
    if (xb_leader(wave)) {
        unsigned* bar = b.bar;
        __builtin_amdgcn_s_waitcnt(0);
        unsigned nloc = b.st[0], nx = b.st[1];
        if (nloc == 0u) { xcd_barrier_complete(bar, b.x, nloc, nx); b.st[0] = nloc; b.st[1] = nx; }
        const unsigned old = xb_add(&bar[XB_XSUB(b.x)], 1u);
        const unsigned gen = old / nloc;
        if (old + 1u == (gen + 1u) * nloc) {
            __builtin_amdgcn_fence(__ATOMIC_RELEASE, "agent");
            asm volatile("s_waitcnt vmcnt(0)" ::: "memory");
            const unsigned og = xb_add(&bar[XB_TOP], 1u);
            const unsigned tg = og / nx;
            if (og + 1u == (tg + 1u) * nx) xb_add(&bar[XB_TOPGEN], 1u);
            else XB_SPIN(xb_ld(&bar[XB_TOPGEN]) == tg, bar);
            __builtin_amdgcn_fence(__ATOMIC_ACQUIRE, "agent");
            xb_add(&bar[XB_XGEN(b.x)], 1u);
            asm volatile("s_waitcnt vmcnt(0)" ::: "memory");
        } else {
            XB_SPIN(xb_ld(&bar[XB_XGEN(b.x)]) == gen, bar);
            __builtin_amdgcn_fence(__ATOMIC_ACQUIRE, "agent");
            asm volatile("s_waitcnt vmcnt(0)" ::: "memory");
        }
    }
    __syncthreads();
}

namespace pg8 {
constexpr int BM = 256, BK = 64, HALF = 128, HTB = HALF * BK * 2, STAGE_BYTES = 8 * HTB, NXCD = 8, WGM = 8;
__host__ __device__ __forceinline__ int lds_byte(int r, int c) { const int st = (r >> 4) * 2 + (c >> 5), rr = r & 15, cc = c & 31, ob = rr * 64 + cc * 2; return st * 1024 + (ob ^ (((ob >> 9) & 1) << 5)); }
__host__ __device__ __forceinline__ void stage_rc(int b, int& R, int& C) { const int st = b / 1024, sb = b % 1024, swz = sb ^ (((sb >> 9) & 1) << 5); R = (st >> 1) * 16 + swz / 64; C = (st & 1) * 32 + (swz % 64) / 2; }
__host__ __device__ __forceinline__ int perm32(int rho) { const int n = rho >> 4, i = rho & 15; return 8 * (i >> 2) + 4 * n + (i & 3); }

struct Unit { int pm, pn; const char* a; const char* b; };
template <class AddrF> struct Order {
    int nM, nN, nwg, G, c, reps; AddrF F;
    __device__ void init(int nM_, int nN_, int G_, int c_, const AddrF& f, int reps_ = 1) { nM = nM_; nN = nN_; nwg = nM * nN; G = G_; c = c_; F = f; reps = reps_; }
    __device__ bool next(int i, Unit& u) const {
        const long L = (long)i * G + c; if (L >= (long)nwg * reps) return false;
        int wgid = (int)(L % nwg); { const int q = nwg / NXCD, r = nwg % NXCD, xcd = wgid % NXCD, off = wgid / NXCD; wgid = (xcd < r ? xcd * (q + 1) : r * (q + 1) + (xcd - r) * q) + off; }
        const int nig = WGM * nN, gid = wgid / nig, fm = gid * WGM, gsz = (nM - fm) < WGM ? (nM - fm) : WGM;
        u.pm = fm + ((wgid % nig) % gsz); u.pn = (wgid % nig) / gsz; u.a = F.a(u.pm, u.pn); u.b = F.b(u.pm, u.pn); return true;
    }
};
struct Gemm { int K; int lda; int ldb; };

template <class Epi, class Sched, bool ALIGN_EPI = true, bool SP2 = true>
__device__ __forceinline__ void gemm_phase(LAS unsigned char* lds, const Gemm g, const Sched& S, const Epi& E, int tid, int wid) {
    const int lane = tid & 63, wr = wid >> 2, wc = wid & 3, fr = lane & 15, fq = lane >> 4;
    const int K = g.K, nt = K / BK;
    unsigned voffA[2], voffB[2];
#pragma unroll
    for (int i = 0; i < 2; ++i) { int R, C; stage_rc(tid * 16 + i * 8192, R, C); const int Rb = Epi::PERM ? ((R & ~31) + perm32(R & 31)) : R;
        voffA[i] = (unsigned)(R * g.lda + C) * 2u; voffB[i] = (unsigned)(Rb * g.ldb + C) * 2u; }
    const size_t kstep = (size_t)(BK * 2);
    const size_t hstepA = (size_t)HALF * g.lda * 2, hstepB = (size_t)HALF * g.ldb * 2;
    const unsigned ldsw = (unsigned)wid * 1024u;
    const int aoff = lds_byte(wr * 64 + fr, fq * 8), boff = lds_byte(wc * 32 + fr, fq * 8);
#define PG8_SA(b, h) (((b) * 2 + (h)) * HTB)
#define PG8_SB(b, h) ((4 + (b) * 2 + (h)) * HTB)
#define PG8_STAGE(bufoff, gbase, voff) do { _Pragma("unroll") for (int _i = 0; _i < 2; ++_i) \
        __builtin_amdgcn_global_load_lds((const unsigned*)((const char*)(gbase) + (voff)[_i]), (LAS unsigned*)(lds + (bufoff) + ldsw + _i * 8192), 16, 0, 0); } while (0)
#define PG8_LDA(dst, b, h) do { _Pragma("unroll") for (int m = 0; m < 4; ++m) _Pragma("unroll") for (int k = 0; k < 2; ++k) dst[m][k] = *(const LAS bf16x8*)(lds + PG8_SA(b, h) + aoff + m * 2048 + k * 1024); } while (0)
#define PG8_LDB(dst, b, h) do { _Pragma("unroll") for (int n = 0; n < 2; ++n) _Pragma("unroll") for (int k = 0; k < 2; ++k) dst[n][k] = *(const LAS bf16x8*)(lds + PG8_SB(b, h) + boff + n * 2048 + k * 1024); } while (0)
#define PG8_MMA(ai, bj, At, Bt) do { __builtin_amdgcn_s_setprio(1); _Pragma("unroll") for (int m = 0; m < 4; ++m) _Pragma("unroll") for (int n = 0; n < 2; ++n) _Pragma("unroll") for (int k = 0; k < 2; ++k) \
        acc[ai][bj][m][n] = __builtin_amdgcn_mfma_f32_16x16x32_bf16(Bt[n][k], At[m][k], acc[ai][bj][m][n], 0, 0, 0); __builtin_amdgcn_s_setprio(0); } while (0)
#define PG8_WAIT_V(n) asm volatile("s_waitcnt vmcnt(" #n ")" ::: "memory")
#define PG8_WAIT_L(n) asm volatile("s_waitcnt lgkmcnt(" #n ")" ::: "memory")
#define PG8_BAR __builtin_amdgcn_s_barrier()
#define PG8_SCHED __builtin_amdgcn_sched_barrier(0)
    Unit cur, nxt; int ui = 0;
    if (!S.next(0, cur)) return;
    f32x4 acc[2][2][4][2];
#pragma unroll
    for (int a = 0; a < 2; ++a)
#pragma unroll
        for (int b = 0; b < 2; ++b)
#pragma unroll
            for (int m = 0; m < 4; ++m)
#pragma unroll
                for (int n = 0; n < 2; ++n) acc[a][b][m][n] = (f32x4){0.f, 0.f, 0.f, 0.f};
    bf16x8 At[4][2], B0[2][2], B1[2][2];
    const char* cA = cur.a; const char* cB = cur.b;
    if constexpr (SP2) {
        PG8_STAGE(PG8_SB(0, 0), cB, voffB); PG8_STAGE(PG8_SB(0, 1), cB + hstepB, voffB); PG8_STAGE(PG8_SA(0, 0), cA, voffA); PG8_STAGE(PG8_SA(0, 1), cA + hstepA, voffA);
        if (wr == 1) PG8_BAR;
        PG8_WAIT_V(2); PG8_BAR;
        PG8_STAGE(PG8_SB(1, 0), cB + kstep, voffB); PG8_STAGE(PG8_SA(1, 0), cA + kstep, voffA); PG8_STAGE(PG8_SB(1, 1), cB + hstepB + kstep, voffB);
        PG8_WAIT_V(6); PG8_BAR;
    } else {
        PG8_STAGE(PG8_SB(0, 0), cB, voffB); PG8_STAGE(PG8_SA(0, 0), cA, voffA); PG8_STAGE(PG8_SB(0, 1), cB + hstepB, voffB); PG8_STAGE(PG8_SA(0, 1), cA + hstepA, voffA);
        if (wr == 1) PG8_BAR;
        PG8_WAIT_V(4); PG8_BAR;
        PG8_STAGE(PG8_SB(1, 0), cB + kstep, voffB); PG8_STAGE(PG8_SA(1, 0), cA + kstep, voffA); PG8_STAGE(PG8_SB(1, 1), cB + hstepB + kstep, voffB);
        PG8_WAIT_V(6); PG8_BAR;
    }
    for (;;) {
        const bool has_next = S.next(ui + 1, nxt);
        const char* nA = has_next ? nxt.a : cA; const char* nB = has_next ? nxt.b : cB;
#pragma unroll 1
        for (int t = 0; t < nt; t += 2) {
            const bool last = (t == nt - 2);
            const char* a1 = cA + (size_t)(t + 1) * kstep;
            const char* a2 = last ? nA : cA + (size_t)(t + 2) * kstep; const char* b2 = last ? nB : cB + (size_t)(t + 2) * kstep;
            const char* a3 = a2 + kstep; const char* b3 = b2 + kstep;
            if constexpr (SP2) {
            PG8_LDB(B0, 0, 0); PG8_LDB(B1, 0, 1); PG8_SCHED; PG8_LDA(At, 0, 0); PG8_STAGE(PG8_SA(1, 1), a1 + hstepA, voffA);
            PG8_WAIT_V(8); PG8_WAIT_L(0); PG8_BAR; PG8_MMA(0, 0, At, B0); PG8_MMA(0, 1, At, B1); PG8_BAR; PG8_SCHED;
            PG8_LDA(At, 0, 1); PG8_STAGE(PG8_SB(0, 0), b2, voffB); PG8_STAGE(PG8_SB(0, 1), b2 + hstepB, voffB); PG8_STAGE(PG8_SA(0, 0), a2, voffA);
            PG8_WAIT_V(8); PG8_WAIT_L(0); PG8_BAR; PG8_MMA(1, 0, At, B0); PG8_MMA(1, 1, At, B1); PG8_BAR; PG8_SCHED;
            PG8_LDB(B0, 1, 0); PG8_LDB(B1, 1, 1); PG8_SCHED; PG8_LDA(At, 1, 0); PG8_STAGE(PG8_SA(0, 1), a2 + hstepA, voffA);
            PG8_WAIT_V(8); PG8_WAIT_L(0); PG8_BAR; PG8_MMA(0, 0, At, B0); PG8_MMA(0, 1, At, B1); PG8_BAR; PG8_SCHED;
            PG8_LDA(At, 1, 1); PG8_STAGE(PG8_SB(1, 0), b3, voffB); PG8_STAGE(PG8_SB(1, 1), b3 + hstepB, voffB); PG8_STAGE(PG8_SA(1, 0), a3, voffA);
            PG8_WAIT_V(8); PG8_WAIT_L(0); PG8_BAR; PG8_MMA(1, 0, At, B0); PG8_MMA(1, 1, At, B1); PG8_BAR; PG8_SCHED;
            } else {
            PG8_LDB(B0, 0, 0); PG8_SCHED; PG8_LDA(At, 0, 0); PG8_STAGE(PG8_SA(1, 1), a1 + hstepA, voffA);
            PG8_WAIT_L(8); PG8_BAR; PG8_WAIT_L(0); PG8_MMA(0, 0, At, B0); PG8_BAR; PG8_SCHED;
            PG8_LDB(B1, 0, 1); PG8_STAGE(PG8_SB(0, 0), b2, voffB);
            PG8_BAR; PG8_WAIT_L(0); PG8_MMA(0, 1, At, B1); PG8_BAR;
            PG8_LDA(At, 0, 1); PG8_STAGE(PG8_SA(0, 0), a2, voffA);
            PG8_BAR; PG8_WAIT_L(0); PG8_MMA(1, 0, At, B0); PG8_BAR; PG8_SCHED;
            PG8_STAGE(PG8_SB(0, 1), b2 + hstepB, voffB);
            PG8_WAIT_V(6); PG8_BAR; PG8_MMA(1, 1, At, B1); PG8_BAR;
            PG8_LDB(B0, 1, 0); PG8_SCHED; PG8_LDA(At, 1, 0); PG8_STAGE(PG8_SA(0, 1), a2 + hstepA, voffA);
            PG8_WAIT_L(8); PG8_BAR; PG8_WAIT_L(0); PG8_MMA(0, 0, At, B0); PG8_BAR; PG8_SCHED;
            PG8_LDB(B1, 1, 1); PG8_STAGE(PG8_SB(1, 0), b3, voffB);
            PG8_BAR; PG8_WAIT_L(0); PG8_MMA(0, 1, At, B1); PG8_BAR;
            PG8_LDA(At, 1, 1); PG8_STAGE(PG8_SA(1, 0), a3, voffA);
            PG8_BAR; PG8_WAIT_L(0); PG8_MMA(1, 0, At, B0); PG8_BAR; PG8_SCHED;
            PG8_STAGE(PG8_SB(1, 1), b3 + hstepB, voffB);
            PG8_WAIT_V(6); PG8_BAR; PG8_MMA(1, 1, At, B1); PG8_BAR;
            }
        }
        if constexpr (ALIGN_EPI) { if (wr == 0) PG8_BAR; }
        E(acc, cur, wr, wc, fr, fq);
        if (!has_next) break;
#pragma unroll
        for (int a = 0; a < 2; ++a)
#pragma unroll
            for (int b = 0; b < 2; ++b)
#pragma unroll
                for (int m = 0; m < 4; ++m)
#pragma unroll
                    for (int n = 0; n < 2; ++n) acc[a][b][m][n] = (f32x4){0.f, 0.f, 0.f, 0.f};
        cur = nxt; cA = nA; cB = nB; ++ui;
        if constexpr (ALIGN_EPI) { if (wr == 1) PG8_BAR; }
    }
    PG8_WAIT_V(0);
    if constexpr (!ALIGN_EPI) { if (wr == 0) PG8_BAR; }
    PG8_BAR;
#undef PG8_SA
#undef PG8_SB
#undef PG8_STAGE
#undef PG8_LDA
#undef PG8_LDB
#undef PG8_MMA
#undef PG8_WAIT_V
#undef PG8_WAIT_L
#undef PG8_BAR
#undef PG8_SCHED
}
}

struct Params { const float* in[40]; float* out; unsigned char* ws; int ph_lo, ph_hi; };
enum { I_X = 0, I_POS, I_NORM_MIX, I_W_IN, I_MU, I_W0, I_W2, I_A0, I_A2, I_G2, I_KK, I_KA, I_RK, I_LNW, I_LNB, I_VDN, I_VUP, I_VB,
       I_CONVW, I_CONVB, I_WA, I_BA, I_WX, I_BX, I_LAM, I_QN, I_KVN, I_WUQ, I_WUK, I_WUV, I_WOR, I_WOL, I_WOM, I_WOUT, I_NFFN, I_WR, I_WG, I_WU, I_WDN, I_NFIN };
struct Frame {
    LAS unsigned char* lds; int tid, lane, wave, G, bid; int gw, nw;
    const __attribute__((address_space(4))) Params* P; unsigned char* ws;
};
template <class Tp> __device__ __forceinline__ Tp* wsp(const Frame& F, size_t off) { return (Tp*)(F.ws + off); }
typedef __attribute__((address_space(1))) const float gcf_t; typedef __attribute__((address_space(1))) float gf_t; typedef __attribute__((address_space(1))) unsigned char guc_t;
__device__ __forceinline__ const float* gin(const Frame& F, int i) { return (const float*)(gcf_t*)F.P->in[i]; }
__device__ __forceinline__ float* gout(const Frame& F) { return (float*)(gf_t*)F.P->out; }
template <class Tp> __device__ __forceinline__ Tp* opaque(Tp* p) { unsigned long long x = (unsigned long long)p; unsigned lo = (unsigned)x, hi = (unsigned)(x >> 32); asm volatile("" : "+v"(lo), "+v"(hi));
    lo = __builtin_amdgcn_readfirstlane(lo); hi = __builtin_amdgcn_readfirstlane(hi);
    typedef __attribute__((address_space(1))) char gchar_t; gchar_t* g = (gchar_t*)(((unsigned long long)hi << 32) | lo); return (Tp*)g; }

__device__ __forceinline__ void unpack8(const u32x4 w, float (&f)[8]) {
    f[0] = bflo(w.x); f[1] = bfhi(w.x); f[2] = bflo(w.y); f[3] = bfhi(w.y); f[4] = bflo(w.z); f[5] = bfhi(w.z); f[6] = bflo(w.w); f[7] = bfhi(w.w);
}
__device__ __forceinline__ u32x4 pack8(const float (&f)[8]) { u32x4 w; w.x = pk2(f[0], f[1]); w.y = pk2(f[2], f[3]); w.z = pk2(f[4], f[5]); w.w = pk2(f[6], f[7]); return w; }

struct CvtJob { const float* src; bf16_t* dst; int lds_; int Ks; int N; int ldd; int Kd; int koff; int rblock; int rstride; };
__device__ __forceinline__ void cvt_load(const Frame& F, const CvtJob& J, int t, f32x4 (&v)[2]) {
    const int tk = J.Kd >> 6; const int kt = t % tk, ntl = t / tk; const int k0 = kt * 64, n0 = ntl * 64; const int kr = F.tid >> 4, nq = F.tid & 15;
#pragma unroll
    for (int h = 0; h < 2; ++h) { const int k = k0 + kr + 32 * h, ks = k - J.koff, n = n0 + nq * 4; v[h] = (f32x4){0.f, 0.f, 0.f, 0.f};
        if (ks >= 0 && ks < J.Ks && n < J.N) v[h] = *(const f32x4*)(J.src + (size_t)ks * J.lds_ + n); }
}
__device__ __forceinline__ void cvt_finish(const Frame& F, const CvtJob& J, int t, const f32x4 (&v)[2]) {
    LAS float* tile = (LAS float*)F.lds;
    const int tk = J.Kd >> 6; const int kt = t % tk, ntl = t / tk; const int k0 = kt * 64, n0 = ntl * 64;
    { const int kr = F.tid >> 4, nq = F.tid & 15;
#pragma unroll
      for (int h = 0; h < 2; ++h) { LAS float* d = tile + (kr + 32 * h) * 65 + nq * 4; d[0] = v[h][0]; d[1] = v[h][1]; d[2] = v[h][2]; d[3] = v[h][3]; } }
    __syncthreads();
    { const int n = F.tid >> 3, kq = F.tid & 7; float f[8];
#pragma unroll
      for (int i = 0; i < 8; ++i) f[i] = tile[(kq * 8 + i) * 65 + n];
      const int nn = n0 + n;
      if (nn < J.N) { const int drow = (nn / J.rblock) * J.rstride + (nn % J.rblock); *(u32x4*)(J.dst + (size_t)drow * J.ldd + k0 + kq * 8) = pack8(f); } }
    __syncthreads();
}
__device__ __forceinline__ void cvt_tile(const Frame& F, const CvtJob& J, int t) { f32x4 v[2]; cvt_load(F, J, t, v); cvt_finish(F, J, t, v); }
__device__ __forceinline__ int cvt_ntiles(const CvtJob& J) { return ((J.N + 63) >> 6) * (J.Kd >> 6); }

__device__ __forceinline__ CvtJob nm_job(const Frame& F, int l, int j) {
    CvtJob J; J.rblock = 1 << 30; J.rstride = 0; J.koff = 0;
    bf16_t* WIN = wsp<bf16_t>(F, WS_WIN);
    if (j == 0) { J.src = gin(F, I_W_IN) + (size_t)l * DM * IN_COLS; J.lds_ = IN_COLS; J.Ks = DM; J.N = 4800; J.dst = WIN; J.ldd = DM; J.Kd = DM; }
    else if (j == 1) { J.src = gin(F, I_W_IN) + (size_t)l * DM * IN_COLS + 4800; J.lds_ = IN_COLS; J.Ks = DM; J.N = 6144; J.dst = WIN + (size_t)H1W * DM; J.ldd = DM; J.Kd = DM; }
    else if (j == 2) { J.src = gin(F, I_VDN) + (size_t)(l > 0 ? l - 1 : 0) * DM * 32; J.lds_ = 32; J.Ks = l > 0 ? DM : 0; J.N = 32; J.dst = WIN + (size_t)4800 * DM; J.ldd = DM; J.Kd = DM; }
    else if (j == 3) { J.src = gin(F, I_VDN); J.lds_ = 32; J.Ks = 0; J.N = 32; J.dst = WIN + (size_t)4832 * DM; J.ldd = DM; J.Kd = DM; }
    else if (j < 8) { const int i = j - 4, d = i & 1; J.src = (i < 2 ? gin(F, I_W2) : gin(F, I_A2)) + (size_t)(l * 2 + d) * 64 * RW; J.lds_ = RW; J.Ks = 64; J.N = RW;
        J.dst = wsp<bf16_t>(F, WS_WL1) + (size_t)i * RW * 256; J.ldd = 256; J.Kd = 256; J.koff = 64 * i; }
    else if (j == 8) { J.src = gin(F, I_G2) + (size_t)l * 128 * RW; J.lds_ = RW; J.Ks = 128; J.N = RW; J.dst = wsp<bf16_t>(F, WS_WL2); J.ldd = 256; J.Kd = 256; }
    else if (j == 9) { J.src = gin(F, I_VUP) + (size_t)(l > 0 ? l - 1 : 0) * 32 * RW; J.lds_ = RW; J.Ks = l > 0 ? 32 : 0; J.N = RW; J.dst = wsp<bf16_t>(F, WS_WL2) + (size_t)RW * 256; J.ldd = 256; J.Kd = 256; J.koff = 128; }
    else if (j < 34) { const int q = j - 10, gp = q >> 3, b = (q >> 2) & 1, kind = q & 3, blk = 2 * gp + b, d = kind & 1;
        J.src = (kind < 2 ? gin(F, I_WA) : gin(F, I_WX)) + (size_t)((l * 2 + d) * 6 + blk) * 128 * 128; J.lds_ = 128; J.Ks = 128; J.N = 128;
        J.dst = wsp<bf16_t>(F, WS_WLRU) + (size_t)(gp * 1024 + b * 512 + kind * 128) * 256; J.ldd = 256; J.Kd = 256; J.koff = b * 128; }
    else if (j == 34) { J.src = gin(F, I_WOR) + (size_t)l * RW * DM; J.lds_ = DM; J.Ks = RW; J.N = DM; J.dst = wsp<bf16_t>(F, WS_WOA); J.ldd = RW; J.Kd = RW; }
    else if (j == 35) { J.src = gin(F, I_WOL) + (size_t)l * LW * DM; J.lds_ = DM; J.Ks = LW; J.N = DM; J.dst = wsp<bf16_t>(F, WS_WOB); J.ldd = LW; J.Kd = LW; }
    else { J.src = gin(F, I_WOUT) + (size_t)l * DM * DM; J.lds_ = DM; J.Ks = DM; J.N = DM; J.dst = wsp<bf16_t>(F, WS_WOUT); J.ldd = DM; J.Kd = DM; }
    return J;
}
constexpr int NM_JOBS = 37;

__device__ __forceinline__ void phase_cvt_nm(const Frame& F, int l) {
    int rot = 0;
    for (int j = 0; j < NM_JOBS; ++j) {
        const CvtJob J = nm_job(F, l, j); const int nt = cvt_ntiles(J);
        int start = F.bid - rot; if (start < 0) start += F.G;
        if (start < nt) { f32x4 cv[2]; cvt_load(F, J, start, cv);
            for (int t = start; t < nt; t += F.G) { f32x4 nv[2]; nv[0] = cv[0]; nv[1] = cv[1]; if (t + F.G < nt) cvt_load(F, J, t + F.G, nv); cvt_finish(F, J, t, cv); cv[0] = nv[0]; cv[1] = nv[1]; } }
        rot = (rot + nt) % F.G;
    }
    { const float* wuq = gin(F, I_WUQ) + (size_t)l * 384 * 768; const float* wuk = gin(F, I_WUK) + (size_t)l * 128 * 512; bf16_t* WQ = wsp<bf16_t>(F, WS_WQ);
      for (int o = F.bid * NTHR + F.tid; o < 4 * 64 * 384; o += F.G * NTHR) { const int i = o % 384, hc = o / 384, h = hc >> 6, cc = hc & 63, g = cc >> 5, ii = cc & 31; const int js = (ii < 16) ? (16 * g + ii) : (32 + 16 * g + ii - 16);
          WQ[(size_t)(h * 192 + 128 + cc) * 384 + i] = (bf16_t)f2bf(wuq[(size_t)i * 768 + h * 192 + 128 + js]); }
      for (int wt = F.gw; wt < 4 * 8 * 6; wt += F.nw) {
          const int hcb = wt / 6, ib = wt % 6, h = hcb >> 3, cb = hcb & 7, i = ib * 64 + F.lane;
          const float* a = wuq + (size_t)i * 768 + h * 192; const float* b = wuk + (size_t)(cb * 16) * 512 + h * 128;
          float acc[16];
#pragma unroll
          for (int j = 0; j < 16; ++j) acc[j] = 0.f;
#pragma unroll 1
          for (int d = 0; d < 128; d += 4) { const f32x4 av = *(const f32x4*)(a + d);
#pragma unroll
              for (int j = 0; j < 16; ++j) { const f32x4 bv = *(const f32x4*)(b + (size_t)j * 512 + d); acc[j] += av[0] * bv[0] + av[1] * bv[1] + av[2] * bv[2] + av[3] * bv[3]; } }
#pragma unroll
          for (int j = 0; j < 16; ++j) WQ[(size_t)(h * 192 + cb * 16 + j) * 384 + i] = (bf16_t)f2bf(acc[j]); } }
    { const float* wuv = gin(F, I_WUV) + (size_t)l * 128 * 512; const float* wom = gin(F, I_WOM) + (size_t)l * 512 * DM; bf16_t* WOC = wsp<bf16_t>(F, WS_WOC);
      for (int bt = F.bid; bt < 4 * 4 * 8; bt += F.G) { const int nb = bt & 3, hcb = bt >> 2, h = hcb >> 3, cb = hcb & 7, n = nb * 512 + F.tid;
          const float* a = wuv + (size_t)(cb * 16) * 512 + h * 128; const float* b = wom + (size_t)(h * 128) * DM + n;
          float acc[16];
#pragma unroll
          for (int j = 0; j < 16; ++j) acc[j] = 0.f;
#pragma unroll 1
          for (int d = 0; d < 128; d += 4) { float bv[4];
#pragma unroll
              for (int e = 0; e < 4; ++e) bv[e] = b[(size_t)(d + e) * DM];
#pragma unroll
              for (int j = 0; j < 16; ++j) { const f32x4 av = *(const f32x4*)(a + (size_t)j * 512 + d); acc[j] += av[0] * bv[0] + av[1] * bv[1] + av[2] * bv[2] + av[3] * bv[3]; } }
          u32x4 w0, w1; w0.x = pk2(acc[0], acc[1]); w0.y = pk2(acc[2], acc[3]); w0.z = pk2(acc[4], acc[5]); w0.w = pk2(acc[6], acc[7]); w1.x = pk2(acc[8], acc[9]); w1.y = pk2(acc[10], acc[11]); w1.z = pk2(acc[12], acc[13]); w1.w = pk2(acc[14], acc[15]);
          u32x4* dst = (u32x4*)(WOC + (size_t)n * 512 + h * 128 + cb * 16); dst[0] = w0; dst[1] = w1; } }
}

__device__ __forceinline__ CvtJob moe_job(const Frame& F, int l, int job) {
    const int e = job / 3, kind = job % 3; CvtJob J; J.koff = 0;
    if (kind < 2) { J.src = (kind == 0 ? gin(F, I_WG) : gin(F, I_WU)) + (size_t)(l * NE + e) * DM * FF; J.lds_ = FF; J.Ks = DM; J.N = FF;
        J.dst = wsp<bf16_t>(F, WS_WGU) + (size_t)e * 2048 * DM + (size_t)kind * 16 * DM; J.ldd = DM; J.Kd = DM; J.rblock = 16; J.rstride = 32; }
    else { J.src = gin(F, I_WDN) + (size_t)(l * NE + e) * FF * DM; J.lds_ = DM; J.Ks = FF; J.N = DM; J.dst = wsp<bf16_t>(F, WS_WD) + (size_t)e * DM * FF; J.ldd = FF; J.Kd = FF; J.rblock = 1 << 30; J.rstride = 0; }
    return J;
}
__device__ __forceinline__ int moe_job_of(int which, int jj) { return which == 0 ? 3 * jj + 2 : 3 * (jj >> 1) + (jj & 1); }
__device__ __forceinline__ void phase_cvt_moe(const Frame& F, int l, int bid, int nblk, int reps, int which) {
    const int NJ = (which == 0 ? 16 : 32) * 512; const int NT_ = NJ * reps; if (bid >= NT_) return;
    f32x4 cv[2], c1[2]; { const int t = bid % NJ; const CvtJob J = moe_job(F, l, moe_job_of(which, t >> 9)); cvt_load(F, J, t & 511, cv); }
    c1[0] = cv[0]; c1[1] = cv[1];
    if (bid + nblk < NT_) { const int t = (bid + nblk) % NJ; const CvtJob J = moe_job(F, l, moe_job_of(which, t >> 9)); cvt_load(F, J, t & 511, c1); }
    for (int t_ = bid; t_ < NT_; t_ += nblk) { const int t = t_ % NJ; const CvtJob J = moe_job(F, l, moe_job_of(which, t >> 9));
        f32x4 c2[2]; c2[0] = c1[0]; c2[1] = c1[1];
        if (t_ + 2 * nblk < NT_) { const int t2 = (t_ + 2 * nblk) % NJ; const CvtJob J2 = moe_job(F, l, moe_job_of(which, t2 >> 9)); cvt_load(F, J2, t2 & 511, c2); }
        cvt_finish(F, J, t & 511, cv); cv[0] = c1[0]; cv[1] = c1[1]; c1[0] = c2[0]; c1[1] = c2[1]; }
}

__device__ __forceinline__ void phase_rope_table(const Frame& F) {
    const int* pos = (const int*)gin(F, I_POS); float* C = wsp<float>(F, WS_COS); float* S = wsp<float>(F, WS_SIN);
    for (int o = F.bid * NTHR + F.tid; o < T * 32; o += F.G * NTHR) { const int t = o >> 5, j = o & 31;
        const float inv = powf(10000.0f, -(float)(2 * j) / 64.0f); const float ang = (float)pos[t] * inv; float s, c; sincosf(ang, &s, &c); C[o] = c; S[o] = s; }
}

__device__ __forceinline__ void phase_norm(const Frame& F, int mode, const float* gain) {
    float* X = gout(F); bf16_t* XN = wsp<bf16_t>(F, WS_XN);
    const int* SLOT = wsp<int>(F, WS_SLOT); const bf16_t* SLAB = wsp<bf16_t>(F, WS_SLAB);
    for (int row = F.gw; row < T; row += F.nw) {
        f32x4 v[8]; const float* src = (mode == 0 ? gin(F, I_X) : X) + (size_t)row * DM;
#pragma unroll
        for (int i = 0; i < 8; ++i) v[i] = *(const f32x4*)(src + i * 256 + F.lane * 4);
        if (mode != 0) {
            const int myslot = SLOT[(F.lane & 15) * T + row];
            unsigned m = (unsigned)(__ballot(myslot >= 0) & 0xFFFFull);
            while (m) { const int e0 = __builtin_ctz(m); m &= m - 1; const bool two = m != 0; const int e1 = two ? __builtin_ctz(m) : e0; if (two) m &= m - 1;
                const int s0 = __builtin_amdgcn_readlane(myslot, e0), s1 = __builtin_amdgcn_readlane(myslot, e1);
                const bf16_t* r0 = SLAB + ((size_t)e0 * CAP + s0) * DM; const bf16_t* r1 = SLAB + ((size_t)e1 * CAP + s1) * DM;
                u32x2 w0[8], w1[8];
#pragma unroll
                for (int i = 0; i < 8; ++i) { w0[i] = *(const u32x2*)(r0 + i * 256 + F.lane * 4); w1[i] = *(const u32x2*)(r1 + i * 256 + F.lane * 4); }
#pragma unroll
                for (int i = 0; i < 8; ++i) { v[i][0] += bflo(w0[i].x); v[i][1] += bfhi(w0[i].x); v[i][2] += bflo(w0[i].y); v[i][3] += bfhi(w0[i].y); }
                if (two) {
#pragma unroll
                    for (int i = 0; i < 8; ++i) { v[i][0] += bflo(w1[i].x); v[i][1] += bfhi(w1[i].x); v[i][2] += bflo(w1[i].y); v[i][3] += bfhi(w1[i].y); } } }
        }
        float ss = 0.f;
#pragma unroll
        for (int i = 0; i < 8; ++i) ss += v[i][0] * v[i][0] + v[i][1] * v[i][1] + v[i][2] * v[i][2] + v[i][3] * v[i][3];
        ss = wave_sum(ss); const float rstd = rsqrtf(ss * (1.0f / DM) + 1e-6f);
        if (mode != 2) {
#pragma unroll
            for (int i = 0; i < 8; ++i) *(f32x4*)(X + (size_t)row * DM + i * 256 + F.lane * 4) = v[i];
#pragma unroll
            for (int i = 0; i < 8; ++i) { const f32x4 g = *(const f32x4*)(gain + i * 256 + F.lane * 4); u32x2 w; w.x = pk2(v[i][0] * rstd * g[0], v[i][1] * rstd * g[1]); w.y = pk2(v[i][2] * rstd * g[2], v[i][3] * rstd * g[3]);
                *(u32x2*)(XN + (size_t)row * DM + i * 256 + F.lane * 4) = w; }
        } else {
#pragma unroll
            for (int i = 0; i < 8; ++i) { const f32x4 g = *(const f32x4*)(gain + i * 256 + F.lane * 4); f32x4 o; o[0] = v[i][0] * rstd * g[0]; o[1] = v[i][1] * rstd * g[1]; o[2] = v[i][2] * rstd * g[2]; o[3] = v[i][3] * rstd * g[3];
                *(f32x4*)(X + (size_t)row * DM + i * 256 + F.lane * 4) = o; }
        }
    }
}

struct AddrLin { const char* A; const char* B; size_t am, an, bm, bn; int ash, bsh;
    __device__ __forceinline__ const char* a(int pm, int pn) const { return A + (size_t)pm * am + (size_t)(pn >> ash) * an; }
    __device__ __forceinline__ const char* b(int pm, int pn) const { return B + (size_t)(pm >> bsh) * bm + (size_t)pn * bn; } };
typedef pg8::Order<AddrLin> OrderL;
#define EPI_ARGS const f32x4 (&acc)[2][2][4][2], const pg8::Unit& u, int wr, int wc, int fr, int fq
#define EPI_ROWS _Pragma("unroll") for (int ai = 0; ai < 2; ++ai) _Pragma("unroll") for (int m = 0; m < 4; ++m, ({ asm volatile("" ::: "memory"); }))
#define EPI_ROW (u.pm * 256 + ai * 128 + wr * 64 + m * 16 + fr)
__device__ __forceinline__ u32x2 pk4(const f32x4 v) { u32x2 w; w.x = pk2(v[0], v[1]); w.y = pk2(v[2], v[3]); return w; }
__device__ __forceinline__ f32x4 up4(const u32x2 w) { return (f32x4){bflo(w.x), bfhi(w.x), bflo(w.y), bfhi(w.y)}; }

struct EpiWin { static constexpr bool PERM = true; unsigned char* ws;
    __device__ __forceinline__ void operator()(EPI_ARGS) const { bf16_t* H1 = (bf16_t*)(ws + WS_H1); bf16_t* HG = (bf16_t*)(ws + WS_HG);
        const bool gates = u.pn >= 19; bf16_t* base = gates ? HG : H1; const int ldc = gates ? HGW : H1W; const int colt = (gates ? u.pn - 19 : u.pn) * 256 + wc * 32 + 8 * fq;
        EPI_ROWS { bf16_t* rowp = base + (size_t)EPI_ROW * ldc + colt;
#pragma unroll
            for (int bj = 0; bj < 2; ++bj) { f32x4 v0 = acc[ai][bj][m][0], v1 = acc[ai][bj][m][1];
                if (gates) {
#pragma unroll
                    for (int i = 0; i < 4; ++i) { v0[i] = sigmoidf_(v0[i]); v1[i] = sigmoidf_(v1[i]); } }
                u32x4 w; w.x = pk2(v0[0], v0[1]); w.y = pk2(v0[2], v0[3]); w.z = pk2(v1[0], v1[1]); w.w = pk2(v1[2], v1[3]);
                *(u32x4*)(rowp + bj * 128) = w; } }
    } };

struct EpiLora1 { static constexpr bool PERM = false; const float* w0; const float* a0; const float* ka; unsigned char* ws;
    __device__ __forceinline__ void operator()(EPI_ARGS) const {
        const bf16_t* KK = (const bf16_t*)(ws + WS_KK); const bf16_t* K = (const bf16_t*)(ws + WS_K); bf16_t* E = (bf16_t*)(ws + WS_E); bf16_t* BV = (bf16_t*)(ws + WS_BV); bf16_t* KD = (bf16_t*)(ws + WS_KD);
        const int seg = u.pn / 3; const int j0 = (u.pn % 3) * 256 + wc * 32 + 4 * fq;
        if (seg < 2) { const float* w0s = w0 + seg * RW; bf16_t* Es = E + (size_t)seg * T * RW;
            EPI_ROWS { const size_t ro = (size_t)EPI_ROW * RW;
#pragma unroll
                for (int bj = 0; bj < 2; ++bj)
#pragma unroll
                    for (int n = 0; n < 2; ++n) { const int j = j0 + bj * 128 + n * 16; const f32x4 v = acc[ai][bj][m][n]; f32x4 o; const f32x4 b = *(const f32x4*)(w0s + j);
#pragma unroll
                        for (int i = 0; i < 4; ++i) { const float z = b[i] + v[i]; o[i] = -0.6065306597126334f * sigmoidf_(z); }
                        *(u32x2*)(Es + ro + j) = pk4(o); } }
        } else { const int d = seg - 2; const float* a0s = a0 + d * RW; bf16_t* BVs = BV + (size_t)d * T * RW; bf16_t* KDs = KD + (size_t)d * T * RW;
            f32x4 bq[4], kaq[4];
#pragma unroll
            for (int x_ = 0; x_ < 4; ++x_) { const int j = j0 + (x_ >> 1) * 128 + (x_ & 1) * 16; bq[x_] = *(const f32x4*)(a0s + j); kaq[x_] = *(const f32x4*)(ka + j); }
            const size_t row0 = (size_t)u.pm * 256 + wr * 64 + fr; u32x2 kkq[2][4], kq_[2][4];
#define EL_LD(rr, b_) do { const size_t ro_ = (row0 + ((rr) >> 2) * 128 + ((rr) & 3) * 16) * RW; _Pragma("unroll") for (int x_ = 0; x_ < 4; ++x_) { const int j_ = j0 + (x_ >> 1) * 128 + (x_ & 1) * 16; kkq[b_][x_] = *(const u32x2*)(KK + ro_ + j_); kq_[b_][x_] = *(const u32x2*)(K + ro_ + j_); } } while (0)
            EL_LD(0, 0);
#pragma unroll
            for (int rr = 0; rr < 8; ++rr) { const int ai = rr >> 2, m = rr & 3; const size_t ro = (row0 + ai * 128 + m * 16) * RW;
                if (rr < 7) EL_LD(rr + 1, (rr + 1) & 1);
#pragma unroll
                for (int x_ = 0; x_ < 4; ++x_) { const int bj = x_ >> 1, n = x_ & 1; const int j = j0 + bj * 128 + n * 16; const f32x4 v = acc[ai][bj][m][n]; f32x4 o, o2; const f32x4 kk = up4(kkq[rr & 1][x_]), k = up4(kq_[rr & 1][x_]);
#pragma unroll
                    for (int i = 0; i < 4; ++i) { const float a = sigmoidf_(bq[x_][i] + v[i]); o[i] = a * kk[i]; o2[i] = k[i] * (1.0f + (a - 1.0f) * kaq[x_][i]); }
                    *(u32x2*)(BVs + ro + j) = pk4(o); *(u32x2*)(KDs + ro + j) = pk4(o2); } }
#undef EL_LD
        }
    } };

struct EpiLora2 { static constexpr bool PERM = false; const float* vb; unsigned char* ws;
    __device__ __forceinline__ void operator()(EPI_ARGS) const { bf16_t* G = (bf16_t*)(ws + WS_G); bf16_t* V = (bf16_t*)(ws + WS_V); const bf16_t* VF = (const bf16_t*)(ws + WS_VF);
        const int seg = u.pn / 3; const int j0 = (u.pn % 3) * 256 + wc * 32 + 4 * fq; const size_t row0 = (size_t)u.pm * 256 + wr * 64 + fr;
        if (seg == 0) {
            EPI_ROWS { const size_t ro = (size_t)EPI_ROW * RW;
#pragma unroll
                for (int x_ = 0; x_ < 4; ++x_) *(u32x2*)(G + ro + j0 + (x_ >> 1) * 128 + (x_ & 1) * 16) = pk4(acc[ai][x_ >> 1][m][x_ & 1]); }
        } else { f32x4 bq[4]; u32x2 vq[2][4], fq_[2][4];
#pragma unroll
            for (int x_ = 0; x_ < 4; ++x_) bq[x_] = *(const f32x4*)(vb + j0 + (x_ >> 1) * 128 + (x_ & 1) * 16);
#define E2_LD(rr, b_) do { const size_t ro_ = (row0 + ((rr) >> 2) * 128 + ((rr) & 3) * 16) * RW; _Pragma("unroll") for (int x_ = 0; x_ < 4; ++x_) { const int j_ = j0 + (x_ >> 1) * 128 + (x_ & 1) * 16; vq[b_][x_] = *(const u32x2*)(V + ro_ + j_); fq_[b_][x_] = *(const u32x2*)(VF + ro_ + j_); } } while (0)
            E2_LD(0, 0);
#pragma unroll
            for (int rr = 0; rr < 8; ++rr) { const int ai = rr >> 2, m = rr & 3; const size_t ro = (row0 + ai * 128 + m * 16) * RW;
                if (rr < 7) E2_LD(rr + 1, (rr + 1) & 1);
#pragma unroll
                for (int x_ = 0; x_ < 4; ++x_) { const int j = j0 + (x_ >> 1) * 128 + (x_ & 1) * 16; const f32x4 v = acc[ai][x_ >> 1][m][x_ & 1]; const f32x4 vv = up4(vq[rr & 1][x_]), vf = up4(fq_[rr & 1][x_]); f32x4 o;
#pragma unroll
                    for (int i = 0; i < 4; ++i) { const float g = sigmoidf_(bq[x_][i] + v[i]); o[i] = vv[i] + (vf[i] - vv[i]) * g; }
                    *(u32x2*)(V + ro + j) = pk4(o); } }
#undef E2_LD
        }
    } };

struct EpiLru { static constexpr bool PERM = false; const float* ba; const float* bx; const float* lam; unsigned char* ws;
    __device__ __forceinline__ void operator()(EPI_ARGS) const { bf16_t* LOGA = (bf16_t*)(ws + WS_LOGA); bf16_t* IG = (bf16_t*)(ws + WS_IG);
        const int gp = u.pn >> 2, q = u.pn & 3, b = q >> 1;
        f32x4 bias[2][2], sp8[2][2];
#pragma unroll
        for (int bj = 0; bj < 2; ++bj)
#pragma unroll
            for (int n = 0; n < 2; ++n) { const int kind = (q & 1) * 2 + bj, d = kind & 1; const int ch = (2 * gp + b) * 128 + wc * 32 + n * 16 + 4 * fq;
                bias[bj][n] = *(const f32x4*)((kind < 2 ? ba : bx) + d * LW + ch); const f32x4 lm = *(const f32x4*)(lam + d * LW + ch);
#pragma unroll
                for (int i = 0; i < 4; ++i) sp8[bj][n][i] = -8.0f * softplusf_(-lm[i]); }
        EPI_ROWS { const size_t ro = (size_t)EPI_ROW * LW;
#pragma unroll
            for (int bj = 0; bj < 2; ++bj)
#pragma unroll
                for (int n = 0; n < 2; ++n) { const int kind = (q & 1) * 2 + bj, d = kind & 1; const int ch = (2 * gp + b) * 128 + wc * 32 + n * 16 + 4 * fq; const f32x4 v = acc[ai][bj][m][n]; f32x4 o;
#pragma unroll
                    for (int i = 0; i < 4; ++i) { const float sg = sigmoidf_(v[i] + bias[bj][n][i]); o[i] = kind < 2 ? sg * sp8[bj][n][i] : sg; }
                    *(u32x2*)((kind < 2 ? LOGA : IG) + (size_t)d * T * LW + ro + ch) = pk4(o); } }
    } };

struct EpiMlaQ { static constexpr bool PERM = false; unsigned char* ws;
    __device__ __forceinline__ void operator()(EPI_ARGS) const { const float* COS = (const float*)(ws + WS_COS); const float* SIN = (const float*)(ws + WS_SIN); bf16_t* Q = (bf16_t*)(ws + WS_Q);
        EPI_ROWS { const int row = EPI_ROW; bf16_t* rowp = Q + (size_t)row * QW;
#pragma unroll
            for (int bj = 0; bj < 2; ++bj) { const int gb = u.pn * 256 + bj * 128 + wc * 32; const int cc = gb % 192;
                if (cc < 128) {
#pragma unroll
                    for (int n = 0; n < 2; ++n) { f32x4 v = acc[ai][bj][m][n]; v[0] *= QSCALE; v[1] *= QSCALE; v[2] *= QSCALE; v[3] *= QSCALE; *(u32x2*)(rowp + gb + n * 16 + 4 * fq) = pk4(v); }
                } else { const int g = (cc - 128) >> 5; const int j = 16 * g + 4 * fq; const f32x4 c = *(const f32x4*)(COS + (size_t)row * 32 + j), s = *(const f32x4*)(SIN + (size_t)row * 32 + j);
                    const f32x4 x1 = acc[ai][bj][m][0], x2 = acc[ai][bj][m][1]; f32x4 o1, o2;
#pragma unroll
                    for (int i = 0; i < 4; ++i) { o1[i] = (x1[i] * c[i] - x2[i] * s[i]) * QSCALE; o2[i] = (x1[i] * s[i] + x2[i] * c[i]) * QSCALE; }
                    *(u32x2*)(rowp + gb + 4 * fq) = pk4(o1); *(u32x2*)(rowp + gb + 16 + 4 * fq) = pk4(o2); } } }
    } };

struct EpiMerge { static constexpr bool PERM = true; unsigned char* ws; int step;
    __device__ __forceinline__ void operator()(EPI_ARGS) const { const bf16_t* HG = (const bf16_t*)(ws + WS_HG); bf16_t* MG = (bf16_t*)(ws + WS_MERGED);
        const int c0 = u.pn * 256 + wc * 32 + 8 * fq; const size_t row0 = (size_t)u.pm * 256 + wr * 64 + fr;
        u32x4 gq[2][2], pq[2][2];
#define EM_LD(rr, b_) do { const size_t row_ = row0 + ((rr) >> 2) * 128 + ((rr) & 3) * 16; _Pragma("unroll") for (int x_ = 0; x_ < 2; ++x_) { const int c_ = c0 + x_ * 128; \
            gq[b_][x_] = *(const u32x4*)(HG + row_ * HGW + step * DM + c_); pq[b_][x_] = step > 0 ? *(const u32x4*)(MG + row_ * DM + c_) : (u32x4){0u, 0u, 0u, 0u}; } } while (0)
        EM_LD(0, 0);
#pragma unroll
        for (int rr = 0; rr < 8; ++rr) { const int ai = rr >> 2, m = rr & 3; const size_t row = row0 + ai * 128 + m * 16;
            if (rr < 7) EM_LD(rr + 1, (rr + 1) & 1);
#pragma unroll
            for (int bj = 0; bj < 2; ++bj) { float g[8], p[8]; unpack8(gq[rr & 1][bj], g); unpack8(pq[rr & 1][bj], p); const f32x4 v0 = acc[ai][bj][m][0], v1 = acc[ai][bj][m][1]; float o[8];
#pragma unroll
                for (int i = 0; i < 4; ++i) { o[i] = v0[i] * g[i] + p[i]; o[4 + i] = v1[i] * g[4 + i] + p[4 + i]; }
                *(u32x4*)(MG + row * DM + c0 + bj * 128) = pack8(o); } }
#undef EM_LD
    } };

struct EpiWout { static constexpr bool PERM = false; float* X; float* Y;
    __device__ __forceinline__ void operator()(EPI_ARGS) const {
        const int c0 = u.pn * 256 + wc * 32 + 4 * fq; const size_t row0 = (size_t)u.pm * 256 + wr * 64 + fr;
        f32x4 xq[2][4];
#define EW_LD(rr, b_) do { const float* rp_ = X + (row0 + ((rr) >> 2) * 128 + ((rr) & 3) * 16) * DM + c0; _Pragma("unroll") for (int x_ = 0; x_ < 4; ++x_) xq[b_][x_] = *(const f32x4*)(rp_ + (x_ >> 1) * 128 + (x_ & 1) * 16); } while (0)
        EW_LD(0, 0);
#pragma unroll
        for (int rr = 0; rr < 8; ++rr) { const int ai = rr >> 2, m = rr & 3; float* rowq = Y + (row0 + ai * 128 + m * 16) * DM + c0;
            if (rr < 7) EW_LD(rr + 1, (rr + 1) & 1);
#pragma unroll
            for (int x_ = 0; x_ < 4; ++x_) *(f32x4*)(rowq + (x_ >> 1) * 128 + (x_ & 1) * 16) = xq[rr & 1][x_] + acc[ai][x_ >> 1][m][x_ & 1]; }
#undef EW_LD
    } };

struct EpiMoeUp { static constexpr bool PERM = false; unsigned char* ws;
    __device__ __forceinline__ void operator()(EPI_ARGS) const { bf16_t* HDN = (bf16_t*)(ws + WS_HDN);
        EPI_ROWS { bf16_t* rowp = HDN + (size_t)EPI_ROW * FF;
#pragma unroll
            for (int bj = 0; bj < 2; ++bj) { const int gb = u.pn * 256 + bj * 128 + wc * 32; const int jb = (gb >> 5) * 16 + 4 * fq; const f32x4 g = acc[ai][bj][m][0], uu = acc[ai][bj][m][1]; f32x4 o;
#pragma unroll
                for (int i = 0; i < 4; ++i) o[i] = g[i] * sigmoidf_(g[i]) * uu[i];
                *(u32x2*)(rowp + jb) = pk4(o); } }
    } };

struct EpiMoeDown { static constexpr bool PERM = true; unsigned char* ws;
    __device__ __forceinline__ void operator()(EPI_ARGS) const { const float* GATEV = (const float*)(ws + WS_GATEV); bf16_t* SLAB = (bf16_t*)(ws + WS_SLAB);
        const int c0 = u.pn * 256 + wc * 32 + 8 * fq; const size_t row0 = (size_t)u.pm * 256 + wr * 64 + fr; float gvv[8];
#pragma unroll
        for (int rr = 0; rr < 8; ++rr) gvv[rr] = GATEV[row0 + (rr >> 2) * 128 + (rr & 3) * 16];
#pragma unroll
        for (int rr = 0; rr < 8; ++rr) { const int ai = rr >> 2, m = rr & 3; const float gv = gvv[rr]; bf16_t* rowp = SLAB + (row0 + ai * 128 + m * 16) * DM + c0;
#pragma unroll
            for (int bj = 0; bj < 2; ++bj) { const f32x4 v0 = acc[ai][bj][m][0], v1 = acc[ai][bj][m][1];
                u32x4 w; w.x = pk2(v0[0] * gv, v0[1] * gv); w.y = pk2(v0[2] * gv, v0[3] * gv); w.z = pk2(v1[0] * gv, v1[1] * gv); w.w = pk2(v1[2] * gv, v1[3] * gv);
                *(u32x4*)(rowp + bj * 128) = w; } }
    } };

template <class Epi> __device__ __forceinline__ void run_gemm(const Frame& F, const Epi& E, const void* A, int lda, const void* B, int ldb, int K, int nM, int nN,
                                                              size_t am, size_t an, size_t bm, size_t bn, int ash, int bsh, int reps = 1) {
    AddrLin ad; ad.A = (const char*)A; ad.B = (const char*)B; ad.am = am; ad.an = an; ad.bm = bm; ad.bn = bn; ad.ash = ash; ad.bsh = bsh;
    OrderL S; S.init(nM, nN, F.G, F.bid, ad, reps);
    pg8::Gemm g; g.K = K; g.lda = lda; g.ldb = ldb;
    pg8::gemm_phase<Epi, OrderL, true, true>(F.lds, g, S, E, F.tid, F.wave);
}

__device__ __forceinline__ void ldrow8(const bf16_t* H, int t, int col, float (&f)[8]) {
    if (t < 0 || t >= T) {
#pragma unroll
        for (int i = 0; i < 8; ++i) f[i] = 0.f;
    } else unpack8(*(const u32x4*)(H + (size_t)t * H1W + col), f);
}
__device__ __forceinline__ u32x4 ldraw8(const bf16_t* H, int t, int col) { return (t < 0 || t >= T) ? (u32x4){0u, 0u, 0u, 0u} : *(const u32x4*)(H + (size_t)t * H1W + col); }
__device__ __forceinline__ void ldf8(const float* p, float (&f)[8]) { const f32x4 a = *(const f32x4*)p, b = *(const f32x4*)(p + 4); f[0] = a[0]; f[1] = a[1]; f[2] = a[2]; f[3] = a[3]; f[4] = b[0]; f[5] = b[1]; f[6] = b[2]; f[7] = b[3]; }
__device__ __forceinline__ float tanh_fast(float x) { return 1.0f - 2.0f * __builtin_amdgcn_rcpf(1.0f + __expf(2.0f * x)); }
__device__ __forceinline__ float gelu_tanh(float x) { const float u = 0.7978845608028654f * (x + 0.044715f * x * x * x); return x * __builtin_amdgcn_rcpf(1.0f + __expf(-2.0f * u)); }

__device__ __forceinline__ void phase_prep(const Frame& F, int l, int reps) {
    const bf16_t* H1 = wsp<bf16_t>(F, WS_H1);
    const float* mu = gin(F, I_MU) + (size_t)l * 2 * RWKV_COLS; const float* k_k = gin(F, I_KK) + l * RW;
    const float* cw = gin(F, I_CONVW) + (size_t)l * 4 * LW; const float* cb = gin(F, I_CONVB) + l * LW;
    const float* qn = gin(F, I_QN) + l * 384; const float* kvn = gin(F, I_KVN) + l * 128;
    bf16_t* R = wsp<bf16_t>(F, WS_R); bf16_t* K = wsp<bf16_t>(F, WS_K); bf16_t* V = wsp<bf16_t>(F, WS_V); bf16_t* VF = wsp<bf16_t>(F, WS_VF); bf16_t* KK = wsp<bf16_t>(F, WS_KK);
    bf16_t* AL = wsp<bf16_t>(F, WS_AL); bf16_t* XC = wsp<bf16_t>(F, WS_XC); bf16_t* GB = wsp<bf16_t>(F, WS_GB); bf16_t* AM = wsp<bf16_t>(F, WS_AM); bf16_t* KV = wsp<bf16_t>(F, WS_KV);
    const float* COS = wsp<float>(F, WS_COS); const float* SIN = wsp<float>(F, WS_SIN);
    const int lane = F.lane;
    for (int t_ = F.gw; t_ < T * reps; t_ += F.nw) { const int t = t_ % T;
        u32x4 rwp[6], rwv[6], rwn[6];
#pragma unroll
        for (int it = 0; it < 6; ++it) { const int q = it * 64 + lane; const int col = q < 336 ? q * 8 : 0; rwp[it] = ldraw8(H1, t, col); rwv[it] = ldraw8(H1, t - 1, col); rwn[it] = ldraw8(H1, t + 1, col); }
#pragma unroll
        for (int it = 0; it < 6; ++it) { const int q = it * 64 + lane; const bool on = q < 336; const int col = on ? q * 8 : 0;
            float p[8], pv[8], nx[8], m0[8], m1[8], o[8];
            unpack8(rwp[it], p); unpack8(rwv[it], pv); unpack8(rwn[it], nx); ldf8(mu + col, m0); ldf8(mu + RWKV_COLS + col, m1);
#pragma unroll
            for (int i = 0; i < 8; ++i) o[i] = p[i] + m0[i] * (pv[i] - p[i]) + m1[i] * (nx[i] - p[i]);
            const bool isk = on && col >= 768 && col < 1536; const int j = isk ? col - 768 : 0;
            float kw[8], x[8]; ldf8(k_k + j, kw); float ss = 0.f;
#pragma unroll
            for (int i = 0; i < 8; ++i) { x[i] = o[i] * kw[i]; ss += x[i] * x[i]; }
            ss += shx(ss, 1, lane); ss += shx(ss, 2, lane); ss += shx(ss, 4, lane);
            if (on) {
                if (col < 768) *(u32x4*)(R + (size_t)t * RW + col) = pack8(o);
                else if (col < 1536) { *(u32x4*)(K + (size_t)t * RW + j) = pack8(o); const float inv = 1.0f / fmaxf(sqrtf(ss), 1e-12f);
#pragma unroll
                    for (int i = 0; i < 8; ++i) x[i] *= inv;
                    *(u32x4*)(KK + (size_t)t * RW + j) = pack8(x); }
                else if (col < 2304) { const u32x4 w = pack8(o); *(u32x4*)(V + (size_t)t * RW + col - 1536) = w; if (l == 0) *(u32x4*)(VF + (size_t)t * RW + col - 1536) = w; }
                else { const int ac = col - 2304;
                    if (ac < 128) {
#pragma unroll
                        for (int i = 0; i < 8; ++i) o[i] = tanh_fast(o[i]);
                    } else if (ac >= 256) {
#pragma unroll
                        for (int i = 0; i < 8; ++i) o[i] = sigmoidf_(o[i]);
                    }
                    *(u32x4*)(AL + (size_t)t * 512 + ac) = pack8(o); }
            } }
        if (lane < 16) { u32x4 w = (u32x4){0u, 0u, 0u, 0u}; if (lane < 4 && l > 0) w = *(const u32x4*)(H1 + (size_t)t * H1W + 4800 + lane * 8); *(u32x4*)(AL + (size_t)t * 512 + 384 + lane * 8) = w; }
        u32x4 lr0[2], lr1[2], lr2[2], lr3[2], lgb[2], mq, mk;
#pragma unroll
        for (int it = 0; it < 2; ++it) { const int q = it * 64 + lane; const int c = q < 96 ? q * 8 : 0; lr0[it] = ldraw8(H1, t - 1, 2688 + c); lr1[it] = ldraw8(H1, t, 2688 + c); lr2[it] = ldraw8(H1, t + 1, 2688 + c); lr3[it] = ldraw8(H1, t + 2, 2688 + c); lgb[it] = ldraw8(H1, t, 3456 + c); }
        mq = ldraw8(H1, lane < 48 ? t : -1, 4224 + (lane < 48 ? lane * 8 : 0)); mk = ldraw8(H1, lane < 24 ? t : -1, 4608 + (lane < 24 ? lane * 8 : 0));
#pragma unroll
        for (int it = 0; it < 2; ++it) { const int q = it * 64 + lane;
            if (q < 96) { const int c = q * 8; float a0[8], a1[8], a2[8], a3[8], w0[8], w1[8], w2[8], w3[8], b[8], o[8];
                unpack8(lr0[it], a0); unpack8(lr1[it], a1); unpack8(lr2[it], a2); unpack8(lr3[it], a3);
                ldf8(cw + c, w0); ldf8(cw + LW + c, w1); ldf8(cw + 2 * LW + c, w2); ldf8(cw + 3 * LW + c, w3); ldf8(cb + c, b);
#pragma unroll
                for (int i = 0; i < 8; ++i) o[i] = b[i] + w0[i] * a0[i] + w1[i] * a1[i] + w2[i] * a2[i] + w3[i] * a3[i];
                *(u32x4*)(XC + (size_t)t * LW + c) = pack8(o);
                unpack8(lgb[it], a0);
#pragma unroll
                for (int i = 0; i < 8; ++i) o[i] = gelu_tanh(a0[i]);
                *(u32x4*)(GB + (size_t)t * LW + c) = pack8(o); } }
        { float p[8]; float ss = 0.f; const bool on = lane < 48; unpack8(mq, p);
#pragma unroll
          for (int i = 0; i < 8; ++i) ss += p[i] * p[i];
          ss = wave_sum(ss); const float rstd = rsqrtf(ss * (1.0f / 384.0f) + 1e-6f);
          if (on) { float g[8]; ldf8(qn + lane * 8, g);
#pragma unroll
              for (int i = 0; i < 8; ++i) p[i] = p[i] * rstd * g[i];
              *(u32x4*)(AM + (size_t)t * 384 + lane * 8) = pack8(p); } }
        { float p[8]; float ss = 0.f; const bool on = lane < 24; unpack8(mk, p);
          if (lane < 16) {
#pragma unroll
              for (int i = 0; i < 8; ++i) ss += p[i] * p[i]; }
          ss = wave_sum(ss); const float rstd = rsqrtf(ss * (1.0f / 128.0f) + 1e-6f);
          float oth[8];
#pragma unroll
          for (int i = 0; i < 8; ++i) oth[i] = shx(p[i], 4, lane);
          if (lane < 16) { float g[8]; ldf8(kvn + lane * 8, g);
#pragma unroll
              for (int i = 0; i < 8; ++i) p[i] = p[i] * rstd * g[i];
              *(u32x4*)(KV + (size_t)t * KVW + lane * 8) = pack8(p); }
          else if (lane < 24) { const int i4 = lane - 16, ii = i4 & 3; float c[8], s[8], o[8]; ldf8(COS + (size_t)t * 32 + ii * 8, c); ldf8(SIN + (size_t)t * 32 + ii * 8, s);
              if (i4 < 4) {
#pragma unroll
                  for (int i = 0; i < 8; ++i) o[i] = p[i] * c[i] - oth[i] * s[i];
                  *(u32x4*)(KV + (size_t)t * KVW + 128 + 32 * (ii >> 1) + 8 * (ii & 1)) = pack8(o);
              } else {
#pragma unroll
                  for (int i = 0; i < 8; ++i) o[i] = oth[i] * s[i] + p[i] * c[i];
                  *(u32x4*)(KV + (size_t)t * KVW + 128 + 32 * (ii >> 1) + 16 + 8 * (ii & 1)) = pack8(o);
              } } }
    }
}

__device__ __forceinline__ float ldbf(const bf16_t* p) { return bf2f((unsigned)*p); }
__device__ __forceinline__ void phase_lru_local(const Frame& F, int reps) {
    const bf16_t* LOGA = wsp<bf16_t>(F, WS_LOGA); const bf16_t* IG = wsp<bf16_t>(F, WS_IG); const bf16_t* XC = wsp<bf16_t>(F, WS_XC);
    float* LA = wsp<float>(F, WS_LA); float* LB = wsp<float>(F, WS_LB);
    for (int idx_ = F.bid * NTHR + F.tid; idx_ < 2 * NCH * LW * reps; idx_ += F.G * NTHR) { const int idx = idx_ % (2 * NCH * LW); const int ch = idx % LW, c = (idx / LW) % NCH, d = idx / (LW * NCH);
        float asum = 0.f, h = 0.f; const bf16_t* la = LOGA + (size_t)d * T * LW + ch; const bf16_t* ig = IG + (size_t)d * T * LW + ch;
        for (int s = 0; s < CL; ++s) { const int t = d == 0 ? c * CL + s : c * CL + CL - 1 - s; const float l_ = ldbf(la + (size_t)t * LW);
            const float a = __expf(l_), b = sqrtf(fmaxf(1.0f - a * a, 0.f)) * ldbf(ig + (size_t)t * LW) * ldbf(XC + (size_t)t * LW + ch); h = a * h + b; asum += l_; }
        LA[idx] = __expf(asum); LB[idx] = h; }
}
__device__ __forceinline__ void phase_lru_carry(const Frame& F, int bid0) {
    const float* LA = wsp<float>(F, WS_LA); const float* LB = wsp<float>(F, WS_LB); float* LH0 = wsp<float>(F, WS_LH0);
    const int idx = (F.bid - bid0) * NTHR + F.tid; if (idx < 0 || idx >= 2 * LW) return; const int ch = idx % LW, d = idx / LW; float h = 0.f;
    for (int k = 0; k < NCH; ++k) { const int c = d == 0 ? k : NCH - 1 - k; const int o = (d * NCH + c) * LW + ch; LH0[o] = h; h = LA[o] * h + LB[o]; }
}
__device__ __forceinline__ void phase_lru_out(const Frame& F, int reps) {
    const bf16_t* LOGA = wsp<bf16_t>(F, WS_LOGA); const bf16_t* IG = wsp<bf16_t>(F, WS_IG); const bf16_t* XC = wsp<bf16_t>(F, WS_XC); const bf16_t* GB = wsp<bf16_t>(F, WS_GB);
    const float* LH0 = wsp<float>(F, WS_LH0); bf16_t* YB = wsp<bf16_t>(F, WS_YB);
    static_assert(NCH * LW == 256 * 768, "lru_out deal");
    const bool bal = F.G == 256; const int gt0 = F.bid * NTHR + F.tid, gst = F.G * NTHR;
    const int nit = bal ? 2 * reps : (gt0 < NCH * LW * reps ? (NCH * LW * reps - gt0 + gst - 1) / gst : 0);
    for (int it_ = 0; it_ < nit; ++it_) { if (bal && (it_ & 1) && F.wave < 4) continue;
        const int idx = bal ? F.bid * 768 + ((it_ & 1) ? 256 + F.tid : F.tid) : (gt0 + it_ * gst) % (NCH * LW); const int ch = idx % LW, c = idx / LW; float hf[CL];
        { float h = LH0[(0 * NCH + c) * LW + ch]; int o0 = c * CL * LW + ch; asm volatile("" : "+v"(o0)); const bf16_t* pl = LOGA + o0; const bf16_t* pi = IG + o0; const bf16_t* px = XC + o0;
#pragma unroll
          for (int s = 0; s < CL; ++s) { const float l_ = ldbf(pl + s * LW); const float a = __expf(l_), b = sqrtf(fmaxf(1.0f - a * a, 0.f)) * ldbf(pi + s * LW) * ldbf(px + s * LW); h = a * h + b; hf[s] = h; } }
        { float h = LH0[(1 * NCH + c) * LW + ch]; int o0 = c * CL * LW + ch; asm volatile("" : "+v"(o0)); const bf16_t* pl = LOGA + (size_t)T * LW + o0; const bf16_t* pi = IG + (size_t)T * LW + o0; const bf16_t* px = XC + o0; const bf16_t* pg = GB + o0; bf16_t* py = YB + o0;
#pragma unroll
          for (int sg = CL - 8; sg >= 0; sg -= 8) { float lv[8], iv[8], xv[8], gv[8];
#pragma unroll
              for (int q = 0; q < 8; ++q) { lv[q] = ldbf(pl + (sg + q) * LW); iv[q] = ldbf(pi + (sg + q) * LW); xv[q] = ldbf(px + (sg + q) * LW); gv[q] = ldbf(pg + (sg + q) * LW); }
#pragma unroll
              for (int q = 7; q >= 0; --q) { const int s = sg + q; const float a = __expf(lv[q]), b = sqrtf(fmaxf(1.0f - a * a, 0.f)) * iv[q] * xv[q]; h = a * h + b;
                  py[s * LW] = (bf16_t)f2bf((hf[s] + h) * gv[q]); } } } }
}

namespace wy {
constexpr int RS = 144, MSZ = 64 * RS;
constexpr int O_KK = 0, O_BT = MSZ, O_KT = 2 * MSZ, O_RT = 3 * MSZ, O_BH = 4 * MSZ, O_KH = 5 * MSZ, O_V = 6 * MSZ, O_KKT = 7 * MSZ, O_AKB = 8 * MSZ, O_ABR = 9 * MSZ, O_AT = 10 * MSZ, O_A = 11 * MSZ, O_S12 = 12 * MSZ,
              O_TOT = O_S12, O_GAM = 13 * MSZ, O_END = O_GAM + 256;
constexpr int O_D = O_BT, O_DT = O_KT, O_UT = O_KK, O_M32 = O_AT, O_M32T = O_S12, O_M64T = O_BT, O_P = O_KT, O_Q = O_A, O_ZY = O_KKT, O_X1 = O_AKB;
static_assert(O_END <= 131072, "wy lds");
__device__ __forceinline__ int crow(int r, int hi) { return (r & 3) + 8 * (r >> 2) + 4 * hi; }
__device__ __forceinline__ f32x16 tile_mm(const LAS char* Aop, int m0, const LAS char* Bop, int n0, int lane) {
    f32x16 acc = (f32x16)(0.f); const int r = lane & 31, hh = lane >> 5;
#pragma unroll
    for (int ks = 0; ks < 4; ++ks) { const bf16x8 a = *(const LAS bf16x8*)(Aop + (m0 + r) * RS + (ks * 16 + hh * 8) * 2), b = *(const LAS bf16x8*)(Bop + (n0 + r) * RS + (ks * 16 + hh * 8) * 2);
        acc = __builtin_amdgcn_mfma_f32_32x32x16_bf16(a, b, acc, 0, 0, 0); }
    return acc;
}
__device__ __forceinline__ void store_t_bf16(LAS char* dst, const f32x16& c, int m0, int n0, int lane) {
    LAS char* p = dst + (n0 + (lane & 31)) * RS + (m0 + 4 * (lane >> 5)) * 2;
#pragma unroll
    for (int g = 0; g < 4; ++g) { u32x2 w; w.x = pk2(c[4 * g], c[4 * g + 1]); w.y = pk2(c[4 * g + 2], c[4 * g + 3]); *(LAS u32x2*)(p + 16 * g) = w; }
}
__device__ __forceinline__ void store_n_bf16(LAS char* dst, const f32x16& c, int m0, int n0, int lane) {
    LAS char* p = dst + (m0 + 4 * (lane >> 5)) * RS + (n0 + (lane & 31)) * 2;
#pragma unroll
    for (int r = 0; r < 16; ++r) *(LAS bf16_t*)(p + ((r & 3) + 8 * (r >> 2)) * RS) = (bf16_t)f2bf(c[r]);
}
__device__ __forceinline__ f32x16 load_acc_from_t(const LAS char* xt, int m0, int n0, int lane) {
    f32x16 v; const LAS char* p = xt + (n0 + (lane & 31)) * RS + (m0 + 4 * (lane >> 5)) * 2;
#pragma unroll
    for (int g = 0; g < 4; ++g) { const f32x4 t4 = up4(*(const LAS u32x2*)(p + 16 * g)); v[4 * g] = t4[0]; v[4 * g + 1] = t4[1]; v[4 * g + 2] = t4[2]; v[4 * g + 3] = t4[3]; }
    return v;
}
}

__device__ __forceinline__ void phase_rwkv_local(const Frame& F, int reps) {
    using namespace wy;
    const bf16_t* E = wsp<bf16_t>(F, WS_E); const bf16_t* BV = wsp<bf16_t>(F, WS_BV); const bf16_t* KKg = wsp<bf16_t>(F, WS_KK); const bf16_t* KD = wsp<bf16_t>(F, WS_KD); const bf16_t* V = wsp<bf16_t>(F, WS_V); const bf16_t* R = wsp<bf16_t>(F, WS_R);
    bf16_t* AF = wsp<bf16_t>(F, WS_AF); float* GT = wsp<float>(F, WS_GT); bf16_t* WY = wsp<bf16_t>(F, WS_WY); float* YF = wsp<float>(F, WS_YF);
    LAS char* L = (LAS char*)F.lds;
    for (int task_ = F.bid; task_ < 2 * NH * NCH * reps; task_ += F.G) { const int task = task_ % (2 * NH * NCH); const int c = task % NCH, hd = task / NCH, h = hd % NH, d = hd / NH;
        int tid = F.tid; asm volatile("" : "+v"(tid)); const int lane = tid & 63, wv = F.wave;
        { const int j = tid & 63, sb = tid >> 6; float ev[8], bb[8], kkv[8], kv[8], rv[8], vv[8], lg[8];
          const size_t od = (size_t)d * T * RW;
#pragma unroll
          for (int q = 0; q < 8; ++q) { const int s_ = 8 * sb + q; const int tt = d == 0 ? c * CL + s_ : c * CL + CL - 1 - s_; const size_t o = (size_t)tt * RW + h * HD + j;
              ev[q] = ldbf(E + od + o); bb[q] = ldbf(BV + od + o); kkv[q] = ldbf(KKg + o); kv[q] = ldbf(KD + od + o); rv[q] = ldbf(R + o); vv[q] = ldbf(V + o); }
          float run = 0.f;
#pragma unroll
          for (int q = 0; q < 8; ++q) { run += ev[q]; lg[q] = run; }
          LAS float* tot = (LAS float*)(L + O_TOT); tot[sb * 64 + j] = run;
          __syncthreads();
          float offs = 0.f, total = 0.f;
#pragma unroll
          for (int q = 0; q < 8; ++q) { const float t_ = tot[q * 64 + j]; total += t_; offs += (q < sb) ? t_ : 0.f; }
          float fkk[8], fbh[8], fkh[8];
#pragma unroll
          for (int q = 0; q < 8; ++q) { const int s_ = 8 * sb + q; const float lgq = lg[q] + offs; const float gi = __expf(-lgq), gl = __expf(total - lgq);
              fkk[q] = kkv[q] * __expf(lgq - ev[q]); fbh[q] = bb[q] * gl; fkh[q] = kv[q] * gl;
              *(LAS bf16_t*)(L + O_KK + s_ * RS + j * 2) = (bf16_t)f2bf(fkk[q]); *(LAS bf16_t*)(L + O_BT + s_ * RS + j * 2) = (bf16_t)f2bf(bb[q] * gi);
              *(LAS bf16_t*)(L + O_KT + s_ * RS + j * 2) = (bf16_t)f2bf(kv[q] * gi); *(LAS bf16_t*)(L + O_RT + s_ * RS + j * 2) = (bf16_t)f2bf(rv[q] * __expf(lgq)); }
          *(LAS u32x4*)(L + O_BH + j * RS + sb * 16) = pack8(fbh); *(LAS u32x4*)(L + O_KH + j * RS + sb * 16) = pack8(fkh);
          *(LAS u32x4*)(L + O_V + j * RS + sb * 16) = pack8(vv); *(LAS u32x4*)(L + O_KKT + j * RS + sb * 16) = pack8(fkk);
          if (sb == 0) ((LAS float*)(L + O_GAM))[j] = __expf(total);
        }
        __syncthreads();
        const int M0 = 32 * (wv & 1), N0 = 32 * ((wv >> 1) & 1), hh = lane >> 5, ln = lane & 31;
        f32x16 akr = (f32x16)(0.f);
        if (wv < 4) {
            { f32x16 cc = tile_mm(L + O_BT, M0, L + O_KK, N0, lane);
#pragma unroll
              for (int r = 0; r < 16; ++r) cc[r] = (M0 + crow(r, hh) < N0 + ln) ? cc[r] : 0.f;
              store_t_bf16(L + O_AT, cc, M0, N0, lane); store_n_bf16(L + O_A, cc, M0, N0, lane); }
            { f32x16 cc = tile_mm(L + O_KK, M0, L + O_KT, N0, lane);
#pragma unroll
              for (int r = 0; r < 16; ++r) cc[r] = (N0 + ln < M0 + crow(r, hh)) ? cc[r] : 0.f;
              store_t_bf16(L + O_AKB, cc, M0, N0, lane); }
        } else {
            { f32x16 cc = tile_mm(L + O_BT, M0, L + O_RT, N0, lane);
#pragma unroll
              for (int r = 0; r < 16; ++r) cc[r] = (M0 + crow(r, hh) <= N0 + ln) ? cc[r] : 0.f;
              store_t_bf16(L + O_ABR, cc, M0, N0, lane); }
            { akr = tile_mm(L + O_KT, M0, L + O_RT, N0, lane);
#pragma unroll
              for (int r = 0; r < 16; ++r) akr[r] = (M0 + crow(r, hh) <= N0 + ln) ? akr[r] : 0.f; }
        }
        __syncthreads();
        if (wv == 0) {
            const int b = lane >> 4, r = lane & 15; float x[16];
#pragma unroll
            for (int t = 0; t < 16; ++t) { const LAS char* cp = L + O_AT + (16 * b + t) * RS + 32 * b; float c[16]; { float f[8]; unpack8(*(const LAS u32x4*)cp, f);
#pragma unroll
                    for (int i = 0; i < 8; ++i) c[i] = f[i]; unpack8(*(const LAS u32x4*)(cp + 16), f);
#pragma unroll
                    for (int i = 0; i < 8; ++i) c[8 + i] = f[i]; }
                float a = (t == r) ? 1.f : 0.f;
#pragma unroll
                for (int q = 0; q < t; ++q) a -= x[q] * c[q];
                x[t] = a; }
            LAS char* dp = L + O_D + (16 * b + r) * RS;
#pragma unroll
            for (int q = 0; q < 8; ++q) { const unsigned z0_ = vzero(); u32x4 w = (u32x4){z0_, z0_, z0_, z0_}; if (q == 2 * b) { float f[8];
#pragma unroll
                    for (int i = 0; i < 8; ++i) f[i] = x[i]; w = pack8(f); }
                if (q == 2 * b + 1) { float f[8];
#pragma unroll
                    for (int i = 0; i < 8; ++i) f[i] = x[8 + i]; w = pack8(f); }
                *(LAS u32x4*)(dp + 16 * q) = w; }
        } else if (wv == 1) {
            const int b = lane >> 4, r = lane & 15; float y[16];
#pragma unroll
            for (int t = 15; t >= 0; --t) { const LAS char* cp = L + O_A + (16 * b + t) * RS + 32 * b; float c[16]; { float f[8]; unpack8(*(const LAS u32x4*)cp, f);
#pragma unroll
                    for (int i = 0; i < 8; ++i) c[i] = f[i]; unpack8(*(const LAS u32x4*)(cp + 16), f);
#pragma unroll
                    for (int i = 0; i < 8; ++i) c[8 + i] = f[i]; }
                float a = (t == r) ? 1.f : 0.f;
#pragma unroll
                for (int q = t + 1; q < 16; ++q) a -= y[q] * c[q];
                y[t] = a; }
            LAS char* dp = L + O_DT + (16 * b + r) * RS;
#pragma unroll
            for (int q = 0; q < 8; ++q) { const unsigned z0_ = vzero(); u32x4 w = (u32x4){z0_, z0_, z0_, z0_}; if (q == 2 * b) { float f[8];
#pragma unroll
                    for (int i = 0; i < 8; ++i) f[i] = y[i]; w = pack8(f); }
                if (q == 2 * b + 1) { float f[8];
#pragma unroll
                    for (int i = 0; i < 8; ++i) f[i] = y[8 + i]; w = pack8(f); }
                *(LAS u32x4*)(dp + 16 * q) = w; }
        }
        __syncthreads();
        if (wv < 4) { f32x16 cc = (f32x16)(0.f);
            if (M0 == N0) { cc = tile_mm(L + O_A, M0, L + O_DT, N0, lane);
#pragma unroll
                for (int r = 0; r < 16; ++r) cc[r] = (((M0 + crow(r, hh)) ^ (N0 + ln)) & 16) ? cc[r] : 0.f; }
            store_t_bf16(L + O_UT, cc, M0, N0, lane); }
        __syncthreads();
        if (wv < 4) { f32x16 cc = tile_mm(L + O_D, M0, L + O_UT, N0, lane); const f32x16 dd = load_acc_from_t(L + O_DT, M0, N0, lane);
#pragma unroll
            for (int r = 0; r < 16; ++r) cc[r] = dd[r] - cc[r];
            store_n_bf16(L + O_M32, cc, M0, N0, lane); store_t_bf16(L + O_M32T, cc, M0, N0, lane); }
        __syncthreads();
        if (wv < 4) { f32x16 cc = (f32x16)(0.f);
            if (M0 == 0 && N0 == 32) cc = tile_mm(L + O_A, M0, L + O_M32T, N0, lane);
            store_t_bf16(L + O_UT, cc, M0, N0, lane); }
        __syncthreads();
        if (wv < 4) { f32x16 cc = tile_mm(L + O_M32, M0, L + O_UT, N0, lane); const f32x16 mm_ = load_acc_from_t(L + O_M32T, M0, N0, lane);
#pragma unroll
            for (int r = 0; r < 16; ++r) cc[r] = mm_[r] - cc[r];
            store_t_bf16(L + O_M64T, cc, M0, N0, lane); }
        __syncthreads();
        { const f32x16 cc = tile_mm(L + (wv < 4 ? O_KKT : O_AKB), M0, L + O_M64T, N0, lane);
          store_n_bf16(L + (wv < 4 ? O_P : O_Q), cc, M0, N0, lane); }
        __syncthreads();
        if (wv < 4) {
            { const f32x16 cc = tile_mm(L + O_P, M0, L + O_ABR, N0, lane);
              const LAS char* rp = L + O_RT + (N0 + ln) * RS + (M0 + 4 * hh) * 2; bf16_t* wp = WY + (size_t)task * 4096 + (N0 + ln) * 64 + M0 + 4 * hh;
#pragma unroll
              for (int g = 0; g < 4; ++g) { const f32x4 rt = up4(*(const LAS u32x2*)(rp + 16 * g)); u32x2 w; w.x = pk2(rt[0] - cc[4 * g], rt[1] - cc[4 * g + 1]); w.y = pk2(rt[2] - cc[4 * g + 2], rt[3] - cc[4 * g + 3]);
                  *(u32x2*)(wp + 8 * g) = w; } }
            { f32x16 cc = tile_mm(L + O_P, M0, L + O_BH, N0, lane);
              const float gm = ((const LAS float*)(L + O_GAM))[N0 + ln];
#pragma unroll
              for (int r = 0; r < 16; ++r) cc[r] = ((M0 + crow(r, hh) == N0 + ln) ? gm : 0.f) - cc[r];
              const int J = M0 >> 5, Jp = N0 >> 5;
#pragma unroll
              for (int s2 = 0; s2 < 2; ++s2) { u32x4 w; w.x = pk2(cc[8 * s2], cc[8 * s2 + 1]); w.y = pk2(cc[8 * s2 + 2], cc[8 * s2 + 3]); w.z = pk2(cc[8 * s2 + 4], cc[8 * s2 + 5]); w.w = pk2(cc[8 * s2 + 6], cc[8 * s2 + 7]);
                  *(u32x4*)(AF + (size_t)task * 4096 + (size_t)((((Jp * 2 + J) * 2 + s2) * 64 + lane) * 8)) = w; } }
        } else {
            { f32x16 cc = tile_mm(L + O_Q, M0, L + O_ABR, N0, lane);
#pragma unroll
              for (int r = 0; r < 16; ++r) cc[r] = akr[r] - cc[r];
              store_t_bf16(L + O_ZY, cc, M0, N0, lane); }
            { f32x16 cc = tile_mm(L + O_Q, M0, L + O_BH, N0, lane);
              const LAS char* kp = L + O_KH + (N0 + ln) * RS + (M0 + 4 * hh) * 2;
#pragma unroll
              for (int g = 0; g < 4; ++g) { const f32x4 kh = up4(*(const LAS u32x2*)(kp + 16 * g)); cc[4 * g] = kh[0] - cc[4 * g]; cc[4 * g + 1] = kh[1] - cc[4 * g + 1]; cc[4 * g + 2] = kh[2] - cc[4 * g + 2]; cc[4 * g + 3] = kh[3] - cc[4 * g + 3]; }
              store_t_bf16(L + O_X1, cc, M0, N0, lane); }
        }
        __syncthreads();
        if (wv < 4) { const f32x16 cc = tile_mm(L + O_X1, M0, L + O_V, N0, lane);
            float* gp = GT + (size_t)task * 4096 + (size_t)(((N0 >> 5) * 2 + (M0 >> 5)) * 16) * 64 + lane;
#pragma unroll
            for (int r = 0; r < 16; ++r) gp[r * 64] = cc[r];
        } else { const f32x16 cc = tile_mm(L + O_V, M0, L + O_ZY, N0, lane);
            const int s_ = N0 + ln; const int tt = d == 0 ? c * CL + s_ : c * CL + CL - 1 - s_; float* yp = YF + (size_t)d * T * RW + (size_t)tt * RW + h * HD + M0 + 4 * hh;
#pragma unroll
            for (int g = 0; g < 4; ++g) *(f32x4*)(yp + 8 * g) = (f32x4){cc[4 * g], cc[4 * g + 1], cc[4 * g + 2], cc[4 * g + 3]}; }
        __syncthreads();
    }
}

__device__ __forceinline__ void phase_rwkv_carry(const Frame& F, bool dry) {
    if (F.bid >= 48) return;
    const int hd = F.bid >> 1, I = F.bid & 1, d = hd / NH, lane = F.lane, wv = F.wave;
    const bf16_t* AF = wsp<bf16_t>(F, WS_AF); float* GT = wsp<float>(F, WS_GT);
    LAS char* ring = (LAS char*)F.lds;
    const bool ld = wv >= 1 && wv <= 4;
#define RC_DMA(k_, sl_) do { const int c_ = d == 0 ? (k_) : NCH - 1 - (k_); const size_t tix_ = (size_t)hd * NCH + c_; \
        _Pragma("unroll") for (int i_ = 0; i_ < 4; ++i_) { const int p_ = (wv - 1) * 4 + i_; \
            const char* g_ = p_ < 8 ? (const char*)AF + tix_ * 8192 + p_ * 1024 : (const char*)GT + tix_ * 16384 + I * 8192 + (p_ - 8) * 1024; \
            __builtin_amdgcn_global_load_lds((const unsigned*)(g_ + lane * 16), (LAS unsigned*)(ring + (sl_) * 16384 + p_ * 1024), 16, 0, 0); } } while (0)
#define RC_BAR() do { asm volatile("" ::: "memory"); __builtin_amdgcn_sched_barrier(0); __builtin_amdgcn_s_barrier(); __builtin_amdgcn_sched_barrier(0); asm volatile("" ::: "memory"); } while (0)
    constexpr int RC_NS = 6;
    if (ld) { RC_DMA(0, 0); RC_DMA(1, 1); RC_DMA(2, 2); RC_DMA(3, 3); RC_DMA(4, 4); asm volatile("s_waitcnt vmcnt(16)" ::: "memory"); }
    RC_BAR();
    bf16x8 bfr[2][2];
#pragma unroll
    for (int J = 0; J < 2; ++J)
#pragma unroll
        for (int s = 0; s < 2; ++s) bfr[J][s] = (bf16x8)(0);
    int cur = 0;
#pragma unroll 1
    for (int k = 0; k < NCH; ++k) {
        const int nx2 = cur == 0 ? RC_NS - 1 : cur - 1;
        if (ld) { if (k + RC_NS - 1 < NCH) { RC_DMA(k + RC_NS - 1, nx2); asm volatile("s_waitcnt vmcnt(16)" ::: "memory"); } else asm volatile("s_waitcnt vmcnt(0)" ::: "memory"); }
        if (wv == 0) {
            const int c = d == 0 ? k : NCH - 1 - k; const size_t tix = (size_t)hd * NCH + c;
            const LAS char* sl = ring + cur * 16384;
            u32x4 a[8]; f32x16 nw[2];
#pragma unroll
            for (int f_ = 0; f_ < 8; ++f_) a[f_] = *(const LAS u32x4*)(sl + (f_ * 64 + lane) * 16);
#pragma unroll
            for (int Jp = 0; Jp < 2; ++Jp)
#pragma unroll
                for (int r = 0; r < 16; ++r) nw[Jp][r] = *(const LAS float*)(sl + 8192 + ((Jp * 16 + r) * 64 + lane) * 4);
#pragma unroll
            for (int Jp = 0; Jp < 2; ++Jp)
#pragma unroll
                for (int J = 0; J < 2; ++J)
#pragma unroll
                    for (int s = 0; s < 2; ++s) nw[Jp] = __builtin_amdgcn_mfma_f32_32x32x16_bf16(__builtin_bit_cast(bf16x8, a[(Jp * 2 + J) * 2 + s]), bfr[J][s], nw[Jp], 0, 0, 0);
            u32x4* sp = (u32x4*)((char*)(dry ? wsp<float>(F, WS_XN) + (tix & 2047) * 4096 : GT + tix * 4096) + I * 8192);
#pragma unroll
            for (int J = 0; J < 2; ++J)
#pragma unroll
                for (int s = 0; s < 2; ++s) { u32x4 w; w.x = pk2(nw[J][8 * s + 0], nw[J][8 * s + 1]); w.y = pk2(nw[J][8 * s + 2], nw[J][8 * s + 3]); w.z = pk2(nw[J][8 * s + 4], nw[J][8 * s + 5]); w.w = pk2(nw[J][8 * s + 6], nw[J][8 * s + 7]);
                    bfr[J][s] = __builtin_bit_cast(bf16x8, w); sp[(2 * J + s) * 64 + lane] = w; }
        }
        RC_BAR();
        cur = cur == RC_NS - 1 ? 0 : cur + 1;
    }
#undef RC_DMA
#undef RC_BAR
}

__device__ __forceinline__ float half_swap_sum(float v) { auto r = __builtin_amdgcn_permlane32_swap(__float_as_uint(v), __float_as_uint(v), false, false); return __uint_as_float(r[0]) + __uint_as_float(r[1]); }
__device__ __forceinline__ void phase_rwkv_outfin(const Frame& F, int l, int reps) {
    const float* GT = wsp<float>(F, WS_GT); const bf16_t* WY = wsp<bf16_t>(F, WS_WY); const float* YF = wsp<float>(F, WS_YF);
    const bf16_t* R = wsp<bf16_t>(F, WS_R); const bf16_t* KD = wsp<bf16_t>(F, WS_KD); const bf16_t* V = wsp<bf16_t>(F, WS_V); const bf16_t* G = wsp<bf16_t>(F, WS_G); bf16_t* YA = wsp<bf16_t>(F, WS_YA);
    const float* rk = gin(F, I_RK) + l * RW; const float* lw = gin(F, I_LNW) + l * RW; const float* lb = gin(F, I_LNB) + l * RW;
    static_assert(NH * NCH == 256 * 12, "outfin deal");
    const bool bal = F.G == 256;
    const int nit = bal ? 2 * reps : (F.gw < NH * NCH * reps ? (NH * NCH * reps - F.gw + F.nw - 1) / F.nw : 0);
    for (int it_ = 0; it_ < nit; ++it_) { if (bal && (it_ & 1) && F.wave >= 4) continue;
        const int task = bal ? F.bid * 12 + (it_ & 1) * 8 + F.wave : (F.gw + it_ * F.nw) % (NH * NCH); const int c = task % NCH, h = task / NCH;
        int lane = F.lane; asm volatile("" : "+v"(lane)); const int ln = lane & 31, hh = lane >> 5;
        f32x16 acc[2][2];
#pragma unroll
        for (int mb = 0; mb < 2; ++mb)
#pragma unroll
            for (int nb = 0; nb < 2; ++nb) acc[mb][nb] = (f32x16)(0.f);
#pragma unroll
        for (int d = 0; d < 2; ++d) { const int hd = d * NH + h; const int cs = d == 0 ? c - 1 : c + 1;
            if (cs >= 0 && cs < NCH) { const float* S0 = GT + ((size_t)hd * NCH + cs) * 4096; const bf16_t* wy = WY + ((size_t)hd * NCH + c) * 4096;
                bf16x8 af[2][4], bfr[2][4];
#pragma unroll
                for (int mb = 0; mb < 2; ++mb)
#pragma unroll
                    for (int ks = 0; ks < 4; ++ks) { af[mb][ks] = *(const bf16x8*)((const char*)S0 + mb * 8192 + (ks * 64 + lane) * 16);
                        const int p = mb * 32 + ln; const int srow = d == 0 ? p : CL - 1 - p; const bf16_t* wr = wy + srow * 64 + ks * 16 + 4 * hh;
                        const u32x2 w0 = *(const u32x2*)wr, w1 = *(const u32x2*)(wr + 8); bfr[mb][ks] = __builtin_bit_cast(bf16x8, (u32x4){w0.x, w0.y, w1.x, w1.y}); }
#pragma unroll
                for (int mb = 0; mb < 2; ++mb)
#pragma unroll
                    for (int nb = 0; nb < 2; ++nb)
#pragma unroll
                        for (int ks = 0; ks < 4; ++ks) acc[mb][nb] = __builtin_amdgcn_mfma_f32_32x32x16_bf16(af[mb][ks], bfr[nb][ks], acc[mb][nb], 0, 0, 0); } }
        LAS char* slab = (LAS char*)(F.lds + F.wave * 9216);
        const int fr_ = lane >> 4, fc_ = lane & 15, br_ = lane >> 3, bc_ = lane & 7;
#define OF_LDF(dst, base, t0) do { _Pragma("unroll") for (int k_ = 0; k_ < 8; ++k_) dst[k_] = *(const u32x4*)((base) + (size_t)((t0) + k_ * 4 + fr_) * RW + h * HD + fc_ * 4); } while (0)
#define OF_STF(src) do { _Pragma("unroll") for (int k_ = 0; k_ < 8; ++k_) *(LAS u32x4*)(slab + (k_ * 4 + fr_) * 272 + fc_ * 16) = src[k_]; } while (0)
#define OF_LDB(dst, base, t0) do { _Pragma("unroll") for (int k_ = 0; k_ < 4; ++k_) dst[k_] = *(const u32x4*)((base) + (size_t)((t0) + k_ * 8 + br_) * RW + h * HD + bc_ * 8); } while (0)
#define OF_STB(src, off) do { _Pragma("unroll") for (int k_ = 0; k_ < 4; ++k_) *(LAS u32x4*)(slab + (off) + (k_ * 8 + br_) * 144 + bc_ * 16) = src[k_]; } while (0)
#define OF_RDF(mb_, g_) (*(const LAS f32x4*)(slab + ln * 272 + ((mb_) * 32 + 8 * (g_) + 4 * hh) * 4))
#define OF_RDB(off, mb_, g_) up4(*(const LAS u32x2*)(slab + (off) + ln * 144 + ((mb_) * 32 + 8 * (g_) + 4 * hh) * 2))
#pragma unroll
        for (int nb = 0; nb < 2; ++nb) { const int t0 = c * CL + nb * 32;
            u32x4 fa[8], fb[8], ba[4], bb[4];
            OF_LDF(fa, YF, t0); OF_LDF(fb, YF + (size_t)T * RW, t0);
            float s1 = 0.f, sb = 0.f;
            OF_STF(fa); OF_LDB(ba, KD, t0); OF_LDB(bb, KD + (size_t)T * RW, t0);
#pragma unroll
            for (int mb = 0; mb < 2; ++mb)
#pragma unroll
                for (int g = 0; g < 4; ++g) { const f32x4 y0 = OF_RDF(mb, g);
#pragma unroll
                    for (int e = 0; e < 4; ++e) acc[mb][nb][4 * g + e] += y0[e]; }
            OF_STF(fb);
#pragma unroll
            for (int mb = 0; mb < 2; ++mb)
#pragma unroll
                for (int g = 0; g < 4; ++g) { const f32x4 y1 = OF_RDF(mb, g);
#pragma unroll
                    for (int e = 0; e < 4; ++e) { const float y = acc[mb][nb][4 * g + e] + y1[e]; acc[mb][nb][4 * g + e] = y; s1 += y; } }
            OF_STB(ba, 0); OF_STB(bb, 4608); OF_LDB(ba, R, t0); OF_LDB(bb, V, t0);
            f32x4 ks[2][4];
#pragma unroll
            for (int mb = 0; mb < 2; ++mb)
#pragma unroll
                for (int g = 0; g < 4; ++g) { const f32x4 k0 = OF_RDB(0, mb, g), k1 = OF_RDB(4608, mb, g); ks[mb][g] = k0 + k1; }
            OF_STB(ba, 0); OF_STB(bb, 4608); OF_LDB(ba, G, t0);
            u32x2 vraw[2][4];
#pragma unroll
            for (int mb = 0; mb < 2; ++mb)
#pragma unroll
                for (int g = 0; g < 4; ++g) { const int j = h * HD + 4 * hh + mb * 32 + 8 * g; const f32x4 rr = OF_RDB(0, mb, g), rkk = *(const f32x4*)(rk + j); vraw[mb][g] = *(const LAS u32x2*)(slab + 4608 + ln * 144 + (mb * 32 + 8 * g + 4 * hh) * 2);
#pragma unroll
                    for (int e = 0; e < 4; ++e) sb += rr[e] * ks[mb][g][e] * rkk[e]; }
            const float mu = half_swap_sum(s1) * (1.0f / 64.0f), bon = half_swap_sum(sb);
            float s2 = 0.f;
#pragma unroll
            for (int mb = 0; mb < 2; ++mb)
#pragma unroll
                for (int r = 0; r < 16; ++r) { const float dl = acc[mb][nb][r] - mu; s2 += dl * dl; }
            const float rstd = rsqrtf(half_swap_sum(s2) * (1.0f / 64.0f) + 64e-5f);
            OF_STB(ba, 0);
            f32x4 ovv[2][4];
#pragma unroll
            for (int mb = 0; mb < 2; ++mb)
#pragma unroll
                for (int g = 0; g < 4; ++g) { const int j = h * HD + 4 * hh + mb * 32 + 8 * g; const f32x4 vv = up4(vraw[mb][g]), gg = OF_RDB(0, mb, g), w4 = *(const f32x4*)(lw + j), b4 = *(const f32x4*)(lb + j);
#pragma unroll
                    for (int e = 0; e < 4; ++e) ovv[mb][g][e] = ((acc[mb][nb][4 * g + e] - mu) * rstd * w4[e] + b4[e] + bon * vv[e]) * gg[e]; }
#pragma unroll
            for (int mb = 0; mb < 2; ++mb)
#pragma unroll
                for (int g = 0; g < 4; ++g) *(LAS u32x2*)(slab + 4608 + ln * 144 + (mb * 32 + 8 * g + 4 * hh) * 2) = pk4(ovv[mb][g]);
#pragma unroll
            for (int k_ = 0; k_ < 4; ++k_) *(u32x4*)(YA + (size_t)(t0 + k_ * 8 + br_) * RW + h * HD + bc_ * 8) = *(const LAS u32x4*)(slab + 4608 + (k_ * 8 + br_) * 144 + bc_ * 16);
        }
#undef OF_LDF
#undef OF_STF
#undef OF_LDB
#undef OF_STB
#undef OF_RDF
#undef OF_RDB
    }
}

namespace att {
constexpr int KN_B = 16384, KR_B = 8192, V_B = 16384, BUF_B = KN_B + KR_B + V_B;
constexpr int SCR_OFF = 2 * BUF_B;
constexpr float THR2 = 10.0f;
__device__ __forceinline__ int crow(int r, int hi) { return (r & 3) + 8 * (r >> 2) + 4 * hi; }
__device__ __forceinline__ int kn_off(int row, int colB) { return row * 256 + (colB ^ ((row & 15) << 4)); }
__device__ __forceinline__ int kr_off(int row, int chunk) { return row * 128 + ((chunk ^ ((row >> 1) & 7)) << 4); }
__device__ __forceinline__ int v_st(int k, int c) { const int kk = (k & ~0xC) | ((k & 4) << 1) | ((k & 8) >> 1); return ((kk >> 3) * 4 + (c >> 5)) * 512 + ((kk & 7) * 32 + (c & 31)) * 2; }
__device__ __forceinline__ int v_rd_base(int lane) { return ((lane & 3) << 3) | (((lane >> 2) & 3) << 6) | (((lane >> 4) & 1) << 5) | (((lane >> 5) & 1) << 8); }
constexpr int v_rd_off(int d0, int ks, int half) { return d0 * 512 + ks * 4096 + half * 2048; }
template <int OFF> __device__ __forceinline__ s16x4 tr_read(int vb) { s16x4 r; asm volatile("ds_read_b64_tr_b16 %0, %1 offset:%2" : "=&v"(r) : "v"(vb), "i"(OFF) : "memory"); return r; }
template <int OFF> __device__ __forceinline__ bf16x8 lds128(int a) { bf16x8 r; asm volatile("ds_read_b128 %0, %1 offset:%2" : "=v"(r) : "v"(a), "i"(OFF) : "memory"); return r; }
#define AT_WAIT(n) do { asm volatile("s_waitcnt lgkmcnt(" #n ")" ::: "memory"); __builtin_amdgcn_sched_barrier(0); } while (0)
struct VSet { s16x4 l0, h0, l1, h1, l2, h2, l3, h3; };
template <int D0> __device__ __forceinline__ void pv_read(VSet& v, int vb) {
    v.l0 = tr_read<v_rd_off(D0, 0, 0)>(vb); v.h0 = tr_read<v_rd_off(D0, 0, 1)>(vb); v.l1 = tr_read<v_rd_off(D0, 1, 0)>(vb); v.h1 = tr_read<v_rd_off(D0, 1, 1)>(vb);
    v.l2 = tr_read<v_rd_off(D0, 2, 0)>(vb); v.h2 = tr_read<v_rd_off(D0, 2, 1)>(vb); v.l3 = tr_read<v_rd_off(D0, 3, 0)>(vb); v.h3 = tr_read<v_rd_off(D0, 3, 1)>(vb); }
__device__ __forceinline__ void pv_mma(f32x16& od, const VSet& v, bf16x8 pa0, bf16x8 pa1, bf16x8 pa2, bf16x8 pa3) {
#define ATT_PK(L, H) (bf16x8){L[0], L[1], L[2], L[3], H[0], H[1], H[2], H[3]}
    od = __builtin_amdgcn_mfma_f32_32x32x16_bf16(pa0, ATT_PK(v.l0, v.h0), od, 0, 0, 0);
    od = __builtin_amdgcn_mfma_f32_32x32x16_bf16(pa1, ATT_PK(v.l1, v.h1), od, 0, 0, 0);
    od = __builtin_amdgcn_mfma_f32_32x32x16_bf16(pa2, ATT_PK(v.l2, v.h2), od, 0, 0, 0);
    od = __builtin_amdgcn_mfma_f32_32x32x16_bf16(pa3, ATT_PK(v.l3, v.h3), od, 0, 0, 0);
#undef ATT_PK
}
template <int D0> __device__ __forceinline__ void pv_one(f32x16& od, int vb, bf16x8 pa0, bf16x8 pa1, bf16x8 pa2, bf16x8 pa3) {
    const s16x4 l0 = tr_read<v_rd_off(D0, 0, 0)>(vb), h0 = tr_read<v_rd_off(D0, 0, 1)>(vb), l1 = tr_read<v_rd_off(D0, 1, 0)>(vb), h1 = tr_read<v_rd_off(D0, 1, 1)>(vb);
    const s16x4 l2 = tr_read<v_rd_off(D0, 2, 0)>(vb), h2 = tr_read<v_rd_off(D0, 2, 1)>(vb), l3 = tr_read<v_rd_off(D0, 3, 0)>(vb), h3 = tr_read<v_rd_off(D0, 3, 1)>(vb);
    asm volatile("s_waitcnt lgkmcnt(0)" ::: "memory"); __builtin_amdgcn_sched_barrier(0);
#define ATT_PK(L, H) (bf16x8){L[0], L[1], L[2], L[3], H[0], H[1], H[2], H[3]}
    od = __builtin_amdgcn_mfma_f32_32x32x16_bf16(pa0, ATT_PK(l0, h0), od, 0, 0, 0);
    od = __builtin_amdgcn_mfma_f32_32x32x16_bf16(pa1, ATT_PK(l1, h1), od, 0, 0, 0);
    od = __builtin_amdgcn_mfma_f32_32x32x16_bf16(pa2, ATT_PK(l2, h2), od, 0, 0, 0);
    od = __builtin_amdgcn_mfma_f32_32x32x16_bf16(pa3, ATT_PK(l3, h3), od, 0, 0, 0);
#undef ATT_PK
}
__device__ __forceinline__ void unit(const Frame& F, int q0, int h) {
    const bf16_t* Q = wsp<bf16_t>(F, WS_Q); const bf16_t* KV = wsp<bf16_t>(F, WS_KV); bf16_t* O = wsp<bf16_t>(F, WS_O);
    LAS char* lds = (LAS char*)F.lds;
    const int tid = F.tid, wid = F.wave, lane = F.lane, r32 = lane & 31, hi = lane >> 5;
    LAS float* scr = (LAS float*)(lds + SCR_OFF) + wid * 64; LAS float* li_l = scr; LAS float* al_l = scr + 32;
    float m_reg = -1e30f, l_reg = 0.f; f32x16 o[4]; o[0] = (f32x16)(0.f); o[1] = o[0]; o[2] = o[0]; o[3] = o[0];
    bf16x8 qr[12];
    { const bf16_t* qw = Q + (size_t)(q0 + wid * 32 + r32) * QW + h * 192 + hi * 8;
#pragma unroll
      for (int d0 = 0; d0 < 12; ++d0) qr[d0] = *(const bf16x8*)(qw + d0 * 16); }
    const int sr = tid >> 4, sc = (tid & 15) * 8, rr = tid >> 3, rc = tid & 7;
    const int kn0 = kn_off(sr, sc * 2), kn1 = kn_off(32 + sr, sc * 2), vs0 = v_st(sr, sc), vs1 = v_st(32 + sr, sc), kro = kr_off(rr, rc);
    const int vb0 = (int)(uintptr_t)(LAS char*)(F.lds + KN_B + KR_B) + v_rd_base(lane);
    const int lds0 = (int)(uintptr_t)(LAS char*)F.lds;
    u32x4 g0, g1, g2;
    const unsigned so0 = (unsigned)(sr * KVW + sc) * 2u, so2 = (unsigned)(rr * KVW + 128 + rc * 8) * 2u;
#define AT_SLOAD(k0) do { const char* kvb = (const char*)KV + (size_t)(k0) * KVW * 2; g0 = *(const u32x4*)(kvb + so0); g1 = *(const u32x4*)(kvb + so0 + 32u * KVW * 2u); g2 = *(const u32x4*)(kvb + so2); } while (0)
#define AT_SWRITE(b) do { LAS char* bb = lds + (b) * BUF_B; *(LAS u32x4*)(bb + kn0) = g0; *(LAS u32x4*)(bb + kn1) = g1; *(LAS u32x4*)(bb + KN_B + kro) = g2; *(LAS u32x4*)(bb + KN_B + KR_B + vs0) = g0; *(LAS u32x4*)(bb + KN_B + KR_B + vs1) = g1; } while (0)
    constexpr int NT = T / 64;
    AT_SLOAD(0); AT_SWRITE(0); __syncthreads();
    for (int j = 0; j < NT; ++j) {
        const int b = j & 1; const LAS char* kb = lds + b * BUF_B;
        if (j + 1 < NT) AT_SLOAD((j + 1) * 64);
        f32x16 p0 = (f32x16)(0.f), p1 = (f32x16)(0.f);
        __builtin_amdgcn_sched_barrier(0);
#pragma unroll
        for (int d0 = 0; d0 < 8; ++d0) { const int cb = (d0 * 16 + hi * 8) * 2;
            const bf16x8 k0 = *(const LAS bf16x8*)(kb + kn_off(r32, cb)), k1 = *(const LAS bf16x8*)(kb + kn_off(32 + r32, cb));
            p0 = __builtin_amdgcn_mfma_f32_32x32x16_bf16(k0, qr[d0], p0, 0, 0, 0); p1 = __builtin_amdgcn_mfma_f32_32x32x16_bf16(k1, qr[d0], p1, 0, 0, 0); }
#pragma unroll
        for (int d0 = 0; d0 < 4; ++d0) { const int ch = d0 * 2 + hi;
            const bf16x8 k0 = *(const LAS bf16x8*)(kb + KN_B + kr_off(r32, ch)), k1 = *(const LAS bf16x8*)(kb + KN_B + kr_off(32 + r32, ch));
            p0 = __builtin_amdgcn_mfma_f32_32x32x16_bf16(k0, qr[8 + d0], p0, 0, 0, 0); p1 = __builtin_amdgcn_mfma_f32_32x32x16_bf16(k1, qr[8 + d0], p1, 0, 0, 0); }
        __builtin_amdgcn_sched_group_barrier(0x100, 6, 0);
#pragma unroll
        for (int i_ = 0; i_ < 9; ++i_) { __builtin_amdgcn_sched_group_barrier(0x008, 2, 0); __builtin_amdgcn_sched_group_barrier(0x100, 2, 0); }
        __builtin_amdgcn_sched_group_barrier(0x008, 6, 0);
        __builtin_amdgcn_sched_barrier(0);
        const int vb = vb0 + b * BUF_B; VSet va, vbs; pv_read<0>(va, vb);
        float pmax = p0[0];
#pragma unroll
        for (int r = 1; r < 16; ++r) pmax = fmaxf(pmax, p0[r]);
#pragma unroll
        for (int r = 0; r < 16; ++r) pmax = fmaxf(pmax, p1[r]);
        { auto rrr = __builtin_amdgcn_permlane32_swap(__float_as_uint(pmax), __float_as_uint(pmax), false, false); pmax = fmaxf(__uint_as_float(rrr[0]), __uint_as_float(rrr[1])); }
        float alpha = 1.f;
        if (!__all(pmax - m_reg <= THR2)) { const float mn = fmaxf(m_reg, pmax); alpha = __builtin_amdgcn_exp2f(m_reg - mn); m_reg = mn;
            if (hi == 0) al_l[r32] = alpha; asm volatile("s_waitcnt lgkmcnt(0)" ::: "memory");
#pragma unroll
            for (int dd = 0; dd < 4; ++dd)
#pragma unroll
                for (int r = 0; r < 16; ++r) o[dd][r] *= al_l[crow(r, hi)]; }
        float ps = 0.f;
#pragma unroll
        for (int r = 0; r < 16; ++r) { p0[r] = __builtin_amdgcn_exp2f(p0[r] - m_reg); p1[r] = __builtin_amdgcn_exp2f(p1[r] - m_reg); ps += p0[r] + p1[r]; }
        { auto rrr = __builtin_amdgcn_permlane32_swap(__float_as_uint(ps), __float_as_uint(ps), false, false); ps = __uint_as_float(rrr[0]) + __uint_as_float(rrr[1]); }
        l_reg = l_reg * alpha + ps;
        bf16x8 pa0, pa1, pa2, pa3;
#define AT_PK4(P, BASE, OUT) do { unsigned a0 = cvtpk(P[BASE + 0], P[BASE + 1]), a1 = cvtpk(P[BASE + 2], P[BASE + 3]); \
        unsigned b0 = cvtpk(P[BASE + 4], P[BASE + 5]), b1 = cvtpk(P[BASE + 6], P[BASE + 7]); \
        auto r0 = __builtin_amdgcn_permlane32_swap(a0, b0, false, false); auto r1 = __builtin_amdgcn_permlane32_swap(a1, b1, false, false); \
        u32x4 w = {r0[0], r1[0], r0[1], r1[1]}; OUT = __builtin_bit_cast(bf16x8, w); } while (0)
        AT_PK4(p0, 0, pa0); AT_PK4(p0, 8, pa1); AT_PK4(p1, 0, pa2); AT_PK4(p1, 8, pa3);
#undef AT_PK4
        pv_read<1>(vbs, vb); AT_WAIT(8); pv_mma(o[0], va, pa0, pa1, pa2, pa3);
        pv_read<2>(va, vb); AT_WAIT(8); pv_mma(o[1], vbs, pa0, pa1, pa2, pa3);
        pv_read<3>(vbs, vb); AT_WAIT(8); pv_mma(o[2], va, pa0, pa1, pa2, pa3);
        AT_WAIT(0); pv_mma(o[3], vbs, pa0, pa1, pa2, pa3);
        if (j + 1 < NT) AT_SWRITE(b ^ 1);
        __syncthreads();
    }
#undef AT_SLOAD
#undef AT_SWRITE
    if (hi == 0) li_l[r32] = l_reg; asm volatile("s_waitcnt lgkmcnt(0)" ::: "memory");
    { int l2 = lane; asm volatile("" : "+v"(l2)); const int hi2 = l2 >> 5; const unsigned ob = (unsigned)((q0 + wid * 32 + 4 * hi2) * OW + h * 128 + (l2 & 31)) * 2u;
#pragma unroll
      for (int r = 0; r < 16; ++r) { const float rl = __builtin_amdgcn_rcpf(li_l[crow(r, hi2)]);
#pragma unroll
          for (int d0 = 0; d0 < 4; ++d0) *(bf16_t*)((char*)O + ob + (unsigned)(((r & 3) + 8 * (r >> 2)) * OW + d0 * 32) * 2u) = (bf16_t)f2bf(o[d0][r] * rl); } }
    __syncthreads();
}
}
__device__ __forceinline__ void phase_attention(const Frame& F, int reps) {
    for (int uu = F.bid; uu < (T / 256) * 4 * reps; uu += F.G) { const int u = uu % ((T / 256) * 4); att::unit(F, (u >> 2) * 256, u & 3); }
}

__device__ __forceinline__ void phase_norm2_router(const Frame& F, int l, int reps) {
    const float* X = gout(F); bf16_t* XN = wsp<bf16_t>(F, WS_XN); float* AFF = wsp<float>(F, WS_AFF);
    const float* gain = gin(F, I_NFFN) + (size_t)l * DM; const float* wr = gin(F, I_WR) + (size_t)l * DM * NE;
    for (int it = F.tid; it < 8192; it += NTHR) { const int ln = it & 63, q = (it >> 6) & 3, c = (it >> 8) & 3, i = it >> 10; *(LAS f32x4*)(F.lds + (size_t)it * 16) = *(const f32x4*)(wr + (size_t)(i * 256 + ln * 4 + c) * NE + 4 * q); }
    __syncthreads();
    for (int row_ = F.gw; row_ < T * reps; row_ += F.nw) { const int row = row_ % T;
        f32x4 v[8]; float ss = 0.f;
#pragma unroll
        for (int i = 0; i < 8; ++i) { v[i] = *(const f32x4*)(X + (size_t)row * DM + i * 256 + F.lane * 4); ss += v[i][0] * v[i][0] + v[i][1] * v[i][1] + v[i][2] * v[i][2] + v[i][3] * v[i][3]; }
        ss = wave_sum(ss); const float rstd = rsqrtf(ss * (1.0f / DM) + 1e-6f);
        float lg[NE];
#pragma unroll
        for (int e = 0; e < NE; ++e) lg[e] = 0.f;
#pragma unroll
        for (int i = 0; i < 8; ++i) { const f32x4 g = *(const f32x4*)(gain + i * 256 + F.lane * 4); f32x4 xn; xn[0] = v[i][0] * rstd * g[0]; xn[1] = v[i][1] * rstd * g[1]; xn[2] = v[i][2] * rstd * g[2]; xn[3] = v[i][3] * rstd * g[3];
            *(u32x2*)(XN + (size_t)row * DM + i * 256 + F.lane * 4) = pk4(xn);
            int lo_ = F.lane * 16; asm volatile("" : "+v"(lo_), "+v"(lg[0]));
#pragma unroll
            for (int c = 0; c < 4; ++c) {
#pragma unroll
                for (int q = 0; q < 4; ++q) { const f32x4 w = *(const LAS f32x4*)(F.lds + (((i * 4 + c) * 4 + q) * 1024 + lo_)); lg[4 * q] += xn[c] * w[0]; lg[4 * q + 1] += xn[c] * w[1]; lg[4 * q + 2] += xn[c] * w[2]; lg[4 * q + 3] += xn[c] * w[3]; } } }
        float mx = -1e30f;
#pragma unroll
        for (int e = 0; e < NE; ++e) { lg[e] = wave_sum(lg[e]); mx = fmaxf(mx, lg[e]); }
        float den = 0.f;
#pragma unroll
        for (int e = 0; e < NE; ++e) { lg[e] = __expf(lg[e] - mx); den += lg[e]; }
        float mine = 0.f;
#pragma unroll
        for (int e = 0; e < NE; ++e) mine = (F.lane == e) ? lg[e] : mine;
        if (F.lane < NE) AFF[(size_t)F.lane * T + row] = mine / den;
    }
}

__device__ __forceinline__ int block_excl_scan(const Frame& F, int v, LAS int* tmp) {
    int inc = v;
#pragma unroll
    for (int o = 1; o < 64; o <<= 1) { const int n = shi(inc, F.lane - o); if (F.lane >= o) inc += n; }
    __syncthreads();
    if (F.lane == 63) tmp[F.wave] = inc;
    __syncthreads();
    int off = 0;
#pragma unroll
    for (int w = 0; w < NWAVE; ++w) off += (w < F.wave) ? tmp[w] : 0;
    return off + inc - v;
}
__device__ __forceinline__ void phase_topk(const Frame& F) {
    if (F.bid >= NE) return;
    const int e = F.bid; const float* AFF = wsp<float>(F, WS_AFF) + (size_t)e * T; int* SLOT = wsp<int>(F, WS_SLOT) + (size_t)e * T; int* IDX = wsp<int>(F, WS_IDX) + e * CAP; float* GATEV = wsp<float>(F, WS_GATEV) + e * CAP;
    LAS unsigned* hist = (LAS unsigned*)F.lds; LAS int* sel = (LAS int*)(F.lds + 1024); LAS int* tmp = (LAS int*)(F.lds + 1088);
    unsigned u[32];
#pragma unroll
    for (int q = 0; q < 8; ++q) { const f32x4 a = *(const f32x4*)(AFF + F.tid * 32 + q * 4); u[4 * q] = __float_as_uint(a[0]); u[4 * q + 1] = __float_as_uint(a[1]); u[4 * q + 2] = __float_as_uint(a[2]); u[4 * q + 3] = __float_as_uint(a[3]); }
    unsigned prefix = 0u, mask = 0u; int need = CAP;
    for (int round = 0; round < 4; ++round) { const int shift = 24 - 8 * round;
        if (F.tid < 256) hist[F.tid] = 0u;
        __syncthreads();
#pragma unroll
        for (int i = 0; i < 32; ++i) if ((u[i] & mask) == prefix) __hip_atomic_fetch_add(&hist[(u[i] >> shift) & 255u], 1u, __ATOMIC_RELAXED, __HIP_MEMORY_SCOPE_WORKGROUP);
        __syncthreads();
        if (F.wave == 0) { const int c0 = (int)hist[4 * F.lane], c1 = (int)hist[4 * F.lane + 1], c2 = (int)hist[4 * F.lane + 2], c3 = (int)hist[4 * F.lane + 3]; const int tot = c0 + c1 + c2 + c3;
            int suf = tot;
#pragma unroll
            for (int o = 1; o < 64; o <<= 1) { const int n = shi(suf, F.lane + o); if (F.lane + o < 64) suf += n; }
            int run = suf - tot; const int cs[4] = {c0, c1, c2, c3};
#pragma unroll
            for (int b = 3; b >= 0; --b) { if (run < need && need <= run + cs[b]) { sel[0] = 4 * F.lane + b; sel[1] = need - run; } run += cs[b]; } }
        __syncthreads();
        prefix |= ((unsigned)sel[0]) << shift; mask |= 255u << shift; need = sel[1];
        __syncthreads();
    }
    const unsigned thr = prefix; int ngt = 0, neq = 0;
#pragma unroll
    for (int i = 0; i < 32; ++i) { ngt += (u[i] > thr) ? 1 : 0; neq += (u[i] == thr) ? 1 : 0; }
    const int eqp = block_excl_scan(F, neq, tmp);
    int nsel = ngt + max(0, min(neq, need - eqp));
    const int sp = block_excl_scan(F, nsel, tmp);
    int re = eqp, rs = sp;
#pragma unroll
    for (int i = 0; i < 32; ++i) { const int t = F.tid * 32 + i; bool s = u[i] > thr; if (u[i] == thr) { s = re < need; ++re; }
        int slot = -1; if (s) { slot = rs++; if (slot < CAP) { IDX[slot] = t; GATEV[slot] = __uint_as_float(u[i]); } else slot = -1; }
        SLOT[t] = slot; }
}

__device__ __forceinline__ void phase_gather(const Frame& F, int reps) {
    const bf16_t* XN = wsp<bf16_t>(F, WS_XN); bf16_t* XS = wsp<bf16_t>(F, WS_XS); const int* IDX = wsp<int>(F, WS_IDX);
    int vz = 0; asm volatile("" : "+v"(vz));
    static_assert((NE * CAP) % 4 == 0, "gather rows");
    for (int q_ = F.gw; q_ < (NE * CAP / 4) * reps; q_ += F.nw) { const int r0 = (q_ % (NE * CAP / 4)) * 4; int tq[4];
#pragma unroll
        for (int j = 0; j < 4; ++j) tq[j] = __builtin_amdgcn_readfirstlane(IDX[r0 + j + vz]);
        u32x4 v[4][4];
#pragma unroll
        for (int j = 0; j < 4; ++j) { const u32x4* s = (const u32x4*)(XN + (size_t)tq[j] * DM);
#pragma unroll
            for (int i = 0; i < 4; ++i) v[j][i] = s[i * 64 + F.lane]; }
#pragma unroll
        for (int j = 0; j < 4; ++j) { u32x4* d = (u32x4*)(XS + (size_t)(r0 + j) * DM);
#pragma unroll
            for (int i = 0; i < 4; ++i) d[i * 64 + F.lane] = v[j][i]; } }
}

__device__ __forceinline__ int fresh_zero() { int z; asm volatile("v_mov_b32 %0, 0" : "=v"(z)); return z; }
__device__ __forceinline__ int relaunder(int v, int z) { return __builtin_amdgcn_readfirstlane(v + z); }
__device__ __forceinline__ Frame mkframe(const Frame& F0) {
    Frame F = F0; const int z = fresh_zero();
    { const unsigned long long x = (unsigned long long)F0.P; const unsigned lo = (unsigned)relaunder((int)(unsigned)x, z), hi = (unsigned)relaunder((int)(unsigned)(x >> 32), z);
      F.P = (const __attribute__((address_space(4))) Params*)(((unsigned long long)hi << 32) | lo); }
    F.ws = (unsigned char*)(guc_t*)F.P->ws;
    F.lane = (int)__builtin_amdgcn_mbcnt_hi(~0u, __builtin_amdgcn_mbcnt_lo(~0u, (unsigned)z));
    F.wave = relaunder(F0.wave, z); F.bid = relaunder(F0.bid, z); F.G = relaunder(F0.G, z); F.nw = F.G * NWAVE;
    F.tid = F.wave * 64 + F.lane; F.gw = F.bid * NWAVE + F.wave; return F;
}
constexpr int PPL = 16;
constexpr int NPHASE = 1 + DEPTH * PPL;
#ifndef MK_N_LAUNCHES
#define MK_N_LAUNCHES 1
#endif

__global__ void __launch_bounds__(NTHR, 2) hybrid_fwd(Params P) {
    extern __shared__ __attribute__((aligned(16))) unsigned char lds_raw[];
    Frame F0; F0.lds = (LAS unsigned char*)lds_raw; F0.tid = threadIdx.x; F0.lane = F0.tid & 63; F0.wave = __builtin_amdgcn_readfirstlane(F0.tid >> 6);
    F0.G = gridDim.x; F0.bid = blockIdx.x; F0.gw = F0.bid * NWAVE + F0.wave; F0.nw = F0.G * NWAVE; F0.P = (const __attribute__((address_space(4))) Params*)__builtin_amdgcn_kernarg_segment_ptr(); F0.ws = (unsigned char*)(guc_t*)F0.P->ws;
    volatile LAS unsigned* MISC = (volatile LAS unsigned*)(F0.lds + MISC_OFF);
    if (F0.tid < 32) MISC[F0.tid] = 0u;
    __syncthreads();
    XcdBarrier bar; bar.bar = (unsigned*)(F0.ws + WS_CTL) + CW_BAR; bar.x = 0; bar.st = nullptr;
    bar = xcd_barrier_post((unsigned*)(F0.ws + WS_CTL) + CW_BAR, MISC + 8, F0.wave);
#ifndef DUP_MASK
#define DUP_MASK 0u
#endif
#define DUPK(k) ((DUP_MASK >> (k)) & 1u)
#define REP(k) for (int rep_ = 0; rep_ < ((DUPK(k) && l == 0) ? 2 : 1); ++rep_, ({ if (DUPK(k)) __syncthreads(); }))
#ifndef SMALL_MASK
#define SMALL_MASK 15
#endif
#ifndef PH_MASK
#define PH_MASK 0xFFFFFFFFu
#endif
#define IN(k) true
#define INK(kind, k) (((PH_MASK >> (kind)) & 1u) && IN(k))
#define SEAM(k) do { Frame Fb = mkframe(F0); XcdBarrier bb; bb.bar = (unsigned*)(Fb.ws + WS_CTL) + CW_BAR; bb.x = xb_xcc_id(); bb.st = (volatile LAS unsigned*)(Fb.lds + MISC_OFF) + 8; xcd_barrier(bb, Fb.wave); } while (0)

    if (INK(16, 0)) { Frame F = mkframe(F0); phase_rope_table(F); phase_cvt_nm(F, 0); if (DUPK(16)) { __syncthreads(); phase_cvt_nm(F, 0); } phase_norm(F, 0, gin(F, I_NORM_MIX)); if (DUPK(18)) { __syncthreads(); phase_norm(F, 0, gin(F, I_NORM_MIX)); } }
    SEAM(0);
    for (int l = 0; l < DEPTH; ++l) {
        const int pb = 1 + l * PPL;
        if (INK(0, pb + 0)) { const int greps = (DUPK(0) && l == 0) ? 2 : 1; Frame F = mkframe(F0); EpiWin E{F.ws};
            run_gemm(F, E, wsp<bf16_t>(F, WS_XN), DM, wsp<bf16_t>(F, WS_WIN), DM, DM, T / 256, NWIN / 256, (size_t)256 * DM * 2, 0, 0, (size_t)256 * DM * 2, 0, 0, greps); }
        SEAM(pb + 0);
        if (INK(1, pb + 1)) { const int nreps = (DUPK(1) && l == 0) ? 2 : 1; Frame F = mkframe(F0); phase_prep(F, l, nreps); }
        SEAM(pb + 1);
        if (INK(2, pb + 2)) { const int greps = (DUPK(2) && l == 0) ? 2 : 1; Frame F = mkframe(F0);
            if (SMALL_MASK & 1) { EpiLora1 E{gin(F, I_W0) + (size_t)l * 2 * RW, gin(F, I_A0) + (size_t)l * 2 * RW, gin(F, I_KA) + (size_t)l * RW, F.ws};
              run_gemm(F, E, wsp<bf16_t>(F, WS_AL), 512, wsp<bf16_t>(F, WS_WL1), 256, 256, T / 256, 12, (size_t)256 * 512 * 2, 0, 0, (size_t)256 * 256 * 2, 0, 0, greps); }
            if (SMALL_MASK & 2) { EpiLora2 E{gin(F, I_VB) + (size_t)(l > 0 ? l - 1 : 0) * RW, F.ws};
              run_gemm(F, E, wsp<bf16_t>(F, WS_AL) + 256, 512, wsp<bf16_t>(F, WS_WL2), 256, 256, T / 256, l > 0 ? 6 : 3, (size_t)256 * 512 * 2, 0, 0, (size_t)256 * 256 * 2, 0, 0, greps); }
            if (SMALL_MASK & 4) { EpiLru E{gin(F, I_BA) + (size_t)l * 2 * LW, gin(F, I_BX) + (size_t)l * 2 * LW, gin(F, I_LAM) + (size_t)l * 2 * LW, F.ws};
              run_gemm(F, E, wsp<bf16_t>(F, WS_XC), LW, wsp<bf16_t>(F, WS_WLRU), 256, 256, T / 256, 12, (size_t)256 * LW * 2, (size_t)256 * 2, 0, (size_t)256 * 256 * 2, 2, 0, greps); }
            if (SMALL_MASK & 8) { EpiMlaQ E{F.ws};
              run_gemm(F, E, wsp<bf16_t>(F, WS_AM), 384, wsp<bf16_t>(F, WS_WQ), 384, 384, T / 256, 3, (size_t)256 * 384 * 2, 0, 0, (size_t)256 * 384 * 2, 0, 0, greps); }
        }
        SEAM(pb + 2);
        if (INK(3, pb + 3)) { const int nreps = (DUPK(3) && l == 0) ? 2 : 1; Frame F = mkframe(F0); phase_rwkv_local(F, nreps); phase_lru_local(F, nreps); }
        SEAM(pb + 3);
        if (INK(4, pb + 4)) { Frame F = mkframe(F0); if (DUPK(4) && l == 0) { phase_rwkv_carry(F, true); __syncthreads(); } phase_rwkv_carry(F, false); phase_lru_carry(F, 48); if (F.bid >= 51) phase_cvt_moe(F, l, F.bid - 51, F.G - 51, 1, 0); }
        SEAM(pb + 4);
        if (INK(5, pb + 5)) { const int nreps = (DUPK(5) && l == 0) ? 2 : 1; Frame F = mkframe(F0); phase_attention(F, nreps); }
        SEAM(pb + 5);
        if (INK(6, pb + 6)) { const int nreps = (DUPK(6) && l == 0) ? 2 : 1; Frame F = mkframe(F0); phase_rwkv_outfin(F, l, nreps); phase_lru_out(F, (DUPK(19) && l == 0) ? 2 : nreps); }
        SEAM(pb + 6);
        if (INK(8, pb + 8)) { const int greps = 1; Frame F = mkframe(F0);
            if (DUPK(8) && l == 0) {
            { EpiMerge E{F.ws, 0};
              run_gemm(F, E, wsp<bf16_t>(F, WS_YA), RW, wsp<bf16_t>(F, WS_WOA), RW, RW, T / 256, DM / 256, (size_t)256 * RW * 2, 0, 0, (size_t)256 * RW * 2, 0, 0, greps); }
            { EpiMerge E{F.ws, 1};
              run_gemm(F, E, wsp<bf16_t>(F, WS_YB), LW, wsp<bf16_t>(F, WS_WOB), LW, LW, T / 256, DM / 256, (size_t)256 * LW * 2, 0, 0, (size_t)256 * LW * 2, 0, 0, greps); }
            { EpiMerge E{F.ws, 2};
              run_gemm(F, E, wsp<bf16_t>(F, WS_O), OW, wsp<bf16_t>(F, WS_WOC), OW, OW, T / 256, DM / 256, (size_t)256 * OW * 2, 0, 0, (size_t)256 * OW * 2, 0, 0, greps); }
            }
            { EpiMerge E{F.ws, 0};
              run_gemm(F, E, wsp<bf16_t>(F, WS_YA), RW, wsp<bf16_t>(F, WS_WOA), RW, RW, T / 256, DM / 256, (size_t)256 * RW * 2, 0, 0, (size_t)256 * RW * 2, 0, 0, greps); }
            { EpiMerge E{F.ws, 1};
              run_gemm(F, E, wsp<bf16_t>(F, WS_YB), LW, wsp<bf16_t>(F, WS_WOB), LW, LW, T / 256, DM / 256, (size_t)256 * LW * 2, 0, 0, (size_t)256 * LW * 2, 0, 0, greps); }
            { EpiMerge E{F.ws, 2};
              run_gemm(F, E, wsp<bf16_t>(F, WS_O), OW, wsp<bf16_t>(F, WS_WOC), OW, OW, T / 256, DM / 256, (size_t)256 * OW * 2, 0, 0, (size_t)256 * OW * 2, 0, 0, greps); }
        }
        SEAM(pb + 8);
        if (INK(9, pb + 9)) { const int greps = 1; Frame F = mkframe(F0); if (DUPK(9) && l == 0) { EpiWout E{gout(F), wsp<float>(F, WS_HG)}; run_gemm(F, E, wsp<bf16_t>(F, WS_MERGED), DM, wsp<bf16_t>(F, WS_WOUT), DM, DM, T / 256, DM / 256, (size_t)256 * DM * 2, 0, 0, (size_t)256 * DM * 2, 0, 0, greps); }
            EpiWout E{gout(F), gout(F)};
            run_gemm(F, E, wsp<bf16_t>(F, WS_MERGED), DM, wsp<bf16_t>(F, WS_WOUT), DM, DM, T / 256, DM / 256, (size_t)256 * DM * 2, 0, 0, (size_t)256 * DM * 2, 0, 0, greps); }
        SEAM(pb + 9);
        if (INK(10, pb + 10)) { const int nreps = (DUPK(10) && l == 0) ? 2 : 1; Frame F = mkframe(F0); phase_norm2_router(F, l, nreps); }
        SEAM(pb + 10);
        if (INK(11, pb + 11)) { const int nreps = (DUPK(11) && l == 0) ? 2 : 1; Frame F = mkframe(F0); if (DUPK(17) && l == 0) { phase_topk(F); __syncthreads(); } phase_topk(F); __syncthreads(); if (F.bid >= NE) phase_cvt_moe(F, l, F.bid - NE, F.G - NE, nreps, 1); }
        SEAM(pb + 11);
        if (INK(12, pb + 12)) { const int nreps = (DUPK(12) && l == 0) ? 2 : 1; Frame F = mkframe(F0); phase_gather(F, nreps); }
        SEAM(pb + 12);
        if (INK(13, pb + 13)) { const int greps = (DUPK(13) && l == 0) ? 2 : 1; Frame F = mkframe(F0); EpiMoeUp E{F.ws};
            run_gemm(F, E, wsp<bf16_t>(F, WS_XS), DM, wsp<bf16_t>(F, WS_WGU), DM, DM, NE * 8, 8, (size_t)256 * DM * 2, 0, (size_t)2048 * DM * 2, (size_t)256 * DM * 2, 0, 3, greps); }
        SEAM(pb + 13);
        if (INK(14, pb + 14)) { const int greps = (DUPK(14) && l == 0) ? 2 : 1; Frame F = mkframe(F0); EpiMoeDown E{F.ws};
            run_gemm(F, E, wsp<bf16_t>(F, WS_HDN), FF, wsp<bf16_t>(F, WS_WD), FF, FF, NE * 8, 8, (size_t)256 * FF * 2, 0, (size_t)2048 * FF * 2, (size_t)256 * FF * 2, 0, 3, greps); }
        SEAM(pb + 14);
        if (INK(15, pb + 15)) { Frame F = mkframe(F0);
            if (l + 1 < DEPTH) { phase_cvt_nm(F, l + 1); phase_norm(F, 1, gin(F, I_NORM_MIX) + (size_t)(l + 1) * DM); }
            else phase_norm(F, 2, gin(F, I_NFIN));
        }
        if (l + 1 < DEPTH) SEAM(pb + 15);
    }
#undef IN
#undef SEAM
}

extern "C" void kernel_launch(void* const* d_in, const int* in_sizes, int n_in, void* d_out, int out_size, void* d_ws, size_t ws_size, hipStream_t stream) {
    static int grid = 0;
    if (grid == 0) {
        int dev = 0, cus = 0, per_cu = 0;
        if (hipGetDevice(&dev) != hipSuccess || hipDeviceGetAttribute(&cus, hipDeviceAttributeMultiprocessorCount, dev) != hipSuccess) { fprintf(stderr, "kernel_launch: device query failed\n"); grid = -1; return; }
        if (hipFuncSetAttribute((const void*)hybrid_fwd, hipFuncAttributeMaxDynamicSharedMemorySize, LDS_BYTES) != hipSuccess) { fprintf(stderr, "kernel_launch: hipFuncSetAttribute failed\n"); grid = -1; return; }
        if (hipOccupancyMaxActiveBlocksPerMultiprocessor(&per_cu, (const void*)hybrid_fwd, NTHR, LDS_BYTES) != hipSuccess || per_cu < 1) fprintf(stderr, "kernel_launch: occupancy query reports %d\n", per_cu);
        (void)hipGetLastError();
        grid = cus;
        if (n_in != 40 || ws_size < WS_NEED) fprintf(stderr, "kernel_launch: unexpected n_in %d / ws_size %zu (need %zu)\n", n_in, ws_size, (size_t)WS_NEED);
    }
    if (grid < 0) return;
    (void)hipMemsetAsync(d_ws, 0, 65536, stream);
    Params p{};
    for (int i = 0; i < 40; ++i) p.in[i] = (const float*)d_in[i];
    p.out = (float*)d_out; p.ws = (unsigned char*)d_ws;
#if MK_N_LAUNCHES == 1
    p.ph_lo = 0; p.ph_hi = NPHASE;
    hipLaunchKernelGGL(hybrid_fwd, dim3(grid), dim3(NTHR), LDS_BYTES, stream, p);
#else
    for (int k = 0; k < NPHASE; ++k) { p.ph_lo = k; p.ph_hi = k + 1; hipLaunchKernelGGL(hybrid_fwd, dim3(grid), dim3(NTHR), LDS_BYTES, stream, p); }
#endif
    const hipError_t le = hipPeekAtLastError();
    if (le != hipSuccess) fprintf(stderr, "kernel_launch: launch failed: %s\n", hipGetErrorName(le));
}
```

```cpp
#include <hip/hip_runtime.h>
#include <cstdio>
#include <cstdint>

#define LAS __attribute__((address_space(3)))
typedef unsigned short bf16_t;
typedef short bf16x8 __attribute__((ext_vector_type(8)));
typedef short s16x4 __attribute__((ext_vector_type(4)));
typedef float f32x4 __attribute__((ext_vector_type(4)));
typedef float f32x2 __attribute__((ext_vector_type(2)));
typedef float f32x16 __attribute__((ext_vector_type(16)));
typedef unsigned u32x4 __attribute__((ext_vector_type(4)));
typedef unsigned u32x2 __attribute__((ext_vector_type(2)));

constexpr int T = 16384, DM = 2048, DEPTH = 2;
constexpr int RW = 768, NH = 12, HD = 64;
constexpr int LW = 768;
constexpr int RWKV_COLS = 2688, IN_COLS = 10944;
constexpr int H1W = 4864, HGW = 6144, NWIN = H1W + HGW;
constexpr int NE = 16, FF = 1024, CAP = 2048;
constexpr int NCH = 256, CL = 64;
constexpr int NTHR = 512, NWAVE = 8;
constexpr int QW = 768, KVW = 192, OW = 512;
constexpr float QSCALE = 0.07216878364870322f * 1.4426950408889634f;

constexpr size_t MiB = 1u << 20;
constexpr size_t WS_CTL = 0, CTL_BYTES = 1 * MiB;
constexpr size_t WS_COS = 1 * MiB, WS_SIN = 3 * MiB;
constexpr size_t WS_VF = 5 * MiB;
constexpr size_t WS_AFF = 29 * MiB;
constexpr size_t WS_SLOT = 30 * MiB;
constexpr size_t WS_IDX = 31 * MiB;
constexpr size_t WS_GATEV = 31 * MiB + 512 * 1024;
constexpr size_t WS_LA = 32 * MiB, WS_LB = 32 * MiB + 1536 * 1024, WS_LH0 = 35 * MiB;
constexpr size_t WS_W = 37 * MiB;
constexpr size_t WS_WIN = WS_W, WS_WOUT = WS_W + 43 * MiB, WS_WOA = WS_W + 51 * MiB, WS_WOB = WS_W + 54 * MiB, WS_WOC = WS_W + 57 * MiB,
                 WS_WL1 = WS_W + 59 * MiB, WS_WL2 = WS_W + 60 * MiB + 512 * 1024, WS_WLRU = WS_W + 61 * MiB + 256 * 1024, WS_WQ = WS_W + 62 * MiB + 768 * 1024;
constexpr size_t WS_XN = 101 * MiB;
constexpr size_t WS_YA = 101 * MiB, WS_YB = 125 * MiB;
constexpr size_t WS_H1 = 165 * MiB;
constexpr size_t WS_AF = 165 * MiB;
constexpr size_t WS_YF = 213 * MiB;
constexpr size_t WS_HG = 317 * MiB;
constexpr size_t WS_R = 509 * MiB, WS_K = 533 * MiB, WS_V = 557 * MiB, WS_KK = 581 * MiB, WS_E = 605 * MiB  , WS_BV = 653 * MiB  , WS_KD = 701 * MiB  , WS_G = 749 * MiB;
constexpr size_t WS_MERGED = 509 * MiB;
constexpr size_t WS_LOGA = 773 * MiB  , WS_IG = 821 * MiB  , WS_XC = 869 * MiB, WS_GB = 893 * MiB;
constexpr size_t WS_AM = 917 * MiB, WS_KV = 929 * MiB, WS_Q = 935 * MiB, WS_O = 959 * MiB;
constexpr size_t WS_AL = 975 * MiB;
constexpr size_t WS_GT = 991 * MiB;
constexpr size_t WS_WY = 1087 * MiB;
constexpr size_t WS_END_MIX = 1135 * MiB;
constexpr size_t WS_WGU = 165 * MiB, WS_XS = 357 * MiB, WS_HDN = 485 * MiB;
constexpr size_t WS_WD = 581 * MiB;
constexpr size_t WS_SLAB = 773 * MiB;
constexpr size_t WS_NEED = 1136 * MiB;
constexpr size_t SZ24 = 24 * MiB;

constexpr int CW_BAR = 4096;
constexpr int LDS_BYTES = 147456;
constexpr int MISC_OFF = 131072 + 320;

typedef __bf16 bf16x2_t __attribute__((ext_vector_type(2)));
__device__ __forceinline__ unsigned f2bf(float f) { return (unsigned)__builtin_bit_cast(unsigned short, (__bf16)f); }
__device__ __forceinline__ float bf2f(unsigned b) { return __builtin_bit_cast(float, b << 16); }
__device__ __forceinline__ unsigned pk2(float lo, float hi) { const bf16x2_t v = __builtin_convertvector((f32x2){lo, hi}, bf16x2_t); return __builtin_bit_cast(unsigned, v); }
__device__ __forceinline__ unsigned cvtpk(float lo, float hi) { unsigned r; asm volatile("v_cvt_pk_bf16_f32 %0, %1, %2" : "=v"(r) : "v"(lo), "v"(hi)); return r; }
__device__ __forceinline__ float bflo(unsigned w) { return __builtin_bit_cast(float, w << 16); }
__device__ __forceinline__ float bfhi(unsigned w) { return __builtin_bit_cast(float, w & 0xffff0000u); }
__device__ __forceinline__ float sigmoidf_(float x) { return __builtin_amdgcn_rcpf(1.0f + __expf(-x)); }
__device__ __forceinline__ float softplusf_(float z) { return fmaxf(z, 0.f) + __logf(1.0f + __expf(-fabsf(z))); }
__device__ __forceinline__ unsigned vzero() { unsigned z; asm volatile("v_mov_b32 %0, 0" : "=v"(z)); return z; }
__device__ __forceinline__ int lane_now() { int z; asm volatile("v_mov_b32 %0, 0" : "=v"(z)); return (int)__builtin_amdgcn_mbcnt_hi(~0u, __builtin_amdgcn_mbcnt_lo(~0u, (unsigned)z)); }
__device__ __forceinline__ float shx(float v, int o, int lane) { return __builtin_bit_cast(float, __builtin_amdgcn_ds_bpermute((lane ^ o) << 2, __builtin_bit_cast(int, v))); }
__device__ __forceinline__ int shi(int v, int src) { return __builtin_amdgcn_ds_bpermute(src << 2, v); }
__device__ __forceinline__ float wave_sum(float v) { const int lane = lane_now();
#pragma unroll
    for (int o = 32; o >= 1; o >>= 1) v += shx(v, o, lane);
    return v;
}

#define XB_TMO      128
#define XB_XCNT(j)  (256  + 64 * (j))
#define XB_XSUB(j)  (1280 + 64 * (j))
#define XB_XGEN(j)  (2304 + 64 * (j))
#define XB_TOP      3328
#define XB_TOPGEN   3392
#define XCD_BAR_WORDS 3456
#define XB_SPIN_CAP (1u << 22)
__device__ __forceinline__ unsigned xb_ld(unsigned* p)              { return __hip_atomic_load(p, __ATOMIC_RELAXED, __HIP_MEMORY_SCOPE_AGENT); }
__device__ __forceinline__ unsigned xb_add(unsigned* p, unsigned v) { return __hip_atomic_fetch_add(p, v, __ATOMIC_RELAXED, __HIP_MEMORY_SCOPE_AGENT); }
__device__ __forceinline__ unsigned xb_xcc_id() { return (unsigned)__builtin_amdgcn_s_getreg((3 << 11) | 20) & 0xFu; }
#define XB_SPIN(cond, bar) do { unsigned _sp = 0; while (cond) { __builtin_amdgcn_s_sleep(1); \
    if ((++_sp & 255u) == 0u) { if (xb_ld(&(bar)[XB_TMO])) break; if (_sp > XB_SPIN_CAP) { atomicAdd(&(bar)[XB_TMO], 1u); break; } } } } while (0)
struct XcdBarrier { unsigned* bar; unsigned x; volatile LAS unsigned* st; };
__device__ __forceinline__ bool xb_leader(int wave) { int z; asm volatile("v_mov_b32 %0, 0" : "=v"(z)); const unsigned l = __builtin_amdgcn_mbcnt_hi(~0u, __builtin_amdgcn_mbcnt_lo(~0u, (unsigned)z)); return (l | (unsigned)(wave + z)) == 0u; }
__device__ __forceinline__ XcdBarrier xcd_barrier_post(unsigned* bar, volatile LAS unsigned* st, int wave) {
    XcdBarrier b; b.bar = bar; b.x = xb_xcc_id(); b.st = st;
    if (xb_leader(wave)) (void)xb_add(&bar[XB_XCNT(b.x)], 1u);
    return b;
}
__device__ __forceinline__ void xcd_barrier_complete(unsigned* bar, unsigned x, unsigned& nloc, unsigned& nx) {
    const unsigned G = gridDim.x * gridDim.y * gridDim.z;
    unsigned sum, cnt, mine, sp = 0u;
    for (;;) {
        sum = 0u; cnt = 0u; mine = 0u;
#pragma unroll
        for (unsigned j = 0; j < 16; ++j) { const unsigned c = xb_ld(&bar[XB_XCNT(j)]); sum += c; cnt += (c > 0u) ? 1u : 0u; mine = (j == x) ? c : mine; }
        if (sum == G) break;
        __builtin_amdgcn_s_sleep(1);
        if ((++sp & 255u) == 0u) { if (xb_ld(&bar[XB_TMO])) break; if (sp > XB_SPIN_CAP) { atomicAdd(&bar[XB_TMO], 1u); break; } }
    }
    nloc = mine > 0u ? mine : 1u; nx = cnt > 0u ? cnt : 1u;
}
__device__ __forceinline__ void xcd_barrier(const XcdBarrier& b, int wave) {
    asm volatile("s_waitcnt vmcnt(0)" ::: "memory");
    __syncthreads();
    if (xb_leader(wave)) {
        unsigned* bar = b.bar;
        __builtin_amdgcn_s_waitcnt(0);
        unsigned nloc = b.st[0], nx = b.st[1];
        if (nloc == 0u) { xcd_barrier_complete(bar, b.x, nloc, nx); b.st[0] = nloc; b.st[1] = nx; }
        const unsigned old = xb_add(&bar[XB_XSUB(b.x)], 1u);
        const unsigned gen = old / nloc;
        if (old + 1u == (gen + 1u) * nloc) {
            __builtin_amdgcn_fence(__ATOMIC_RELEASE, "agent");
            asm volatile("s_waitcnt vmcnt(0)" ::: "memory");
            const unsigned og = xb_add(&bar[XB_TOP], 1u);
            const unsigned tg = og / nx;
            if (og + 1u == (tg + 1u) * nx) xb_add(&bar[XB_TOPGEN], 1u);
            else XB_SPIN(xb_ld(&bar[XB_TOPGEN]) == tg, bar);
            __builtin_amdgcn_fence(__ATOMIC_ACQUIRE, "agent");
            xb_add(&bar[XB_XGEN(b.x)], 1u);
            asm volatile("s_waitcnt vmcnt(0)" ::: "memory");
        } else {
            XB_SPIN(xb_ld(&bar[XB_XGEN(b.x)]) == gen, bar);
            __builtin_amdgcn_fence(__ATOMIC_ACQUIRE, "agent");
            asm volatile("s_waitcnt vmcnt(0)" ::: "memory");
        }
    }
    __syncthreads();
}

namespace pg8 {
constexpr int BM = 256, BK = 64, HALF = 128, HTB = HALF * BK * 2, STAGE_BYTES = 8 * HTB, NXCD = 8, WGM = 8;
__host__ __device__ __forceinline__ int lds_byte(int r, int c) { const int st = (r >> 4) * 2 + (c >> 5), rr = r & 15, cc = c & 31, ob = rr * 64 + cc * 2; return st * 1024 + (ob ^ (((ob >> 9) & 1) << 5)); }
__host__ __device__ __forceinline__ void stage_rc(int b, int& R, int& C) { const int st = b / 1024, sb = b % 1024, swz = sb ^ (((sb >> 9) & 1) << 5); R = (st >> 1) * 16 + swz / 64; C = (st & 1) * 32 + (swz % 64) / 2; }
__host__ __device__ __forceinline__ int perm32(int rho) { const int n = rho >> 4, i = rho & 15; return 8 * (i >> 2) + 4 * n + (i & 3); }

struct Unit { int pm, pn; const char* a; const char* b; };
template <class AddrF> struct Order {
    int nM, nN, nwg, G, c, reps; AddrF F;
    __device__ void init(int nM_, int nN_, int G_, int c_, const AddrF& f, int reps_ = 1) { nM = nM_; nN = nN_; nwg = nM * nN; G = G_; c = c_; F = f; reps = reps_; }
    __device__ bool next(int i, Unit& u) const {
        const long L = (long)i * G + c; if (L >= (long)nwg * reps) return false;
        int wgid = (int)(L % nwg); { const int q = nwg / NXCD, r = nwg % NXCD, xcd = wgid % NXCD, off = wgid / NXCD; wgid = (xcd < r ? xcd * (q + 1) : r * (q + 1) + (xcd - r) * q) + off; }
        const int nig = WGM * nN, gid = wgid / nig, fm = gid * WGM, gsz = (nM - fm) < WGM ? (nM - fm) : WGM;
        u.pm = fm + ((wgid % nig) % gsz); u.pn = (wgid % nig) / gsz; u.a = F.a(u.pm, u.pn); u.b = F.b(u.pm, u.pn); return true;
    }
};
struct Gemm { int K; int lda; int ldb; };

template <class Epi, class Sched, bool ALIGN_EPI = true, bool SP2 = true>
__device__ __forceinline__ void gemm_phase(LAS unsigned char* lds, const Gemm g, const Sched& S, const Epi& E, int tid, int wid) {
    const int lane = tid & 63, wr = wid >> 2, wc = wid & 3, fr = lane & 15, fq = lane >> 4;
    const int K = g.K, nt = K / BK;
    unsigned voffA[2], voffB[2];
#pragma unroll
    for (int i = 0; i < 2; ++i) { int R, C; stage_rc(tid * 16 + i * 8192, R, C); const int Rb = Epi::PERM ? ((R & ~31) + perm32(R & 31)) : R;
        voffA[i] = (unsigned)(R * g.lda + C) * 2u; voffB[i] = (unsigned)(Rb * g.ldb + C) * 2u; }
    const size_t kstep = (size_t)(BK * 2);
    const size_t hstepA = (size_t)HALF * g.lda * 2, hstepB = (size_t)HALF * g.ldb * 2;
    const unsigned ldsw = (unsigned)wid * 1024u;
    const int aoff = lds_byte(wr * 64 + fr, fq * 8), boff = lds_byte(wc * 32 + fr, fq * 8);
#define PG8_SA(b, h) (((b) * 2 + (h)) * HTB)
#define PG8_SB(b, h) ((4 + (b) * 2 + (h)) * HTB)
#define PG8_STAGE(bufoff, gbase, voff) do { _Pragma("unroll") for (int _i = 0; _i < 2; ++_i) \
        __builtin_amdgcn_global_load_lds((const unsigned*)((const char*)(gbase) + (voff)[_i]), (LAS unsigned*)(lds + (bufoff) + ldsw + _i * 8192), 16, 0, 0); } while (0)
#define PG8_LDA(dst, b, h) do { _Pragma("unroll") for (int m = 0; m < 4; ++m) _Pragma("unroll") for (int k = 0; k < 2; ++k) dst[m][k] = *(const LAS bf16x8*)(lds + PG8_SA(b, h) + aoff + m * 2048 + k * 1024); } while (0)
#define PG8_LDB(dst, b, h) do { _Pragma("unroll") for (int n = 0; n < 2; ++n) _Pragma("unroll") for (int k = 0; k < 2; ++k) dst[n][k] = *(const LAS bf16x8*)(lds + PG8_SB(b, h) + boff + n * 2048 + k * 1024); } while (0)
#define PG8_MMA(ai, bj, At, Bt) do { __builtin_amdgcn_s_setprio(1); _Pragma("unroll") for (int m = 0; m < 4; ++m) _Pragma("unroll") for (int n = 0; n < 2; ++n) _Pragma("unroll") for (int k = 0; k < 2; ++k) \
        acc[ai][bj][m][n] = __builtin_amdgcn_mfma_f32_16x16x32_bf16(Bt[n][k], At[m][k], acc[ai][bj][m][n], 0, 0, 0); __builtin_amdgcn_s_setprio(0); } while (0)
#define PG8_WAIT_V(n) asm volatile("s_waitcnt vmcnt(" #n ")" ::: "memory")
#define PG8_WAIT_L(n) asm volatile("s_waitcnt lgkmcnt(" #n ")" ::: "memory")
#define PG8_BAR __builtin_amdgcn_s_barrier()
#define PG8_SCHED __builtin_amdgcn_sched_barrier(0)
    Unit cur, nxt; int ui = 0;
    if (!S.next(0, cur)) return;
    f32x4 acc[2][2][4][2];
#pragma unroll
    for (int a = 0; a < 2; ++a)
#pragma unroll
        for (int b = 0; b < 2; ++b)
#pragma unroll
            for (int m = 0; m < 4; ++m)
#pragma unroll
                for (int n = 0; n < 2; ++n) acc[a][b][m][n] = (f32x4){0.f, 0.f, 0.f, 0.f};
    bf16x8 At[4][2], B0[2][2], B1[2][2];
    const char* cA = cur.a; const char* cB = cur.b;
    if constexpr (SP2) {
        PG8_STAGE(PG8_SB(0, 0), cB, voffB); PG8_STAGE(PG8_SB(0, 1), cB + hstepB, voffB); PG8_STAGE(PG8_SA(0, 0), cA, voffA); PG8_STAGE(PG8_SA(0, 1), cA + hstepA, voffA);
        if (wr == 1) PG8_BAR;
        PG8_WAIT_V(2); PG8_BAR;
        PG8_STAGE(PG8_SB(1, 0), cB + kstep, voffB); PG8_STAGE(PG8_SA(1, 0), cA + kstep, voffA); PG8_STAGE(PG8_SB(1, 1), cB + hstepB + kstep, voffB);
        PG8_WAIT_V(6); PG8_BAR;
    } else {
        PG8_STAGE(PG8_SB(0, 0), cB, voffB); PG8_STAGE(PG8_SA(0, 0), cA, voffA); PG8_STAGE(PG8_SB(0, 1), cB + hstepB, voffB); PG8_STAGE(PG8_SA(0, 1), cA + hstepA, voffA);
        if (wr == 1) PG8_BAR;
        PG8_WAIT_V(4); PG8_BAR;
        PG8_STAGE(PG8_SB(1, 0), cB + kstep, voffB); PG8_STAGE(PG8_SA(1, 0), cA + kstep, voffA); PG8_STAGE(PG8_SB(1, 1), cB + hstepB + kstep, voffB);
        PG8_WAIT_V(6); PG8_BAR;
    }
    for (;;) {
        const bool has_next = S.next(ui + 1, nxt);
        const char* nA = has_next ? nxt.a : cA; const char* nB = has_next ? nxt.b : cB;
#pragma unroll 1
        for (int t = 0; t < nt; t += 2) {
            const bool last = (t == nt - 2);
            const char* a1 = cA + (size_t)(t + 1) * kstep;
            const char* a2 = last ? nA : cA + (size_t)(t + 2) * kstep; const char* b2 = last ? nB : cB + (size_t)(t + 2) * kstep;
            const char* a3 = a2 + kstep; const char* b3 = b2 + kstep;
            if constexpr (SP2) {
            PG8_LDB(B0, 0, 0); PG8_LDB(B1, 0, 1); PG8_SCHED; PG8_LDA(At, 0, 0); PG8_STAGE(PG8_SA(1, 1), a1 + hstepA, voffA);
            PG8_WAIT_V(8); PG8_WAIT_L(0); PG8_BAR; PG8_MMA(0, 0, At, B0); PG8_MMA(0, 1, At, B1); PG8_BAR; PG8_SCHED;
            PG8_LDA(At, 0, 1); PG8_STAGE(PG8_SB(0, 0), b2, voffB); PG8_STAGE(PG8_SB(0, 1), b2 + hstepB, voffB); PG8_STAGE(PG8_SA(0, 0), a2, voffA);
            PG8_WAIT_V(8); PG8_WAIT_L(0); PG8_BAR; PG8_MMA(1, 0, At, B0); PG8_MMA(1, 1, At, B1); PG8_BAR; PG8_SCHED;
            PG8_LDB(B0, 1, 0); PG8_LDB(B1, 1, 1); PG8_SCHED; PG8_LDA(At, 1, 0); PG8_STAGE(PG8_SA(0, 1), a2 + hstepA, voffA);
            PG8_WAIT_V(8); PG8_WAIT_L(0); PG8_BAR; PG8_MMA(0, 0, At, B0); PG8_MMA(0, 1, At, B1); PG8_BAR; PG8_SCHED;
            PG8_LDA(At, 1, 1); PG8_STAGE(PG8_SB(1, 0), b3, voffB); PG8_STAGE(PG8_SB(1, 1), b3 + hstepB, voffB); PG8_STAGE(PG8_SA(1, 0), a3, voffA);
            PG8_WAIT_V(8); PG8_WAIT_L(0); PG8_BAR; PG8_MMA(1, 0, At, B0); PG8_MMA(1, 1, At, B1); PG8_BAR; PG8_SCHED;
            } else {
            PG8_LDB(B0, 0, 0); PG8_SCHED; PG8_LDA(At, 0, 0); PG8_STAGE(PG8_SA(1, 1), a1 + hstepA, voffA);
            PG8_WAIT_L(8); PG8_BAR; PG8_WAIT_L(0); PG8_MMA(0, 0, At, B0); PG8_BAR; PG8_SCHED;
            PG8_LDB(B1, 0, 1); PG8_STAGE(PG8_SB(0, 0), b2, voffB);
            PG8_BAR; PG8_WAIT_L(0); PG8_MMA(0, 1, At, B1); PG8_BAR;
            PG8_LDA(At, 0, 1); PG8_STAGE(PG8_SA(0, 0), a2, voffA);
            PG8_BAR; PG8_WAIT_L(0); PG8_MMA(1, 0, At, B0); PG8_BAR; PG8_SCHED;
            PG8_STAGE(PG8_SB(0, 1), b2 + hstepB, voffB);
            PG8_WAIT_V(6); PG8_BAR; PG8_MMA(1, 1, At, B1); PG8_BAR;
            PG8_LDB(B0, 1, 0); PG8_SCHED; PG8_LDA(At, 1, 0); PG8_STAGE(PG8_SA(0, 1), a2 + hstepA, voffA);
            PG8_WAIT_L(8); PG8_BAR; PG8_WAIT_L(0); PG8_MMA(0, 0, At, B0); PG8_BAR; PG8_SCHED;
            PG8_LDB(B1, 1, 1); PG8_STAGE(PG8_SB(1, 0), b3, voffB);
            PG8_BAR; PG8_WAIT_L(0); PG8_MMA(0, 1, At, B1); PG8_BAR;
            PG8_LDA(At, 1, 1); PG8_STAGE(PG8_SA(1, 0), a3, voffA);
            PG8_BAR; PG8_WAIT_L(0); PG8_MMA(1, 0, At, B0); PG8_BAR; PG8_SCHED;
            PG8_STAGE(PG8_SB(1, 1), b3 + hstepB, voffB);
            PG8_WAIT_V(6); PG8_BAR; PG8_MMA(1, 1, At, B1); PG8_BAR;
            }
        }
        if constexpr (ALIGN_EPI) { if (wr == 0) PG8_BAR; }
        E(acc, cur, wr, wc, fr, fq);
        if (!has_next) break;
#pragma unroll
        for (int a = 0; a < 2; ++a)
#pragma unroll
            for (int b = 0; b < 2; ++b)
#pragma unroll
                for (int m = 0; m < 4; ++m)
#pragma unroll
                    for (int n = 0; n < 2; ++n) acc[a][b][m][n] = (f32x4){0.f, 0.f, 0.f, 0.f};
        cur = nxt; cA = nA; cB = nB; ++ui;
        if constexpr (ALIGN_EPI) { if (wr == 1) PG8_BAR; }
    }
    PG8_WAIT_V(0);
    if constexpr (!ALIGN_EPI) { if (wr == 0) PG8_BAR; }
    PG8_BAR;
#undef PG8_SA
#undef PG8_SB
#undef PG8_STAGE
#undef PG8_LDA
#undef PG8_LDB
#undef PG8_MMA
#undef PG8_WAIT_V
#undef PG8_WAIT_L
#undef PG8_BAR
#undef PG8_SCHED
}
}

struct Params { const float* in[40]; float* out; unsigned char* ws; int ph_lo, ph_hi; };
enum { I_X = 0, I_POS, I_NORM_MIX, I_W_IN, I_MU, I_W0, I_W2, I_A0, I_A2, I_G2, I_KK, I_KA, I_RK, I_LNW, I_LNB, I_VDN, I_VUP, I_VB,
       I_CONVW, I_CONVB, I_WA, I_BA, I_WX, I_BX, I_LAM, I_QN, I_KVN, I_WUQ, I_WUK, I_WUV, I_WOR, I_WOL, I_WOM, I_WOUT, I_NFFN, I_WR, I_WG, I_WU, I_WDN, I_NFIN };
struct Frame {
    LAS unsigned char* lds; int tid, lane, wave, G, bid; int gw, nw;
    const __attribute__((address_space(4))) Params* P; unsigned char* ws;
};
template <class Tp> __device__ __forceinline__ Tp* wsp(const Frame& F, size_t off) { return (Tp*)(F.ws + off); }
typedef __attribute__((address_space(1))) const float gcf_t; typedef __attribute__((address_space(1))) float gf_t; typedef __attribute__((address_space(1))) unsigned char guc_t;
__device__ __forceinline__ const float* gin(const Frame& F, int i) { return (const float*)(gcf_t*)F.P->in[i]; }
__device__ __forceinline__ float* gout(const Frame& F) { return (float*)(gf_t*)F.P->out; }
template <class Tp> __device__ __forceinline__ Tp* opaque(Tp* p) { unsigned long long x = (unsigned long long)p; unsigned lo = (unsigned)x, hi = (unsigned)(x >> 32); asm volatile("" : "+v"(lo), "+v"(hi));
    lo = __builtin_amdgcn_readfirstlane(lo); hi = __builtin_amdgcn_readfirstlane(hi);
    typedef __attribute__((address_space(1))) char gchar_t; gchar_t* g = (gchar_t*)(((unsigned long long)hi << 32) | lo); return (Tp*)g; }

__device__ __forceinline__ void unpack8(const u32x4 w, float (&f)[8]) {
    f[0] = bflo(w.x); f[1] = bfhi(w.x); f[2] = bflo(w.y); f[3] = bfhi(w.y); f[4] = bflo(w.z); f[5] = bfhi(w.z); f[6] = bflo(w.w); f[7] = bfhi(w.w);
}
__device__ __forceinline__ u32x4 pack8(const float (&f)[8]) { u32x4 w; w.x = pk2(f[0], f[1]); w.y = pk2(f[2], f[3]); w.z = pk2(f[4], f[5]); w.w = pk2(f[6], f[7]); return w; }

struct CvtJob { const float* src; bf16_t* dst; int lds_; int Ks; int N; int ldd; int Kd; int koff; int rblock; int rstride; };
__device__ __forceinline__ void cvt_load(const Frame& F, const CvtJob& J, int t, f32x4 (&v)[2]) {
    const int tk = J.Kd >> 6; const int kt = t % tk, ntl = t / tk; const int k0 = kt * 64, n0 = ntl * 64; const int kr = F.tid >> 4, nq = F.tid & 15;
#pragma unroll
    for (int h = 0; h < 2; ++h) { const int k = k0 + kr + 32 * h, ks = k - J.koff, n = n0 + nq * 4; v[h] = (f32x4){0.f, 0.f, 0.f, 0.f};
        if (ks >= 0 && ks < J.Ks && n < J.N) v[h] = *(const f32x4*)(J.src + (size_t)ks * J.lds_ + n); }
}
__device__ __forceinline__ void cvt_finish(const Frame& F, const CvtJob& J, int t, const f32x4 (&v)[2]) {
    LAS float* tile = (LAS float*)F.lds;
    const int tk = J.Kd >> 6; const int kt = t % tk, ntl = t / tk; const int k0 = kt * 64, n0 = ntl * 64;
    { const int kr = F.tid >> 4, nq = F.tid & 15;
#pragma unroll
      for (int h = 0; h < 2; ++h) { LAS float* d = tile + (kr + 32 * h) * 65 + nq * 4; d[0] = v[h][0]; d[1] = v[h][1]; d[2] = v[h][2]; d[3] = v[h][3]; } }
    __syncthreads();
    { const int n = F.tid >> 3, kq = F.tid & 7; float f[8];
#pragma unroll
      for (int i = 0; i < 8; ++i) f[i] = tile[(kq * 8 + i) * 65 + n];
      const int nn = n0 + n;
      if (nn < J.N) { const int drow = (nn / J.rblock) * J.rstride + (nn % J.rblock); *(u32x4*)(J.dst + (size_t)drow * J.ldd + k0 + kq * 8) = pack8(f); } }
    __syncthreads();
}
__device__ __forceinline__ void cvt_tile(const Frame& F, const CvtJob& J, int t) { f32x4 v[2]; cvt_load(F, J, t, v); cvt_finish(F, J, t, v); }
__device__ __forceinline__ int cvt_ntiles(const CvtJob& J) { return ((J.N + 63) >> 6) * (J.Kd >> 6); }

__device__ __forceinline__ CvtJob nm_job(const Frame& F, int l, int j) {
    CvtJob J; J.rblock = 1 << 30; J.rstride = 0; J.koff = 0;
    bf16_t* WIN = wsp<bf16_t>(F, WS_WIN);
    if (j == 0) { J.src = gin(F, I_W_IN) + (size_t)l * DM * IN_COLS; J.lds_ = IN_COLS; J.Ks = DM; J.N = 4800; J.dst = WIN; J.ldd = DM; J.Kd = DM; }
    else if (j == 1) { J.src = gin(F, I_W_IN) + (size_t)l * DM * IN_COLS + 4800; J.lds_ = IN_COLS; J.Ks = DM; J.N = 6144; J.dst = WIN + (size_t)H1W * DM; J.ldd = DM; J.Kd = DM; }
    else if (j == 2) { J.src = gin(F, I_VDN) + (size_t)(l > 0 ? l - 1 : 0) * DM * 32; J.lds_ = 32; J.Ks = l > 0 ? DM : 0; J.N = 32; J.dst = WIN + (size_t)4800 * DM; J.ldd = DM; J.Kd = DM; }
    else if (j == 3) { J.src = gin(F, I_VDN); J.lds_ = 32; J.Ks = 0; J.N = 32; J.dst = WIN + (size_t)4832 * DM; J.ldd = DM; J.Kd = DM; }
    else if (j < 8) { const int i = j - 4, d = i & 1; J.src = (i < 2 ? gin(F, I_W2) : gin(F, I_A2)) + (size_t)(l * 2 + d) * 64 * RW; J.lds_ = RW; J.Ks = 64; J.N = RW;
        J.dst = wsp<bf16_t>(F, WS_WL1) + (size_t)i * RW * 256; J.ldd = 256; J.Kd = 256; J.koff = 64 * i; }
    else if (j == 8) { J.src = gin(F, I_G2) + (size_t)l * 128 * RW; J.lds_ = RW; J.Ks = 128; J.N = RW; J.dst = wsp<bf16_t>(F, WS_WL2); J.ldd = 256; J.Kd = 256; }
    else if (j == 9) { J.src = gin(F, I_VUP) + (size_t)(l > 0 ? l - 1 : 0) * 32 * RW; J.lds_ = RW; J.Ks = l > 0 ? 32 : 0; J.N = RW; J.dst = wsp<bf16_t>(F, WS_WL2) + (size_t)RW * 256; J.ldd = 256; J.Kd = 256; J.koff = 128; }
    else if (j < 34) { const int q = j - 10, gp = q >> 3, b = (q >> 2) & 1, kind = q & 3, blk = 2 * gp + b, d = kind & 1;
        J.src = (kind < 2 ? gin(F, I_WA) : gin(F, I_WX)) + (size_t)((l * 2 + d) * 6 + blk) * 128 * 128; J.lds_ = 128; J.Ks = 128; J.N = 128;
        J.dst = wsp<bf16_t>(F, WS_WLRU) + (size_t)(gp * 1024 + b * 512 + kind * 128) * 256; J.ldd = 256; J.Kd = 256; J.koff = b * 128; }
    else if (j == 34) { J.src = gin(F, I_WOR) + (size_t)l * RW * DM; J.lds_ = DM; J.Ks = RW; J.N = DM; J.dst = wsp<bf16_t>(F, WS_WOA); J.ldd = RW; J.Kd = RW; }
    else if (j == 35) { J.src = gin(F, I_WOL) + (size_t)l * LW * DM; J.lds_ = DM; J.Ks = LW; J.N = DM; J.dst = wsp<bf16_t>(F, WS_WOB); J.ldd = LW; J.Kd = LW; }
    else { J.src = gin(F, I_WOUT) + (size_t)l * DM * DM; J.lds_ = DM; J.Ks = DM; J.N = DM; J.dst = wsp<bf16_t>(F, WS_WOUT); J.ldd = DM; J.Kd = DM; }
    return J;
}
constexpr int NM_JOBS = 37;

__device__ __forceinline__ void phase_cvt_nm(const Frame& F, int l) {
    int rot = 0;
    for (int j = 0; j < NM_JOBS; ++j) {
        const CvtJob J = nm_job(F, l, j); const int nt = cvt_ntiles(J);
        int start = F.bid - rot; if (start < 0) start += F.G;
        if (start < nt) { f32x4 cv[2], c1[2]; cvt_load(F, J, start, cv); c1[0] = cv[0]; c1[1] = cv[1]; if (start + F.G < nt) cvt_load(F, J, start + F.G, c1);
            for (int t = start; t < nt; t += F.G) { f32x4 c2[2]; c2[0] = c1[0]; c2[1] = c1[1]; if (t + 2 * F.G < nt) cvt_load(F, J, t + 2 * F.G, c2); cvt_finish(F, J, t, cv); cv[0] = c1[0]; cv[1] = c1[1]; c1[0] = c2[0]; c1[1] = c2[1]; } }
        rot = (rot + nt) % F.G;
    }
    { const float* wuq = gin(F, I_WUQ) + (size_t)l * 384 * 768; const float* wuk = gin(F, I_WUK) + (size_t)l * 128 * 512; bf16_t* WQ = wsp<bf16_t>(F, WS_WQ);
      for (int o = F.bid * NTHR + F.tid; o < 4 * 64 * 384; o += F.G * NTHR) { const int i = o % 384, hc = o / 384, h = hc >> 6, cc = hc & 63, g = cc >> 5, ii = cc & 31; const int js = (ii < 16) ? (16 * g + ii) : (32 + 16 * g + ii - 16);
          WQ[(size_t)(h * 192 + 128 + cc) * 384 + i] = (bf16_t)f2bf(wuq[(size_t)i * 768 + h * 192 + 128 + js]); }
      for (int wt = F.gw; wt < 4 * 8 * 6; wt += F.nw) {
          const int hcb = wt / 6, ib = wt % 6, h = hcb >> 3, cb = hcb & 7, i = ib * 64 + F.lane;
          const float* a = wuq + (size_t)i * 768 + h * 192; const float* b = wuk + (size_t)(cb * 16) * 512 + h * 128;
          float acc[16];
#pragma unroll
          for (int j = 0; j < 16; ++j) acc[j] = 0.f;
#pragma unroll 1
          for (int d = 0; d < 128; d += 4) { const f32x4 av = *(const f32x4*)(a + d);
#pragma unroll
              for (int j = 0; j < 16; ++j) { const f32x4 bv = *(const f32x4*)(b + (size_t)j * 512 + d); acc[j] += av[0] * bv[0] + av[1] * bv[1] + av[2] * bv[2] + av[3] * bv[3]; } }
#pragma unroll
          for (int j = 0; j < 16; ++j) WQ[(size_t)(h * 192 + cb * 16 + j) * 384 + i] = (bf16_t)f2bf(acc[j]); } }
    { const float* wuv = gin(F, I_WUV) + (size_t)l * 128 * 512; const float* wom = gin(F, I_WOM) + (size_t)l * 512 * DM; bf16_t* WOC = wsp<bf16_t>(F, WS_WOC);
      for (int bt = F.bid; bt < 4 * 4 * 8; bt += F.G) { const int nb = bt & 3, hcb = bt >> 2, h = hcb >> 3, cb = hcb & 7, n = nb * 512 + F.tid;
          const float* a = wuv + (size_t)(cb * 16) * 512 + h * 128; const float* b = wom + (size_t)(h * 128) * DM + n;
          float acc[16];
#pragma unroll
          for (int j = 0; j < 16; ++j) acc[j] = 0.f;
#pragma unroll 1
          for (int d = 0; d < 128; d += 4) { float bv[4];
#pragma unroll
              for (int e = 0; e < 4; ++e) bv[e] = b[(size_t)(d + e) * DM];
#pragma unroll
              for (int j = 0; j < 16; ++j) { const f32x4 av = *(const f32x4*)(a + (size_t)j * 512 + d); acc[j] += av[0] * bv[0] + av[1] * bv[1] + av[2] * bv[2] + av[3] * bv[3]; } }
          u32x4 w0, w1; w0.x = pk2(acc[0], acc[1]); w0.y = pk2(acc[2], acc[3]); w0.z = pk2(acc[4], acc[5]); w0.w = pk2(acc[6], acc[7]); w1.x = pk2(acc[8], acc[9]); w1.y = pk2(acc[10], acc[11]); w1.z = pk2(acc[12], acc[13]); w1.w = pk2(acc[14], acc[15]);
          u32x4* dst = (u32x4*)(WOC + (size_t)n * 512 + h * 128 + cb * 16); dst[0] = w0; dst[1] = w1; } }
}

__device__ __forceinline__ CvtJob moe_job(const Frame& F, int l, int job) {
    const int e = job / 3, kind = job % 3; CvtJob J; J.koff = 0;
    if (kind < 2) { J.src = (kind == 0 ? gin(F, I_WG) : gin(F, I_WU)) + (size_t)(l * NE + e) * DM * FF; J.lds_ = FF; J.Ks = DM; J.N = FF;
        J.dst = wsp<bf16_t>(F, WS_WGU) + (size_t)e * 2048 * DM + (size_t)kind * 16 * DM; J.ldd = DM; J.Kd = DM; J.rblock = 16; J.rstride = 32; }
    else { J.src = gin(F, I_WDN) + (size_t)(l * NE + e) * FF * DM; J.lds_ = DM; J.Ks = FF; J.N = DM; J.dst = wsp<bf16_t>(F, WS_WD) + (size_t)e * DM * FF; J.ldd = FF; J.Kd = FF; J.rblock = 1 << 30; J.rstride = 0; }
    return J;
}
__device__ __forceinline__ int moe_job_of(int which, int jj) { return which == 0 ? 3 * jj + 2 : 3 * (jj >> 1) + (jj & 1); }
__device__ __forceinline__ void phase_cvt_moe(const Frame& F, int l, int bid, int nblk, int reps, int which) {
    const int NJ = (which == 0 ? 16 : 32) * 512; const int NT_ = NJ * reps; if (bid >= NT_) return;
    f32x4 cv[2], c1[2]; { const int t = bid % NJ; const CvtJob J = moe_job(F, l, moe_job_of(which, t >> 9)); cvt_load(F, J, t & 511, cv); }
    c1[0] = cv[0]; c1[1] = cv[1];
    if (bid + nblk < NT_) { const int t = (bid + nblk) % NJ; const CvtJob J = moe_job(F, l, moe_job_of(which, t >> 9)); cvt_load(F, J, t & 511, c1); }
    for (int t_ = bid; t_ < NT_; t_ += nblk) { const int t = t_ % NJ; const CvtJob J = moe_job(F, l, moe_job_of(which, t >> 9));
        f32x4 c2[2]; c2[0] = c1[0]; c2[1] = c1[1];
        if (t_ + 2 * nblk < NT_) { const int t2 = (t_ + 2 * nblk) % NJ; const CvtJob J2 = moe_job(F, l, moe_job_of(which, t2 >> 9)); cvt_load(F, J2, t2 & 511, c2); }
        cvt_finish(F, J, t & 511, cv); cv[0] = c1[0]; cv[1] = c1[1]; c1[0] = c2[0]; c1[1] = c2[1]; }
}

__device__ __forceinline__ void phase_rope_table(const Frame& F) {
    const int* pos = (const int*)gin(F, I_POS); float* C = wsp<float>(F, WS_COS); float* S = wsp<float>(F, WS_SIN);
    for (int o = F.bid * NTHR + F.tid; o < T * 32; o += F.G * NTHR) { const int t = o >> 5, j = o & 31;
        const float inv = powf(10000.0f, -(float)(2 * j) / 64.0f); const float ang = (float)pos[t] * inv; float s, c; sincosf(ang, &s, &c); C[o] = c; S[o] = s; }
}

__device__ __forceinline__ void phase_norm(const Frame& F, int mode, const float* gain) {
    float* X = gout(F); bf16_t* XN = wsp<bf16_t>(F, WS_XN);
    const int* SLOT = wsp<int>(F, WS_SLOT); const bf16_t* SLAB = wsp<bf16_t>(F, WS_SLAB);
    for (int row = F.gw; row < T; row += F.nw) {
        f32x4 v[8]; const float* src = (mode == 0 ? gin(F, I_X) : X) + (size_t)row * DM;
#pragma unroll
        for (int i = 0; i < 8; ++i) v[i] = *(const f32x4*)(src + i * 256 + F.lane * 4);
        if (mode != 0) {
            const int myslot = SLOT[(F.lane & 15) * T + row];
            unsigned m = (unsigned)(__ballot(myslot >= 0) & 0xFFFFull);
            while (m) { const int e0 = __builtin_ctz(m); m &= m - 1; const bool two = m != 0; const int e1 = two ? __builtin_ctz(m) : e0; if (two) m &= m - 1;
                const int s0 = __builtin_amdgcn_readlane(myslot, e0), s1 = __builtin_amdgcn_readlane(myslot, e1);
                const bf16_t* r0 = SLAB + ((size_t)e0 * CAP + s0) * DM; const bf16_t* r1 = SLAB + ((size_t)e1 * CAP + s1) * DM;
                u32x2 w0[8], w1[8];
#pragma unroll
                for (int i = 0; i < 8; ++i) { w0[i] = *(const u32x2*)(r0 + i * 256 + F.lane * 4); w1[i] = *(const u32x2*)(r1 + i * 256 + F.lane * 4); }
#pragma unroll
                for (int i = 0; i < 8; ++i) { v[i][0] += bflo(w0[i].x); v[i][1] += bfhi(w0[i].x); v[i][2] += bflo(w0[i].y); v[i][3] += bfhi(w0[i].y); }
                if (two) {
#pragma unroll
                    for (int i = 0; i < 8; ++i) { v[i][0] += bflo(w1[i].x); v[i][1] += bfhi(w1[i].x); v[i][2] += bflo(w1[i].y); v[i][3] += bfhi(w1[i].y); } } }
        }
        float ss = 0.f;
#pragma unroll
        for (int i = 0; i < 8; ++i) ss += v[i][0] * v[i][0] + v[i][1] * v[i][1] + v[i][2] * v[i][2] + v[i][3] * v[i][3];
        ss = wave_sum(ss); const float rstd = rsqrtf(ss * (1.0f / DM) + 1e-6f);
        if (mode != 2) {
#pragma unroll
            for (int i = 0; i < 8; ++i) *(f32x4*)(X + (size_t)row * DM + i * 256 + F.lane * 4) = v[i];
#pragma unroll
            for (int i = 0; i < 8; ++i) { const f32x4 g = *(const f32x4*)(gain + i * 256 + F.lane * 4); u32x2 w; w.x = pk2(v[i][0] * rstd * g[0], v[i][1] * rstd * g[1]); w.y = pk2(v[i][2] * rstd * g[2], v[i][3] * rstd * g[3]);
                *(u32x2*)(XN + (size_t)row * DM + i * 256 + F.lane * 4) = w; }
        } else {
#pragma unroll
            for (int i = 0; i < 8; ++i) { const f32x4 g = *(const f32x4*)(gain + i * 256 + F.lane * 4); f32x4 o; o[0] = v[i][0] * rstd * g[0]; o[1] = v[i][1] * rstd * g[1]; o[2] = v[i][2] * rstd * g[2]; o[3] = v[i][3] * rstd * g[3];
                *(f32x4*)(X + (size_t)row * DM + i * 256 + F.lane * 4) = o; }
        }
    }
}

struct AddrLin { const char* A; const char* B; size_t am, an, bm, bn; int ash, bsh;
    __device__ __forceinline__ const char* a(int pm, int pn) const { return A + (size_t)pm * am + (size_t)(pn >> ash) * an; }
    __device__ __forceinline__ const char* b(int pm, int pn) const { return B + (size_t)(pm >> bsh) * bm + (size_t)pn * bn; } };
typedef pg8::Order<AddrLin> OrderL;
#define EPI_ARGS const f32x4 (&acc)[2][2][4][2], const pg8::Unit& u, int wr, int wc, int fr, int fq
#define EPI_ROWS _Pragma("unroll") for (int ai = 0; ai < 2; ++ai) _Pragma("unroll") for (int m = 0; m < 4; ++m, ({ asm volatile("" ::: "memory"); }))
#define EPI_ROW (u.pm * 256 + ai * 128 + wr * 64 + m * 16 + fr)
__device__ __forceinline__ u32x2 pk4(const f32x4 v) { u32x2 w; w.x = pk2(v[0], v[1]); w.y = pk2(v[2], v[3]); return w; }
__device__ __forceinline__ f32x4 up4(const u32x2 w) { return (f32x4){bflo(w.x), bfhi(w.x), bflo(w.y), bfhi(w.y)}; }

struct EpiWin { static constexpr bool PERM = true; unsigned char* ws;
    __device__ __forceinline__ void operator()(EPI_ARGS) const { bf16_t* H1 = (bf16_t*)(ws + WS_H1); bf16_t* HG = (bf16_t*)(ws + WS_HG);
        const bool gates = u.pn >= 19; bf16_t* base = gates ? HG : H1; const int ldc = gates ? HGW : H1W; const int colt = (gates ? u.pn - 19 : u.pn) * 256 + wc * 32 + 8 * fq;
        EPI_ROWS { bf16_t* rowp = base + (size_t)EPI_ROW * ldc + colt;
#pragma unroll
            for (int bj = 0; bj < 2; ++bj) { f32x4 v0 = acc[ai][bj][m][0], v1 = acc[ai][bj][m][1];
                if (gates) {
#pragma unroll
                    for (int i = 0; i < 4; ++i) { v0[i] = sigmoidf_(v0[i]); v1[i] = sigmoidf_(v1[i]); } }
                u32x4 w; w.x = pk2(v0[0], v0[1]); w.y = pk2(v0[2], v0[3]); w.z = pk2(v1[0], v1[1]); w.w = pk2(v1[2], v1[3]);
                *(u32x4*)(rowp + bj * 128) = w; } }
    } };

struct EpiLora1 { static constexpr bool PERM = false; const float* w0; const float* a0; const float* ka; unsigned char* ws;
    __device__ __forceinline__ void operator()(EPI_ARGS) const {
        const bf16_t* KK = (const bf16_t*)(ws + WS_KK); const bf16_t* K = (const bf16_t*)(ws + WS_K); bf16_t* E = (bf16_t*)(ws + WS_E); bf16_t* BV = (bf16_t*)(ws + WS_BV); bf16_t* KD = (bf16_t*)(ws + WS_KD);
        const int seg = u.pn / 3; const int j0 = (u.pn % 3) * 256 + wc * 32 + 4 * fq;
        if (seg < 2) { const float* w0s = w0 + seg * RW; bf16_t* Es = E + (size_t)seg * T * RW;
            EPI_ROWS { const size_t ro = (size_t)EPI_ROW * RW;
#pragma unroll
                for (int bj = 0; bj < 2; ++bj)
#pragma unroll
                    for (int n = 0; n < 2; ++n) { const int j = j0 + bj * 128 + n * 16; const f32x4 v = acc[ai][bj][m][n]; f32x4 o; const f32x4 b = *(const f32x4*)(w0s + j);
#pragma unroll
                        for (int i = 0; i < 4; ++i) { const float z = b[i] + v[i]; o[i] = -0.6065306597126334f * sigmoidf_(z); }
                        *(u32x2*)(Es + ro + j) = pk4(o); } }
        } else { const int d = seg - 2; const float* a0s = a0 + d * RW; bf16_t* BVs = BV + (size_t)d * T * RW; bf16_t* KDs = KD + (size_t)d * T * RW;
            f32x4 bq[4], kaq[4];
#pragma unroll
            for (int x_ = 0; x_ < 4; ++x_) { const int j = j0 + (x_ >> 1) * 128 + (x_ & 1) * 16; bq[x_] = *(const f32x4*)(a0s + j); kaq[x_] = *(const f32x4*)(ka + j); }
            const size_t row0 = (size_t)u.pm * 256 + wr * 64 + fr; u32x2 kkq[2][4], kq_[2][4];
#define EL_LD(rr, b_) do { const size_t ro_ = (row0 + ((rr) >> 2) * 128 + ((rr) & 3) * 16) * RW; _Pragma("unroll") for (int x_ = 0; x_ < 4; ++x_) { const int j_ = j0 + (x_ >> 1) * 128 + (x_ & 1) * 16; kkq[b_][x_] = *(const u32x2*)(KK + ro_ + j_); kq_[b_][x_] = *(const u32x2*)(K + ro_ + j_); } } while (0)
            EL_LD(0, 0);
#pragma unroll
            for (int rr = 0; rr < 8; ++rr) { const int ai = rr >> 2, m = rr & 3; const size_t ro = (row0 + ai * 128 + m * 16) * RW;
                if (rr < 7) EL_LD(rr + 1, (rr + 1) & 1);
#pragma unroll
                for (int x_ = 0; x_ < 4; ++x_) { const int bj = x_ >> 1, n = x_ & 1; const int j = j0 + bj * 128 + n * 16; const f32x4 v = acc[ai][bj][m][n]; f32x4 o, o2; const f32x4 kk = up4(kkq[rr & 1][x_]), k = up4(kq_[rr & 1][x_]);
#pragma unroll
                    for (int i = 0; i < 4; ++i) { const float a = sigmoidf_(bq[x_][i] + v[i]); o[i] = a * kk[i]; o2[i] = k[i] * (1.0f + (a - 1.0f) * kaq[x_][i]); }
                    *(u32x2*)(BVs + ro + j) = pk4(o); *(u32x2*)(KDs + ro + j) = pk4(o2); } }
#undef EL_LD
        }
    } };

struct EpiLora2 { static constexpr bool PERM = false; const float* vb; unsigned char* ws;
    __device__ __forceinline__ void operator()(EPI_ARGS) const { bf16_t* G = (bf16_t*)(ws + WS_G); bf16_t* V = (bf16_t*)(ws + WS_V); const bf16_t* VF = (const bf16_t*)(ws + WS_VF);
        const int seg = u.pn / 3; const int j0 = (u.pn % 3) * 256 + wc * 32 + 4 * fq; const size_t row0 = (size_t)u.pm * 256 + wr * 64 + fr;
        if (seg == 0) {
            EPI_ROWS { const size_t ro = (size_t)EPI_ROW * RW;
#pragma unroll
                for (int x_ = 0; x_ < 4; ++x_) *(u32x2*)(G + ro + j0 + (x_ >> 1) * 128 + (x_ & 1) * 16) = pk4(acc[ai][x_ >> 1][m][x_ & 1]); }
        } else { f32x4 bq[4]; u32x2 vq[2][4], fq_[2][4];
#pragma unroll
            for (int x_ = 0; x_ < 4; ++x_) bq[x_] = *(const f32x4*)(vb + j0 + (x_ >> 1) * 128 + (x_ & 1) * 16);
#define E2_LD(rr, b_) do { const size_t ro_ = (row0 + ((rr) >> 2) * 128 + ((rr) & 3) * 16) * RW; _Pragma("unroll") for (int x_ = 0; x_ < 4; ++x_) { const int j_ = j0 + (x_ >> 1) * 128 + (x_ & 1) * 16; vq[b_][x_] = *(const u32x2*)(V + ro_ + j_); fq_[b_][x_] = *(const u32x2*)(VF + ro_ + j_); } } while (0)
            E2_LD(0, 0);
#pragma unroll
            for (int rr = 0; rr < 8; ++rr) { const int ai = rr >> 2, m = rr & 3; const size_t ro = (row0 + ai * 128 + m * 16) * RW;
                if (rr < 7) E2_LD(rr + 1, (rr + 1) & 1);
#pragma unroll
                for (int x_ = 0; x_ < 4; ++x_) { const int j = j0 + (x_ >> 1) * 128 + (x_ & 1) * 16; const f32x4 v = acc[ai][x_ >> 1][m][x_ & 1]; const f32x4 vv = up4(vq[rr & 1][x_]), vf = up4(fq_[rr & 1][x_]); f32x4 o;
#pragma unroll
                    for (int i = 0; i < 4; ++i) { const float g = sigmoidf_(bq[x_][i] + v[i]); o[i] = vv[i] + (vf[i] - vv[i]) * g; }
                    *(u32x2*)(V + ro + j) = pk4(o); } }
#undef E2_LD
        }
    } };

struct EpiLru { static constexpr bool PERM = false; const float* ba; const float* bx; const float* lam; unsigned char* ws;
    __device__ __forceinline__ void operator()(EPI_ARGS) const { bf16_t* LOGA = (bf16_t*)(ws + WS_LOGA); bf16_t* IG = (bf16_t*)(ws + WS_IG);
        const int gp = u.pn >> 2, q = u.pn & 3, b = q >> 1;
        f32x4 bias[2][2], sp8[2][2];
#pragma unroll
        for (int bj = 0; bj < 2; ++bj)
#pragma unroll
            for (int n = 0; n < 2; ++n) { const int kind = (q & 1) * 2 + bj, d = kind & 1; const int ch = (2 * gp + b) * 128 + wc * 32 + n * 16 + 4 * fq;
                bias[bj][n] = *(const f32x4*)((kind < 2 ? ba : bx) + d * LW + ch); const f32x4 lm = *(const f32x4*)(lam + d * LW + ch);
#pragma unroll
                for (int i = 0; i < 4; ++i) sp8[bj][n][i] = -8.0f * softplusf_(-lm[i]); }
        EPI_ROWS { const size_t ro = (size_t)EPI_ROW * LW;
#pragma unroll
            for (int bj = 0; bj < 2; ++bj)
#pragma unroll
                for (int n = 0; n < 2; ++n) { const int kind = (q & 1) * 2 + bj, d = kind & 1; const int ch = (2 * gp + b) * 128 + wc * 32 + n * 16 + 4 * fq; const f32x4 v = acc[ai][bj][m][n]; f32x4 o;
#pragma unroll
                    for (int i = 0; i < 4; ++i) { const float sg = sigmoidf_(v[i] + bias[bj][n][i]); o[i] = kind < 2 ? sg * sp8[bj][n][i] : sg; }
                    *(u32x2*)((kind < 2 ? LOGA : IG) + (size_t)d * T * LW + ro + ch) = pk4(o); } }
    } };

struct EpiMlaQ { static constexpr bool PERM = false; unsigned char* ws;
    __device__ __forceinline__ void operator()(EPI_ARGS) const { const float* COS = (const float*)(ws + WS_COS); const float* SIN = (const float*)(ws + WS_SIN); bf16_t* Q = (bf16_t*)(ws + WS_Q);
        EPI_ROWS { const int row = EPI_ROW; bf16_t* rowp = Q + (size_t)row * QW;
#pragma unroll
            for (int bj = 0; bj < 2; ++bj) { const int gb = u.pn * 256 + bj * 128 + wc * 32; const int cc = gb % 192;
                if (cc < 128) {
#pragma unroll
                    for (int n = 0; n < 2; ++n) { f32x4 v = acc[ai][bj][m][n]; v[0] *= QSCALE; v[1] *= QSCALE; v[2] *= QSCALE; v[3] *= QSCALE; *(u32x2*)(rowp + gb + n * 16 + 4 * fq) = pk4(v); }
                } else { const int g = (cc - 128) >> 5; const int j = 16 * g + 4 * fq; const f32x4 c = *(const f32x4*)(COS + (size_t)row * 32 + j), s = *(const f32x4*)(SIN + (size_t)row * 32 + j);
                    const f32x4 x1 = acc[ai][bj][m][0], x2 = acc[ai][bj][m][1]; f32x4 o1, o2;
#pragma unroll
                    for (int i = 0; i < 4; ++i) { o1[i] = (x1[i] * c[i] - x2[i] * s[i]) * QSCALE; o2[i] = (x1[i] * s[i] + x2[i] * c[i]) * QSCALE; }
                    *(u32x2*)(rowp + gb + 4 * fq) = pk4(o1); *(u32x2*)(rowp + gb + 16 + 4 * fq) = pk4(o2); } } }
    } };

struct EpiMerge { static constexpr bool PERM = true; unsigned char* ws; int step;
    __device__ __forceinline__ void operator()(EPI_ARGS) const { const bf16_t* HG = (const bf16_t*)(ws + WS_HG); bf16_t* MG = (bf16_t*)(ws + WS_MERGED);
        const int c0 = u.pn * 256 + wc * 32 + 8 * fq; const size_t row0 = (size_t)u.pm * 256 + wr * 64 + fr;
        u32x4 gq[2][2], pq[2][2];
#define EM_LD(rr, b_) do { const size_t row_ = row0 + ((rr) >> 2) * 128 + ((rr) & 3) * 16; _Pragma("unroll") for (int x_ = 0; x_ < 2; ++x_) { const int c_ = c0 + x_ * 128; \
            gq[b_][x_] = *(const u32x4*)(HG + row_ * HGW + step * DM + c_); pq[b_][x_] = step > 0 ? *(const u32x4*)(MG + row_ * DM + c_) : (u32x4){0u, 0u, 0u, 0u}; } } while (0)
        EM_LD(0, 0);
#pragma unroll
        for (int rr = 0; rr < 8; ++rr) { const int ai = rr >> 2, m = rr & 3; const size_t row = row0 + ai * 128 + m * 16;
            if (rr < 7) EM_LD(rr + 1, (rr + 1) & 1);
#pragma unroll
            for (int bj = 0; bj < 2; ++bj) { float g[8], p[8]; unpack8(gq[rr & 1][bj], g); unpack8(pq[rr & 1][bj], p); const f32x4 v0 = acc[ai][bj][m][0], v1 = acc[ai][bj][m][1]; float o[8];
#pragma unroll
                for (int i = 0; i < 4; ++i) { o[i] = v0[i] * g[i] + p[i]; o[4 + i] = v1[i] * g[4 + i] + p[4 + i]; }
                *(u32x4*)(MG + row * DM + c0 + bj * 128) = pack8(o); } }
#undef EM_LD
    } };

struct EpiWout { static constexpr bool PERM = false; float* X; float* Y;
    __device__ __forceinline__ void operator()(EPI_ARGS) const {
        const int c0 = u.pn * 256 + wc * 32 + 4 * fq; const size_t row0 = (size_t)u.pm * 256 + wr * 64 + fr;
        f32x4 xq[2][4];
#define EW_LD(rr, b_) do { const float* rp_ = X + (row0 + ((rr) >> 2) * 128 + ((rr) & 3) * 16) * DM + c0; _Pragma("unroll") for (int x_ = 0; x_ < 4; ++x_) xq[b_][x_] = *(const f32x4*)(rp_ + (x_ >> 1) * 128 + (x_ & 1) * 16); } while (0)
        EW_LD(0, 0);
#pragma unroll
        for (int rr = 0; rr < 8; ++rr) { const int ai = rr >> 2, m = rr & 3; float* rowq = Y + (row0 + ai * 128 + m * 16) * DM + c0;
            if (rr < 7) EW_LD(rr + 1, (rr + 1) & 1);
#pragma unroll
            for (int x_ = 0; x_ < 4; ++x_) *(f32x4*)(rowq + (x_ >> 1) * 128 + (x_ & 1) * 16) = xq[rr & 1][x_] + acc[ai][x_ >> 1][m][x_ & 1]; }
#undef EW_LD
    } };

struct EpiMoeUp { static constexpr bool PERM = false; unsigned char* ws;
    __device__ __forceinline__ void operator()(EPI_ARGS) const { bf16_t* HDN = (bf16_t*)(ws + WS_HDN);
        EPI_ROWS { bf16_t* rowp = HDN + (size_t)EPI_ROW * FF;
#pragma unroll
            for (int bj = 0; bj < 2; ++bj) { const int gb = u.pn * 256 + bj * 128 + wc * 32; const int jb = (gb >> 5) * 16 + 4 * fq; const f32x4 g = acc[ai][bj][m][0], uu = acc[ai][bj][m][1]; f32x4 o;
#pragma unroll
                for (int i = 0; i < 4; ++i) o[i] = g[i] * sigmoidf_(g[i]) * uu[i];
                *(u32x2*)(rowp + jb) = pk4(o); } }
    } };

struct EpiMoeDown { static constexpr bool PERM = true; unsigned char* ws;
    __device__ __forceinline__ void operator()(EPI_ARGS) const { const float* GATEV = (const float*)(ws + WS_GATEV); bf16_t* SLAB = (bf16_t*)(ws + WS_SLAB);
        const int c0 = u.pn * 256 + wc * 32 + 8 * fq; const size_t row0 = (size_t)u.pm * 256 + wr * 64 + fr; float gvv[8];
#pragma unroll
        for (int rr = 0; rr < 8; ++rr) gvv[rr] = GATEV[row0 + (rr >> 2) * 128 + (rr & 3) * 16];
#pragma unroll
        for (int rr = 0; rr < 8; ++rr) { const int ai = rr >> 2, m = rr & 3; const float gv = gvv[rr]; bf16_t* rowp = SLAB + (row0 + ai * 128 + m * 16) * DM + c0;
#pragma unroll
            for (int bj = 0; bj < 2; ++bj) { const f32x4 v0 = acc[ai][bj][m][0], v1 = acc[ai][bj][m][1];
                u32x4 w; w.x = pk2(v0[0] * gv, v0[1] * gv); w.y = pk2(v0[2] * gv, v0[3] * gv); w.z = pk2(v1[0] * gv, v1[1] * gv); w.w = pk2(v1[2] * gv, v1[3] * gv);
                *(u32x4*)(rowp + bj * 128) = w; } }
    } };

template <class Epi> __device__ __forceinline__ void run_gemm(const Frame& F, const Epi& E, const void* A, int lda, const void* B, int ldb, int K, int nM, int nN,
                                                              size_t am, size_t an, size_t bm, size_t bn, int ash, int bsh, int reps = 1) {
    AddrLin ad; ad.A = (const char*)A; ad.B = (const char*)B; ad.am = am; ad.an = an; ad.bm = bm; ad.bn = bn; ad.ash = ash; ad.bsh = bsh;
    OrderL S; S.init(nM, nN, F.G, F.bid, ad, reps);
    pg8::Gemm g; g.K = K; g.lda = lda; g.ldb = ldb;
    pg8::gemm_phase<Epi, OrderL, true, true>(F.lds, g, S, E, F.tid, F.wave);
}

__device__ __forceinline__ void ldrow8(const bf16_t* H, int t, int col, float (&f)[8]) {
    if (t < 0 || t >= T) {
#pragma unroll
        for (int i = 0; i < 8; ++i) f[i] = 0.f;
    } else unpack8(*(const u32x4*)(H + (size_t)t * H1W + col), f);
}
__device__ __forceinline__ u32x4 ldraw8(const bf16_t* H, int t, int col) { return (t < 0 || t >= T) ? (u32x4){0u, 0u, 0u, 0u} : *(const u32x4*)(H + (size_t)t * H1W + col); }
__device__ __forceinline__ void ldf8(const float* p, float (&f)[8]) { const f32x4 a = *(const f32x4*)p, b = *(const f32x4*)(p + 4); f[0] = a[0]; f[1] = a[1]; f[2] = a[2]; f[3] = a[3]; f[4] = b[0]; f[5] = b[1]; f[6] = b[2]; f[7] = b[3]; }
__device__ __forceinline__ float tanh_fast(float x) { return 1.0f - 2.0f * __builtin_amdgcn_rcpf(1.0f + __expf(2.0f * x)); }
__device__ __forceinline__ float gelu_tanh(float x) { const float u = 0.7978845608028654f * (x + 0.044715f * x * x * x); return x * __builtin_amdgcn_rcpf(1.0f + __expf(-2.0f * u)); }

__device__ __forceinline__ void phase_prep(const Frame& F, int l, int reps) {
    const bf16_t* H1 = wsp<bf16_t>(F, WS_H1);
    const float* mu = gin(F, I_MU) + (size_t)l * 2 * RWKV_COLS; const float* k_k = gin(F, I_KK) + l * RW;
    const float* cw = gin(F, I_CONVW) + (size_t)l * 4 * LW; const float* cb = gin(F, I_CONVB) + l * LW;
    const float* qn = gin(F, I_QN) + l * 384; const float* kvn = gin(F, I_KVN) + l * 128;
    bf16_t* R = wsp<bf16_t>(F, WS_R); bf16_t* K = wsp<bf16_t>(F, WS_K); bf16_t* V = wsp<bf16_t>(F, WS_V); bf16_t* VF = wsp<bf16_t>(F, WS_VF); bf16_t* KK = wsp<bf16_t>(F, WS_KK);
    bf16_t* AL = wsp<bf16_t>(F, WS_AL); bf16_t* XC = wsp<bf16_t>(F, WS_XC); bf16_t* GB = wsp<bf16_t>(F, WS_GB); bf16_t* AM = wsp<bf16_t>(F, WS_AM); bf16_t* KV = wsp<bf16_t>(F, WS_KV);
    const float* COS = wsp<float>(F, WS_COS); const float* SIN = wsp<float>(F, WS_SIN);
    const int lane = F.lane;
    for (int t_ = F.gw; t_ < T * reps; t_ += F.nw) { const int t = t_ % T;
        u32x4 rwp[6], rwv[6], rwn[6];
#pragma unroll
        for (int it = 0; it < 6; ++it) { const int q = it * 64 + lane; const int col = q < 336 ? q * 8 : 0; rwp[it] = ldraw8(H1, t, col); rwv[it] = ldraw8(H1, t - 1, col); rwn[it] = ldraw8(H1, t + 1, col); }
#pragma unroll
        for (int it = 0; it < 6; ++it) { const int q = it * 64 + lane; const bool on = q < 336; const int col = on ? q * 8 : 0;
            float p[8], pv[8], nx[8], m0[8], m1[8], o[8];
            unpack8(rwp[it], p); unpack8(rwv[it], pv); unpack8(rwn[it], nx); ldf8(mu + col, m0); ldf8(mu + RWKV_COLS + col, m1);
#pragma unroll
            for (int i = 0; i < 8; ++i) o[i] = p[i] + m0[i] * (pv[i] - p[i]) + m1[i] * (nx[i] - p[i]);
            const bool isk = on && col >= 768 && col < 1536; const int j = isk ? col - 768 : 0;
            float kw[8], x[8]; ldf8(k_k + j, kw); float ss = 0.f;
#pragma unroll
            for (int i = 0; i < 8; ++i) { x[i] = o[i] * kw[i]; ss += x[i] * x[i]; }
            ss += shx(ss, 1, lane); ss += shx(ss, 2, lane); ss += shx(ss, 4, lane);
            if (on) {
                if (col < 768) *(u32x4*)(R + (size_t)t * RW + col) = pack8(o);
                else if (col < 1536) { *(u32x4*)(K + (size_t)t * RW + j) = pack8(o); const float inv = 1.0f / fmaxf(sqrtf(ss), 1e-12f);
#pragma unroll
                    for (int i = 0; i < 8; ++i) x[i] *= inv;
                    *(u32x4*)(KK + (size_t)t * RW + j) = pack8(x); }
                else if (col < 2304) { const u32x4 w = pack8(o); *(u32x4*)(V + (size_t)t * RW + col - 1536) = w; if (l == 0) *(u32x4*)(VF + (size_t)t * RW + col - 1536) = w; }
                else { const int ac = col - 2304;
                    if (ac < 128) {
#pragma unroll
                        for (int i = 0; i < 8; ++i) o[i] = tanh_fast(o[i]);
                    } else if (ac >= 256) {
#pragma unroll
                        for (int i = 0; i < 8; ++i) o[i] = sigmoidf_(o[i]);
                    }
                    *(u32x4*)(AL + (size_t)t * 512 + ac) = pack8(o); }
            } }
        if (lane < 16) { u32x4 w = (u32x4){0u, 0u, 0u, 0u}; if (lane < 4 && l > 0) w = *(const u32x4*)(H1 + (size_t)t * H1W + 4800 + lane * 8); *(u32x4*)(AL + (size_t)t * 512 + 384 + lane * 8) = w; }
        u32x4 lr0[2], lr1[2], lr2[2], lr3[2], lgb[2], mq, mk;
#pragma unroll
        for (int it = 0; it < 2; ++it) { const int q = it * 64 + lane; const int c = q < 96 ? q * 8 : 0; lr0[it] = ldraw8(H1, t - 1, 2688 + c); lr1[it] = ldraw8(H1, t, 2688 + c); lr2[it] = ldraw8(H1, t + 1, 2688 + c); lr3[it] = ldraw8(H1, t + 2, 2688 + c); lgb[it] = ldraw8(H1, t, 3456 + c); }
        mq = ldraw8(H1, lane < 48 ? t : -1, 4224 + (lane < 48 ? lane * 8 : 0)); mk = ldraw8(H1, lane < 24 ? t : -1, 4608 + (lane < 24 ? lane * 8 : 0));
#pragma unroll
        for (int it = 0; it < 2; ++it) { const int q = it * 64 + lane;
            if (q < 96) { const int c = q * 8; float a0[8], a1[8], a2[8], a3[8], w0[8], w1[8], w2[8], w3[8], b[8], o[8];
                unpack8(lr0[it], a0); unpack8(lr1[it], a1); unpack8(lr2[it], a2); unpack8(lr3[it], a3);
                ldf8(cw + c, w0); ldf8(cw + LW + c, w1); ldf8(cw + 2 * LW + c, w2); ldf8(cw + 3 * LW + c, w3); ldf8(cb + c, b);
#pragma unroll
                for (int i = 0; i < 8; ++i) o[i] = b[i] + w0[i] * a0[i] + w1[i] * a1[i] + w2[i] * a2[i] + w3[i] * a3[i];
                *(u32x4*)(XC + (size_t)t * LW + c) = pack8(o);
                unpack8(lgb[it], a0);
#pragma unroll
                for (int i = 0; i < 8; ++i) o[i] = gelu_tanh(a0[i]);
                *(u32x4*)(GB + (size_t)t * LW + c) = pack8(o); } }
        { float p[8]; float ss = 0.f; const bool on = lane < 48; unpack8(mq, p);
#pragma unroll
          for (int i = 0; i < 8; ++i) ss += p[i] * p[i];
          ss = wave_sum(ss); const float rstd = rsqrtf(ss * (1.0f / 384.0f) + 1e-6f);
          if (on) { float g[8]; ldf8(qn + lane * 8, g);
#pragma unroll
              for (int i = 0; i < 8; ++i) p[i] = p[i] * rstd * g[i];
              *(u32x4*)(AM + (size_t)t * 384 + lane * 8) = pack8(p); } }
        { float p[8]; float ss = 0.f; const bool on = lane < 24; unpack8(mk, p);
          if (lane < 16) {
#pragma unroll
              for (int i = 0; i < 8; ++i) ss += p[i] * p[i]; }
          ss = wave_sum(ss); const float rstd = rsqrtf(ss * (1.0f / 128.0f) + 1e-6f);
          float oth[8];
#pragma unroll
          for (int i = 0; i < 8; ++i) oth[i] = shx(p[i], 4, lane);
          if (lane < 16) { float g[8]; ldf8(kvn + lane * 8, g);
#pragma unroll
              for (int i = 0; i < 8; ++i) p[i] = p[i] * rstd * g[i];
              *(u32x4*)(KV + (size_t)t * KVW + lane * 8) = pack8(p); }
          else if (lane < 24) { const int i4 = lane - 16, ii = i4 & 3; float c[8], s[8], o[8]; ldf8(COS + (size_t)t * 32 + ii * 8, c); ldf8(SIN + (size_t)t * 32 + ii * 8, s);
              if (i4 < 4) {
#pragma unroll
                  for (int i = 0; i < 8; ++i) o[i] = p[i] * c[i] - oth[i] * s[i];
                  *(u32x4*)(KV + (size_t)t * KVW + 128 + 32 * (ii >> 1) + 8 * (ii & 1)) = pack8(o);
              } else {
#pragma unroll
                  for (int i = 0; i < 8; ++i) o[i] = oth[i] * s[i] + p[i] * c[i];
                  *(u32x4*)(KV + (size_t)t * KVW + 128 + 32 * (ii >> 1) + 16 + 8 * (ii & 1)) = pack8(o);
              } } }
    }
}

__device__ __forceinline__ float ldbf(const bf16_t* p) { return bf2f((unsigned)*p); }
__device__ __forceinline__ void phase_lru_local(const Frame& F, int reps) {
    const bf16_t* LOGA = wsp<bf16_t>(F, WS_LOGA); const bf16_t* IG = wsp<bf16_t>(F, WS_IG); const bf16_t* XC = wsp<bf16_t>(F, WS_XC);
    float* LA = wsp<float>(F, WS_LA); float* LB = wsp<float>(F, WS_LB);
    for (int idx_ = F.bid * NTHR + F.tid; idx_ < 2 * NCH * LW * reps; idx_ += F.G * NTHR) { const int idx = idx_ % (2 * NCH * LW); const int ch = idx % LW, c = (idx / LW) % NCH, d = idx / (LW * NCH);
        float asum = 0.f, h = 0.f; const bf16_t* la = LOGA + (size_t)d * T * LW + ch; const bf16_t* ig = IG + (size_t)d * T * LW + ch;
        for (int s = 0; s < CL; ++s) { const int t = d == 0 ? c * CL + s : c * CL + CL - 1 - s; const float l_ = ldbf(la + (size_t)t * LW);
            const float a = __expf(l_), b = sqrtf(fmaxf(1.0f - a * a, 0.f)) * ldbf(ig + (size_t)t * LW) * ldbf(XC + (size_t)t * LW + ch); h = a * h + b; asum += l_; }
        LA[idx] = __expf(asum); LB[idx] = h; }
}
__device__ __forceinline__ void phase_lru_carry(const Frame& F, int bid0) {
    const float* LA = wsp<float>(F, WS_LA); const float* LB = wsp<float>(F, WS_LB); float* LH0 = wsp<float>(F, WS_LH0);
    const int idx = (F.bid - bid0) * NTHR + F.tid; if (idx < 0 || idx >= 2 * LW) return; const int ch = idx % LW, d = idx / LW; float h = 0.f;
    for (int k = 0; k < NCH; ++k) { const int c = d == 0 ? k : NCH - 1 - k; const int o = (d * NCH + c) * LW + ch; LH0[o] = h; h = LA[o] * h + LB[o]; }
}
__device__ __forceinline__ void phase_lru_out(const Frame& F, int reps) {
    const bf16_t* LOGA = wsp<bf16_t>(F, WS_LOGA); const bf16_t* IG = wsp<bf16_t>(F, WS_IG); const bf16_t* XC = wsp<bf16_t>(F, WS_XC); const bf16_t* GB = wsp<bf16_t>(F, WS_GB);
    const float* LH0 = wsp<float>(F, WS_LH0); bf16_t* YB = wsp<bf16_t>(F, WS_YB);
    for (int idx_ = (F.G - 1 - F.bid) * NTHR + F.tid; idx_ < NCH * LW * reps; idx_ += F.G * NTHR) { const int idx = idx_ % (NCH * LW); const int ch = idx % LW, c = idx / LW; float hf[CL];
        { float h = LH0[(0 * NCH + c) * LW + ch]; int o0 = c * CL * LW + ch; asm volatile("" : "+v"(o0)); const bf16_t* pl = LOGA + o0; const bf16_t* pi = IG + o0; const bf16_t* px = XC + o0;
#pragma unroll
          for (int s = 0; s < CL; ++s) { const float l_ = ldbf(pl + s * LW); const float a = __expf(l_), b = sqrtf(fmaxf(1.0f - a * a, 0.f)) * ldbf(pi + s * LW) * ldbf(px + s * LW); h = a * h + b; hf[s] = h; } }
        { float h = LH0[(1 * NCH + c) * LW + ch]; int o0 = c * CL * LW + ch; asm volatile("" : "+v"(o0)); const bf16_t* pl = LOGA + (size_t)T * LW + o0; const bf16_t* pi = IG + (size_t)T * LW + o0; const bf16_t* px = XC + o0; const bf16_t* pg = GB + o0; bf16_t* py = YB + o0;
#pragma unroll
          for (int sg = CL - 8; sg >= 0; sg -= 8) { float lv[8], iv[8], xv[8], gv[8];
#pragma unroll
              for (int q = 0; q < 8; ++q) { lv[q] = ldbf(pl + (sg + q) * LW); iv[q] = ldbf(pi + (sg + q) * LW); xv[q] = ldbf(px + (sg + q) * LW); gv[q] = ldbf(pg + (sg + q) * LW); }
#pragma unroll
              for (int q = 7; q >= 0; --q) { const int s = sg + q; const float a = __expf(lv[q]), b = sqrtf(fmaxf(1.0f - a * a, 0.f)) * iv[q] * xv[q]; h = a * h + b;
                  py[s * LW] = (bf16_t)f2bf((hf[s] + h) * gv[q]); } } } }
}

namespace wy {
constexpr int RS = 144, MSZ = 64 * RS;
constexpr int O_KK = 0, O_BT = MSZ, O_KT = 2 * MSZ, O_RT = 3 * MSZ, O_BH = 4 * MSZ, O_KH = 5 * MSZ, O_V = 6 * MSZ, O_KKT = 7 * MSZ, O_AKB = 8 * MSZ, O_ABR = 9 * MSZ, O_AT = 10 * MSZ, O_A = 11 * MSZ, O_S12 = 12 * MSZ,
              O_TOT = O_S12, O_GAM = 13 * MSZ, O_END = O_GAM + 256;
constexpr int O_D = O_BT, O_DT = O_KT, O_UT = O_KK, O_M32 = O_AT, O_M32T = O_S12, O_M64T = O_BT, O_P = O_KT, O_Q = O_A, O_ZY = O_KKT, O_X1 = O_AKB;
static_assert(O_END <= 131072, "wy lds");
__device__ __forceinline__ int crow(int r, int hi) { return (r & 3) + 8 * (r >> 2) + 4 * hi; }
__device__ __forceinline__ f32x16 tile_mm(const LAS char* Aop, int m0, const LAS char* Bop, int n0, int lane) {
    f32x16 acc = (f32x16)(0.f); const int r = lane & 31, hh = lane >> 5;
#pragma unroll
    for (int ks = 0; ks < 4; ++ks) { const bf16x8 a = *(const LAS bf16x8*)(Aop + (m0 + r) * RS + (ks * 16 + hh * 8) * 2), b = *(const LAS bf16x8*)(Bop + (n0 + r) * RS + (ks * 16 + hh * 8) * 2);
        acc = __builtin_amdgcn_mfma_f32_32x32x16_bf16(a, b, acc, 0, 0, 0); }
    return acc;
}
__device__ __forceinline__ void store_t_bf16(LAS char* dst, const f32x16& c, int m0, int n0, int lane) {
    LAS char* p = dst + (n0 + (lane & 31)) * RS + (m0 + 4 * (lane >> 5)) * 2;
#pragma unroll
    for (int g = 0; g < 4; ++g) { u32x2 w; w.x = pk2(c[4 * g], c[4 * g + 1]); w.y = pk2(c[4 * g + 2], c[4 * g + 3]); *(LAS u32x2*)(p + 16 * g) = w; }
}
__device__ __forceinline__ void store_n_bf16(LAS char* dst, const f32x16& c, int m0, int n0, int lane) {
    LAS char* p = dst + (m0 + 4 * (lane >> 5)) * RS + (n0 + (lane & 31)) * 2;
#pragma unroll
    for (int r = 0; r < 16; ++r) *(LAS bf16_t*)(p + ((r & 3) + 8 * (r >> 2)) * RS) = (bf16_t)f2bf(c[r]);
}
__device__ __forceinline__ f32x16 load_acc_from_t(const LAS char* xt, int m0, int n0, int lane) {
    f32x16 v; const LAS char* p = xt + (n0 + (lane & 31)) * RS + (m0 + 4 * (lane >> 5)) * 2;
#pragma unroll
    for (int g = 0; g < 4; ++g) { const f32x4 t4 = up4(*(const LAS u32x2*)(p + 16 * g)); v[4 * g] = t4[0]; v[4 * g + 1] = t4[1]; v[4 * g + 2] = t4[2]; v[4 * g + 3] = t4[3]; }
    return v;
}
}

__device__ __forceinline__ void phase_rwkv_local(const Frame& F, int reps) {
    using namespace wy;
    const bf16_t* E = wsp<bf16_t>(F, WS_E); const bf16_t* BV = wsp<bf16_t>(F, WS_BV); const bf16_t* KKg = wsp<bf16_t>(F, WS_KK); const bf16_t* KD = wsp<bf16_t>(F, WS_KD); const bf16_t* V = wsp<bf16_t>(F, WS_V); const bf16_t* R = wsp<bf16_t>(F, WS_R);
    bf16_t* AF = wsp<bf16_t>(F, WS_AF); float* GT = wsp<float>(F, WS_GT); bf16_t* WY = wsp<bf16_t>(F, WS_WY); float* YF = wsp<float>(F, WS_YF);
    LAS char* L = (LAS char*)F.lds;
    for (int task_ = F.bid; task_ < 2 * NH * NCH * reps; task_ += F.G) { const int task = task_ % (2 * NH * NCH); const int c = task % NCH, hd = task / NCH, h = hd % NH, d = hd / NH;
        int tid = F.tid; asm volatile("" : "+v"(tid)); const int lane = tid & 63, wv = F.wave;
        { const int j = tid & 63, sb = tid >> 6; float ev[8], bb[8], kkv[8], kv[8], rv[8], vv[8], lg[8];
          const size_t od = (size_t)d * T * RW;
#pragma unroll
          for (int q = 0; q < 8; ++q) { const int s_ = 8 * sb + q; const int tt = d == 0 ? c * CL + s_ : c * CL + CL - 1 - s_; const size_t o = (size_t)tt * RW + h * HD + j;
              ev[q] = ldbf(E + od + o); bb[q] = ldbf(BV + od + o); kkv[q] = ldbf(KKg + o); kv[q] = ldbf(KD + od + o); rv[q] = ldbf(R + o); vv[q] = ldbf(V + o); }
          float run = 0.f;
#pragma unroll
          for (int q = 0; q < 8; ++q) { run += ev[q]; lg[q] = run; }
          LAS float* tot = (LAS float*)(L + O_TOT); tot[sb * 64 + j] = run;
          __syncthreads();
          float offs = 0.f, total = 0.f;
#pragma unroll
          for (int q = 0; q < 8; ++q) { const float t_ = tot[q * 64 + j]; total += t_; offs += (q < sb) ? t_ : 0.f; }
          float fkk[8], fbh[8], fkh[8];
#pragma unroll
          for (int q = 0; q < 8; ++q) { const int s_ = 8 * sb + q; const float lgq = lg[q] + offs; const float gi = __expf(-lgq), gl = __expf(total - lgq);
              fkk[q] = kkv[q] * __expf(lgq - ev[q]); fbh[q] = bb[q] * gl; fkh[q] = kv[q] * gl;
              *(LAS bf16_t*)(L + O_KK + s_ * RS + j * 2) = (bf16_t)f2bf(fkk[q]); *(LAS bf16_t*)(L + O_BT + s_ * RS + j * 2) = (bf16_t)f2bf(bb[q] * gi);
              *(LAS bf16_t*)(L + O_KT + s_ * RS + j * 2) = (bf16_t)f2bf(kv[q] * gi); *(LAS bf16_t*)(L + O_RT + s_ * RS + j * 2) = (bf16_t)f2bf(rv[q] * __expf(lgq)); }
          *(LAS u32x4*)(L + O_BH + j * RS + sb * 16) = pack8(fbh); *(LAS u32x4*)(L + O_KH + j * RS + sb * 16) = pack8(fkh);
          *(LAS u32x4*)(L + O_V + j * RS + sb * 16) = pack8(vv); *(LAS u32x4*)(L + O_KKT + j * RS + sb * 16) = pack8(fkk);
          if (sb == 0) ((LAS float*)(L + O_GAM))[j] = __expf(total);
        }
        __syncthreads();
        const int M0 = 32 * (wv & 1), N0 = 32 * ((wv >> 1) & 1), hh = lane >> 5, ln = lane & 31;
        f32x16 akr = (f32x16)(0.f);
        if (wv < 4) {
            { f32x16 cc = tile_mm(L + O_BT, M0, L + O_KK, N0, lane);
#pragma unroll
              for (int r = 0; r < 16; ++r) cc[r] = (M0 + crow(r, hh) < N0 + ln) ? cc[r] : 0.f;
              store_t_bf16(L + O_AT, cc, M0, N0, lane); store_n_bf16(L + O_A, cc, M0, N0, lane); }
            { f32x16 cc = tile_mm(L + O_KK, M0, L + O_KT, N0, lane);
#pragma unroll
              for (int r = 0; r < 16; ++r) cc[r] = (N0 + ln < M0 + crow(r, hh)) ? cc[r] : 0.f;
              store_t_bf16(L + O_AKB, cc, M0, N0, lane); }
        } else {
            { f32x16 cc = tile_mm(L + O_BT, M0, L + O_RT, N0, lane);
#pragma unroll
              for (int r = 0; r < 16; ++r) cc[r] = (M0 + crow(r, hh) <= N0 + ln) ? cc[r] : 0.f;
              store_t_bf16(L + O_ABR, cc, M0, N0, lane); }
            { akr = tile_mm(L + O_KT, M0, L + O_RT, N0, lane);
#pragma unroll
              for (int r = 0; r < 16; ++r) akr[r] = (M0 + crow(r, hh) <= N0 + ln) ? akr[r] : 0.f; }
        }
        __syncthreads();
        if (wv == 0) {
            const int b = lane >> 4, r = lane & 15; float x[16];
#pragma unroll
            for (int t = 0; t < 16; ++t) { const LAS char* cp = L + O_AT + (16 * b + t) * RS + 32 * b; float c[16]; { float f[8]; unpack8(*(const LAS u32x4*)cp, f);
#pragma unroll
                    for (int i = 0; i < 8; ++i) c[i] = f[i]; unpack8(*(const LAS u32x4*)(cp + 16), f);
#pragma unroll
                    for (int i = 0; i < 8; ++i) c[8 + i] = f[i]; }
                float a = (t == r) ? 1.f : 0.f;
#pragma unroll
                for (int q = 0; q < t; ++q) a -= x[q] * c[q];
                x[t] = a; }
            LAS char* dp = L + O_D + (16 * b + r) * RS;
#pragma unroll
            for (int q = 0; q < 8; ++q) { const unsigned z0_ = vzero(); u32x4 w = (u32x4){z0_, z0_, z0_, z0_}; if (q == 2 * b) { float f[8];
#pragma unroll
                    for (int i = 0; i < 8; ++i) f[i] = x[i]; w = pack8(f); }
                if (q == 2 * b + 1) { float f[8];
#pragma unroll
                    for (int i = 0; i < 8; ++i) f[i] = x[8 + i]; w = pack8(f); }
                *(LAS u32x4*)(dp + 16 * q) = w; }
        } else if (wv == 1) {
            const int b = lane >> 4, r = lane & 15; float y[16];
#pragma unroll
            for (int t = 15; t >= 0; --t) { const LAS char* cp = L + O_A + (16 * b + t) * RS + 32 * b; float c[16]; { float f[8]; unpack8(*(const LAS u32x4*)cp, f);
#pragma unroll
                    for (int i = 0; i < 8; ++i) c[i] = f[i]; unpack8(*(const LAS u32x4*)(cp + 16), f);
#pragma unroll
                    for (int i = 0; i < 8; ++i) c[8 + i] = f[i]; }
                float a = (t == r) ? 1.f : 0.f;
#pragma unroll
                for (int q = t + 1; q < 16; ++q) a -= y[q] * c[q];
                y[t] = a; }
            LAS char* dp = L + O_DT + (16 * b + r) * RS;
#pragma unroll
            for (int q = 0; q < 8; ++q) { const unsigned z0_ = vzero(); u32x4 w = (u32x4){z0_, z0_, z0_, z0_}; if (q == 2 * b) { float f[8];
#pragma unroll
                    for (int i = 0; i < 8; ++i) f[i] = y[i]; w = pack8(f); }
                if (q == 2 * b + 1) { float f[8];
#pragma unroll
                    for (int i = 0; i < 8; ++i) f[i] = y[8 + i]; w = pack8(f); }
                *(LAS u32x4*)(dp + 16 * q) = w; }
        }
        __syncthreads();
        if (wv < 4) { f32x16 cc = (f32x16)(0.f);
            if (M0 == N0) { cc = tile_mm(L + O_A, M0, L + O_DT, N0, lane);
#pragma unroll
                for (int r = 0; r < 16; ++r) cc[r] = (((M0 + crow(r, hh)) ^ (N0 + ln)) & 16) ? cc[r] : 0.f; }
            store_t_bf16(L + O_UT, cc, M0, N0, lane); }
        __syncthreads();
        if (wv < 4) { f32x16 cc = tile_mm(L + O_D, M0, L + O_UT, N0, lane); const f32x16 dd = load_acc_from_t(L + O_DT, M0, N0, lane);
#pragma unroll
            for (int r = 0; r < 16; ++r) cc[r] = dd[r] - cc[r];
            store_n_bf16(L + O_M32, cc, M0, N0, lane); store_t_bf16(L + O_M32T, cc, M0, N0, lane); }
        __syncthreads();
        if (wv < 4) { f32x16 cc = (f32x16)(0.f);
            if (M0 == 0 && N0 == 32) cc = tile_mm(L + O_A, M0, L + O_M32T, N0, lane);
            store_t_bf16(L + O_UT, cc, M0, N0, lane); }
        __syncthreads();
        if (wv < 4) { f32x16 cc = tile_mm(L + O_M32, M0, L + O_UT, N0, lane); const f32x16 mm_ = load_acc_from_t(L + O_M32T, M0, N0, lane);
#pragma unroll
            for (int r = 0; r < 16; ++r) cc[r] = mm_[r] - cc[r];
            store_t_bf16(L + O_M64T, cc, M0, N0, lane); }
        __syncthreads();
        { const f32x16 cc = tile_mm(L + (wv < 4 ? O_KKT : O_AKB), M0, L + O_M64T, N0, lane);
          store_n_bf16(L + (wv < 4 ? O_P : O_Q), cc, M0, N0, lane); }
        __syncthreads();
        if (wv < 4) {
            { const f32x16 cc = tile_mm(L + O_P, M0, L + O_ABR, N0, lane);
              const LAS char* rp = L + O_RT + (N0 + ln) * RS + (M0 + 4 * hh) * 2; bf16_t* wp = WY + (size_t)task * 4096 + (N0 + ln) * 64 + M0 + 4 * hh;
#pragma unroll
              for (int g = 0; g < 4; ++g) { const f32x4 rt = up4(*(const LAS u32x2*)(rp + 16 * g)); u32x2 w; w.x = pk2(rt[0] - cc[4 * g], rt[1] - cc[4 * g + 1]); w.y = pk2(rt[2] - cc[4 * g + 2], rt[3] - cc[4 * g + 3]);
                  *(u32x2*)(wp + 8 * g) = w; } }
            { f32x16 cc = tile_mm(L + O_P, M0, L + O_BH, N0, lane);
              const float gm = ((const LAS float*)(L + O_GAM))[N0 + ln];
#pragma unroll
              for (int r = 0; r < 16; ++r) cc[r] = ((M0 + crow(r, hh) == N0 + ln) ? gm : 0.f) - cc[r];
              const int J = M0 >> 5, Jp = N0 >> 5;
#pragma unroll
              for (int s2 = 0; s2 < 2; ++s2) { u32x4 w; w.x = pk2(cc[8 * s2], cc[8 * s2 + 1]); w.y = pk2(cc[8 * s2 + 2], cc[8 * s2 + 3]); w.z = pk2(cc[8 * s2 + 4], cc[8 * s2 + 5]); w.w = pk2(cc[8 * s2 + 6], cc[8 * s2 + 7]);
                  *(u32x4*)(AF + (size_t)task * 4096 + (size_t)((((Jp * 2 + J) * 2 + s2) * 64 + lane) * 8)) = w; } }
        } else {
            { f32x16 cc = tile_mm(L + O_Q, M0, L + O_ABR, N0, lane);
#pragma unroll
              for (int r = 0; r < 16; ++r) cc[r] = akr[r] - cc[r];
              store_t_bf16(L + O_ZY, cc, M0, N0, lane); }
            { f32x16 cc = tile_mm(L + O_Q, M0, L + O_BH, N0, lane);
              const LAS char* kp = L + O_KH + (N0 + ln) * RS + (M0 + 4 * hh) * 2;
#pragma unroll
              for (int g = 0; g < 4; ++g) { const f32x4 kh = up4(*(const LAS u32x2*)(kp + 16 * g)); cc[4 * g] = kh[0] - cc[4 * g]; cc[4 * g + 1] = kh[1] - cc[4 * g + 1]; cc[4 * g + 2] = kh[2] - cc[4 * g + 2]; cc[4 * g + 3] = kh[3] - cc[4 * g + 3]; }
              store_t_bf16(L + O_X1, cc, M0, N0, lane); }
        }
        __syncthreads();
        if (wv < 4) { const f32x16 cc = tile_mm(L + O_X1, M0, L + O_V, N0, lane);
            float* gp = GT + (size_t)task * 4096 + (size_t)(((N0 >> 5) * 2 + (M0 >> 5)) * 16) * 64 + lane;
#pragma unroll
            for (int r = 0; r < 16; ++r) gp[r * 64] = cc[r];
        } else { const f32x16 cc = tile_mm(L + O_V, M0, L + O_ZY, N0, lane);
            const int s_ = N0 + ln; const int tt = d == 0 ? c * CL + s_ : c * CL + CL - 1 - s_; float* yp = YF + (size_t)d * T * RW + (size_t)tt * RW + h * HD + M0 + 4 * hh;
#pragma unroll
            for (int g = 0; g < 4; ++g) *(f32x4*)(yp + 8 * g) = (f32x4){cc[4 * g], cc[4 * g + 1], cc[4 * g + 2], cc[4 * g + 3]}; }
        __syncthreads();
    }
}

__device__ __forceinline__ void phase_rwkv_carry(const Frame& F, bool dry) {
    if (F.bid >= 48) return;
    const int hd = F.bid >> 1, I = F.bid & 1, d = hd / NH, lane = F.lane, wv = F.wave;
    const bf16_t* AF = wsp<bf16_t>(F, WS_AF); float* GT = wsp<float>(F, WS_GT);
    LAS char* ring = (LAS char*)F.lds;
    const bool ld = wv >= 1 && wv <= 4;
#define RC_DMA(k_, sl_) do { const int c_ = d == 0 ? (k_) : NCH - 1 - (k_); const size_t tix_ = (size_t)hd * NCH + c_; \
        _Pragma("unroll") for (int i_ = 0; i_ < 4; ++i_) { const int p_ = (wv - 1) * 4 + i_; \
            const char* g_ = p_ < 8 ? (const char*)AF + tix_ * 8192 + p_ * 1024 : (const char*)GT + tix_ * 16384 + I * 8192 + (p_ - 8) * 1024; \
            __builtin_amdgcn_global_load_lds((const unsigned*)(g_ + lane * 16), (LAS unsigned*)(ring + (sl_) * 16384 + p_ * 1024), 16, 0, 0); } } while (0)
#define RC_BAR() do { asm volatile("" ::: "memory"); __builtin_amdgcn_sched_barrier(0); __builtin_amdgcn_s_barrier(); __builtin_amdgcn_sched_barrier(0); asm volatile("" ::: "memory"); } while (0)
    constexpr int RC_NS = 6;
    if (ld) { RC_DMA(0, 0); RC_DMA(1, 1); RC_DMA(2, 2); RC_DMA(3, 3); RC_DMA(4, 4); asm volatile("s_waitcnt vmcnt(16)" ::: "memory"); }
    RC_BAR();
    bf16x8 bfr[2][2];
#pragma unroll
    for (int J = 0; J < 2; ++J)
#pragma unroll
        for (int s = 0; s < 2; ++s) bfr[J][s] = (bf16x8)(0);
    int cur = 0;
#pragma unroll 1
    for (int k = 0; k < NCH; ++k) {
        const int nx2 = cur == 0 ? RC_NS - 1 : cur - 1;
        if (ld) { if (k + RC_NS - 1 < NCH) { RC_DMA(k + RC_NS - 1, nx2); asm volatile("s_waitcnt vmcnt(16)" ::: "memory"); } else asm volatile("s_waitcnt vmcnt(0)" ::: "memory"); }
        if (wv == 0) {
            const int c = d == 0 ? k : NCH - 1 - k; const size_t tix = (size_t)hd * NCH + c;
            const LAS char* sl = ring + cur * 16384;
            u32x4 a[8]; f32x16 nw[2];
#pragma unroll
            for (int f_ = 0; f_ < 8; ++f_) a[f_] = *(const LAS u32x4*)(sl + (f_ * 64 + lane) * 16);
#pragma unroll
            for (int Jp = 0; Jp < 2; ++Jp)
#pragma unroll
                for (int r = 0; r < 16; ++r) nw[Jp][r] = *(const LAS float*)(sl + 8192 + ((Jp * 16 + r) * 64 + lane) * 4);
#pragma unroll
            for (int Jp = 0; Jp < 2; ++Jp)
#pragma unroll
                for (int J = 0; J < 2; ++J)
#pragma unroll
                    for (int s = 0; s < 2; ++s) nw[Jp] = __builtin_amdgcn_mfma_f32_32x32x16_bf16(__builtin_bit_cast(bf16x8, a[(Jp * 2 + J) * 2 + s]), bfr[J][s], nw[Jp], 0, 0, 0);
            u32x4* sp = (u32x4*)((char*)(dry ? wsp<float>(F, WS_XN) + (tix & 2047) * 4096 : GT + tix * 4096) + I * 8192);
#pragma unroll
            for (int J = 0; J < 2; ++J)
#pragma unroll
                for (int s = 0; s < 2; ++s) { u32x4 w; w.x = pk2(nw[J][8 * s + 0], nw[J][8 * s + 1]); w.y = pk2(nw[J][8 * s + 2], nw[J][8 * s + 3]); w.z = pk2(nw[J][8 * s + 4], nw[J][8 * s + 5]); w.w = pk2(nw[J][8 * s + 6], nw[J][8 * s + 7]);
                    bfr[J][s] = __builtin_bit_cast(bf16x8, w); sp[(2 * J + s) * 64 + lane] = w; }
        }
        RC_BAR();
        cur = cur == RC_NS - 1 ? 0 : cur + 1;
    }
#undef RC_DMA
#undef RC_BAR
}

__device__ __forceinline__ float half_swap_sum(float v) { auto r = __builtin_amdgcn_permlane32_swap(__float_as_uint(v), __float_as_uint(v), false, false); return __uint_as_float(r[0]) + __uint_as_float(r[1]); }
__device__ __forceinline__ void phase_rwkv_outfin(const Frame& F, int l, int reps) {
    const float* GT = wsp<float>(F, WS_GT); const bf16_t* WY = wsp<bf16_t>(F, WS_WY); const float* YF = wsp<float>(F, WS_YF);
    const bf16_t* R = wsp<bf16_t>(F, WS_R); const bf16_t* KD = wsp<bf16_t>(F, WS_KD); const bf16_t* V = wsp<bf16_t>(F, WS_V); const bf16_t* G = wsp<bf16_t>(F, WS_G); bf16_t* YA = wsp<bf16_t>(F, WS_YA);
    const float* rk = gin(F, I_RK) + l * RW; const float* lw = gin(F, I_LNW) + l * RW; const float* lb = gin(F, I_LNB) + l * RW;
    for (int task_ = F.gw; task_ < NH * NCH * reps; task_ += F.nw) { const int task = task_ % (NH * NCH); const int c = task % NCH, h = task / NCH;
        int lane = F.lane; asm volatile("" : "+v"(lane)); const int ln = lane & 31, hh = lane >> 5;
        f32x16 acc[2][2];
#pragma unroll
        for (int mb = 0; mb < 2; ++mb)
#pragma unroll
            for (int nb = 0; nb < 2; ++nb) acc[mb][nb] = (f32x16)(0.f);
#pragma unroll
        for (int d = 0; d < 2; ++d) { const int hd = d * NH + h; const int cs = d == 0 ? c - 1 : c + 1;
            if (cs >= 0 && cs < NCH) { const float* S0 = GT + ((size_t)hd * NCH + cs) * 4096; const bf16_t* wy = WY + ((size_t)hd * NCH + c) * 4096;
                bf16x8 af[2][4], bfr[2][4];
#pragma unroll
                for (int mb = 0; mb < 2; ++mb)
#pragma unroll
                    for (int ks = 0; ks < 4; ++ks) { af[mb][ks] = *(const bf16x8*)((const char*)S0 + mb * 8192 + (ks * 64 + lane) * 16);
                        const int p = mb * 32 + ln; const int srow = d == 0 ? p : CL - 1 - p; const bf16_t* wr = wy + srow * 64 + ks * 16 + 4 * hh;
                        const u32x2 w0 = *(const u32x2*)wr, w1 = *(const u32x2*)(wr + 8); bfr[mb][ks] = __builtin_bit_cast(bf16x8, (u32x4){w0.x, w0.y, w1.x, w1.y}); }
#pragma unroll
                for (int mb = 0; mb < 2; ++mb)
#pragma unroll
                    for (int nb = 0; nb < 2; ++nb)
#pragma unroll
                        for (int ks = 0; ks < 4; ++ks) acc[mb][nb] = __builtin_amdgcn_mfma_f32_32x32x16_bf16(af[mb][ks], bfr[nb][ks], acc[mb][nb], 0, 0, 0); } }
        LAS char* slab = (LAS char*)(F.lds + F.wave * 9216);
        const int fr_ = lane >> 4, fc_ = lane & 15, br_ = lane >> 3, bc_ = lane & 7;
#define OF_LDF(dst, base, t0) do { _Pragma("unroll") for (int k_ = 0; k_ < 8; ++k_) dst[k_] = *(const u32x4*)((base) + (size_t)((t0) + k_ * 4 + fr_) * RW + h * HD + fc_ * 4); } while (0)
#define OF_STF(src) do { _Pragma("unroll") for (int k_ = 0; k_ < 8; ++k_) *(LAS u32x4*)(slab + (k_ * 4 + fr_) * 272 + fc_ * 16) = src[k_]; } while (0)
#define OF_LDB(dst, base, t0) do { _Pragma("unroll") for (int k_ = 0; k_ < 4; ++k_) dst[k_] = *(const u32x4*)((base) + (size_t)((t0) + k_ * 8 + br_) * RW + h * HD + bc_ * 8); } while (0)
#define OF_STB(src, off) do { _Pragma("unroll") for (int k_ = 0; k_ < 4; ++k_) *(LAS u32x4*)(slab + (off) + (k_ * 8 + br_) * 144 + bc_ * 16) = src[k_]; } while (0)
#define OF_RDF(mb_, g_) (*(const LAS f32x4*)(slab + ln * 272 + ((mb_) * 32 + 8 * (g_) + 4 * hh) * 4))
#define OF_RDB(off, mb_, g_) up4(*(const LAS u32x2*)(slab + (off) + ln * 144 + ((mb_) * 32 + 8 * (g_) + 4 * hh) * 2))
#pragma unroll
        for (int nb = 0; nb < 2; ++nb) { const int t0 = c * CL + nb * 32;
            u32x4 fa[8], fb[8], ba[4], bb[4];
            OF_LDF(fa, YF, t0); OF_LDF(fb, YF + (size_t)T * RW, t0);
            float s1 = 0.f, sb = 0.f;
            OF_STF(fa); OF_LDB(ba, KD, t0); OF_LDB(bb, KD + (size_t)T * RW, t0);
#pragma unroll
            for (int mb = 0; mb < 2; ++mb)
#pragma unroll
                for (int g = 0; g < 4; ++g) { const f32x4 y0 = OF_RDF(mb, g);
#pragma unroll
                    for (int e = 0; e < 4; ++e) acc[mb][nb][4 * g + e] += y0[e]; }
            OF_STF(fb);
#pragma unroll
            for (int mb = 0; mb < 2; ++mb)
#pragma unroll
                for (int g = 0; g < 4; ++g) { const f32x4 y1 = OF_RDF(mb, g);
#pragma unroll
                    for (int e = 0; e < 4; ++e) { const float y = acc[mb][nb][4 * g + e] + y1[e]; acc[mb][nb][4 * g + e] = y; s1 += y; } }
            OF_STB(ba, 0); OF_STB(bb, 4608); OF_LDB(ba, R, t0); OF_LDB(bb, V, t0);
            f32x4 ks[2][4];
#pragma unroll
            for (int mb = 0; mb < 2; ++mb)
#pragma unroll
                for (int g = 0; g < 4; ++g) { const f32x4 k0 = OF_RDB(0, mb, g), k1 = OF_RDB(4608, mb, g); ks[mb][g] = k0 + k1; }
            OF_STB(ba, 0); OF_STB(bb, 4608); OF_LDB(ba, G, t0);
            u32x2 vraw[2][4];
#pragma unroll
            for (int mb = 0; mb < 2; ++mb)
#pragma unroll
                for (int g = 0; g < 4; ++g) { const int j = h * HD + 4 * hh + mb * 32 + 8 * g; const f32x4 rr = OF_RDB(0, mb, g), rkk = *(const f32x4*)(rk + j); vraw[mb][g] = *(const LAS u32x2*)(slab + 4608 + ln * 144 + (mb * 32 + 8 * g + 4 * hh) * 2);
#pragma unroll
                    for (int e = 0; e < 4; ++e) sb += rr[e] * ks[mb][g][e] * rkk[e]; }
            const float mu = half_swap_sum(s1) * (1.0f / 64.0f), bon = half_swap_sum(sb);
            float s2 = 0.f;
#pragma unroll
            for (int mb = 0; mb < 2; ++mb)
#pragma unroll
                for (int r = 0; r < 16; ++r) { const float dl = acc[mb][nb][r] - mu; s2 += dl * dl; }
            const float rstd = rsqrtf(half_swap_sum(s2) * (1.0f / 64.0f) + 64e-5f);
            OF_STB(ba, 0);
            f32x4 ovv[2][4];
#pragma unroll
            for (int mb = 0; mb < 2; ++mb)
#pragma unroll
                for (int g = 0; g < 4; ++g) { const int j = h * HD + 4 * hh + mb * 32 + 8 * g; const f32x4 vv = up4(vraw[mb][g]), gg = OF_RDB(0, mb, g), w4 = *(const f32x4*)(lw + j), b4 = *(const f32x4*)(lb + j);
#pragma unroll
                    for (int e = 0; e < 4; ++e) ovv[mb][g][e] = ((acc[mb][nb][4 * g + e] - mu) * rstd * w4[e] + b4[e] + bon * vv[e]) * gg[e]; }
#pragma unroll
            for (int mb = 0; mb < 2; ++mb)
#pragma unroll
                for (int g = 0; g < 4; ++g) *(LAS u32x2*)(slab + 4608 + ln * 144 + (mb * 32 + 8 * g + 4 * hh) * 2) = pk4(ovv[mb][g]);
#pragma unroll
            for (int k_ = 0; k_ < 4; ++k_) *(u32x4*)(YA + (size_t)(t0 + k_ * 8 + br_) * RW + h * HD + bc_ * 8) = *(const LAS u32x4*)(slab + 4608 + (k_ * 8 + br_) * 144 + bc_ * 16);
        }
#undef OF_LDF
#undef OF_STF
#undef OF_LDB
#undef OF_STB
#undef OF_RDF
#undef OF_RDB
    }
}

namespace att {
constexpr int KN_B = 16384, KR_B = 8192, V_B = 16384, BUF_B = KN_B + KR_B + V_B;
constexpr int SCR_OFF = 2 * BUF_B;
constexpr float THR2 = 10.0f;
__device__ __forceinline__ int crow(int r, int hi) { return (r & 3) + 8 * (r >> 2) + 4 * hi; }
__device__ __forceinline__ int kn_off(int row, int colB) { return row * 256 + (colB ^ ((row & 15) << 4)); }
__device__ __forceinline__ int kr_off(int row, int chunk) { return row * 128 + ((chunk ^ ((row >> 1) & 7)) << 4); }
__device__ __forceinline__ int v_st(int k, int c) { const int kk = (k & ~0xC) | ((k & 4) << 1) | ((k & 8) >> 1); return ((kk >> 3) * 4 + (c >> 5)) * 512 + ((kk & 7) * 32 + (c & 31)) * 2; }
__device__ __forceinline__ int v_rd_base(int lane) { return ((lane & 3) << 3) | (((lane >> 2) & 3) << 6) | (((lane >> 4) & 1) << 5) | (((lane >> 5) & 1) << 8); }
constexpr int v_rd_off(int d0, int ks, int half) { return d0 * 512 + ks * 4096 + half * 2048; }
template <int OFF> __device__ __forceinline__ s16x4 tr_read(int vb) { s16x4 r; asm volatile("ds_read_b64_tr_b16 %0, %1 offset:%2" : "=&v"(r) : "v"(vb), "i"(OFF) : "memory"); return r; }
template <int OFF> __device__ __forceinline__ bf16x8 lds128(int a) { bf16x8 r; asm volatile("ds_read_b128 %0, %1 offset:%2" : "=v"(r) : "v"(a), "i"(OFF) : "memory"); return r; }
#define AT_WAIT(n) do { asm volatile("s_waitcnt lgkmcnt(" #n ")" ::: "memory"); __builtin_amdgcn_sched_barrier(0); } while (0)
struct VSet { s16x4 l0, h0, l1, h1, l2, h2, l3, h3; };
template <int D0> __device__ __forceinline__ void pv_read(VSet& v, int vb) {
    v.l0 = tr_read<v_rd_off(D0, 0, 0)>(vb); v.h0 = tr_read<v_rd_off(D0, 0, 1)>(vb); v.l1 = tr_read<v_rd_off(D0, 1, 0)>(vb); v.h1 = tr_read<v_rd_off(D0, 1, 1)>(vb);
    v.l2 = tr_read<v_rd_off(D0, 2, 0)>(vb); v.h2 = tr_read<v_rd_off(D0, 2, 1)>(vb); v.l3 = tr_read<v_rd_off(D0, 3, 0)>(vb); v.h3 = tr_read<v_rd_off(D0, 3, 1)>(vb); }
__device__ __forceinline__ void pv_mma(f32x16& od, const VSet& v, bf16x8 pa0, bf16x8 pa1, bf16x8 pa2, bf16x8 pa3) {
#define ATT_PK(L, H) (bf16x8){L[0], L[1], L[2], L[3], H[0], H[1], H[2], H[3]}
    od = __builtin_amdgcn_mfma_f32_32x32x16_bf16(pa0, ATT_PK(v.l0, v.h0), od, 0, 0, 0);
    od = __builtin_amdgcn_mfma_f32_32x32x16_bf16(pa1, ATT_PK(v.l1, v.h1), od, 0, 0, 0);
    od = __builtin_amdgcn_mfma_f32_32x32x16_bf16(pa2, ATT_PK(v.l2, v.h2), od, 0, 0, 0);
    od = __builtin_amdgcn_mfma_f32_32x32x16_bf16(pa3, ATT_PK(v.l3, v.h3), od, 0, 0, 0);
#undef ATT_PK
}
template <int D0> __device__ __forceinline__ void pv_one(f32x16& od, int vb, bf16x8 pa0, bf16x8 pa1, bf16x8 pa2, bf16x8 pa3) {
    const s16x4 l0 = tr_read<v_rd_off(D0, 0, 0)>(vb), h0 = tr_read<v_rd_off(D0, 0, 1)>(vb), l1 = tr_read<v_rd_off(D0, 1, 0)>(vb), h1 = tr_read<v_rd_off(D0, 1, 1)>(vb);
    const s16x4 l2 = tr_read<v_rd_off(D0, 2, 0)>(vb), h2 = tr_read<v_rd_off(D0, 2, 1)>(vb), l3 = tr_read<v_rd_off(D0, 3, 0)>(vb), h3 = tr_read<v_rd_off(D0, 3, 1)>(vb);
    asm volatile("s_waitcnt lgkmcnt(0)" ::: "memory"); __builtin_amdgcn_sched_barrier(0);
#define ATT_PK(L, H) (bf16x8){L[0], L[1], L[2], L[3], H[0], H[1], H[2], H[3]}
    od = __builtin_amdgcn_mfma_f32_32x32x16_bf16(pa0, ATT_PK(l0, h0), od, 0, 0, 0);
    od = __builtin_amdgcn_mfma_f32_32x32x16_bf16(pa1, ATT_PK(l1, h1), od, 0, 0, 0);
    od = __builtin_amdgcn_mfma_f32_32x32x16_bf16(pa2, ATT_PK(l2, h2), od, 0, 0, 0);
    od = __builtin_amdgcn_mfma_f32_32x32x16_bf16(pa3, ATT_PK(l3, h3), od, 0, 0, 0);
#undef ATT_PK
}
__device__ __forceinline__ void unit(const Frame& F, int q0, int h) {
    const bf16_t* Q = wsp<bf16_t>(F, WS_Q); const bf16_t* KV = wsp<bf16_t>(F, WS_KV); bf16_t* O = wsp<bf16_t>(F, WS_O);
    LAS char* lds = (LAS char*)F.lds;
    const int tid = F.tid, wid = F.wave, lane = F.lane, r32 = lane & 31, hi = lane >> 5;
    LAS float* scr = (LAS float*)(lds + SCR_OFF) + wid * 64; LAS float* li_l = scr; LAS float* al_l = scr + 32;
    float m_reg = -1e30f, l_reg = 0.f; f32x16 o[4]; o[0] = (f32x16)(0.f); o[1] = o[0]; o[2] = o[0]; o[3] = o[0];
    bf16x8 qr[12];
    { const bf16_t* qw = Q + (size_t)(q0 + wid * 32 + r32) * QW + h * 192 + hi * 8;
#pragma unroll
      for (int d0 = 0; d0 < 12; ++d0) qr[d0] = *(const bf16x8*)(qw + d0 * 16); }
    const int sr = tid >> 4, sc = (tid & 15) * 8, rr = tid >> 3, rc = tid & 7;
    const int kn0 = kn_off(sr, sc * 2), kn1 = kn_off(32 + sr, sc * 2), vs0 = v_st(sr, sc), vs1 = v_st(32 + sr, sc), kro = kr_off(rr, rc);
    const int vb0 = (int)(uintptr_t)(LAS char*)(F.lds + KN_B + KR_B) + v_rd_base(lane);
    const int lds0 = (int)(uintptr_t)(LAS char*)F.lds;
    u32x4 g0, g1, g2;
    const unsigned so0 = (unsigned)(sr * KVW + sc) * 2u, so2 = (unsigned)(rr * KVW + 128 + rc * 8) * 2u;
#define AT_SLOAD(k0) do { const char* kvb = (const char*)KV + (size_t)(k0) * KVW * 2; g0 = *(const u32x4*)(kvb + so0); g1 = *(const u32x4*)(kvb + so0 + 32u * KVW * 2u); g2 = *(const u32x4*)(kvb + so2); } while (0)
#define AT_SWRITE(b) do { LAS char* bb = lds + (b) * BUF_B; *(LAS u32x4*)(bb + kn0) = g0; *(LAS u32x4*)(bb + kn1) = g1; *(LAS u32x4*)(bb + KN_B + kro) = g2; *(LAS u32x4*)(bb + KN_B + KR_B + vs0) = g0; *(LAS u32x4*)(bb + KN_B + KR_B + vs1) = g1; } while (0)
    constexpr int NT = T / 64;
    AT_SLOAD(0); AT_SWRITE(0); __syncthreads();
    for (int j = 0; j < NT; ++j) {
        const int b = j & 1; const LAS char* kb = lds + b * BUF_B;
        if (j + 1 < NT) AT_SLOAD((j + 1) * 64);
        f32x16 p0 = (f32x16)(0.f), p1 = (f32x16)(0.f);
        __builtin_amdgcn_sched_barrier(0);
#pragma unroll
        for (int d0 = 0; d0 < 8; ++d0) { const int cb = (d0 * 16 + hi * 8) * 2;
            const bf16x8 k0 = *(const LAS bf16x8*)(kb + kn_off(r32, cb)), k1 = *(const LAS bf16x8*)(kb + kn_off(32 + r32, cb));
            p0 = __builtin_amdgcn_mfma_f32_32x32x16_bf16(k0, qr[d0], p0, 0, 0, 0); p1 = __builtin_amdgcn_mfma_f32_32x32x16_bf16(k1, qr[d0], p1, 0, 0, 0); }
#pragma unroll
        for (int d0 = 0; d0 < 4; ++d0) { const int ch = d0 * 2 + hi;
            const bf16x8 k0 = *(const LAS bf16x8*)(kb + KN_B + kr_off(r32, ch)), k1 = *(const LAS bf16x8*)(kb + KN_B + kr_off(32 + r32, ch));
            p0 = __builtin_amdgcn_mfma_f32_32x32x16_bf16(k0, qr[8 + d0], p0, 0, 0, 0); p1 = __builtin_amdgcn_mfma_f32_32x32x16_bf16(k1, qr[8 + d0], p1, 0, 0, 0); }
        __builtin_amdgcn_sched_group_barrier(0x100, 6, 0);
#pragma unroll
        for (int i_ = 0; i_ < 9; ++i_) { __builtin_amdgcn_sched_group_barrier(0x008, 2, 0); __builtin_amdgcn_sched_group_barrier(0x100, 2, 0); }
        __builtin_amdgcn_sched_group_barrier(0x008, 6, 0);
        __builtin_amdgcn_sched_barrier(0);
        const int vb = vb0 + b * BUF_B; VSet va, vbs; pv_read<0>(va, vb);
        float pmax = p0[0];
#pragma unroll
        for (int r = 1; r < 16; ++r) pmax = fmaxf(pmax, p0[r]);
#pragma unroll
        for (int r = 0; r < 16; ++r) pmax = fmaxf(pmax, p1[r]);
        { auto rrr = __builtin_amdgcn_permlane32_swap(__float_as_uint(pmax), __float_as_uint(pmax), false, false); pmax = fmaxf(__uint_as_float(rrr[0]), __uint_as_float(rrr[1])); }
        float alpha = 1.f;
        if (!__all(pmax - m_reg <= THR2)) { const float mn = fmaxf(m_reg, pmax); alpha = __builtin_amdgcn_exp2f(m_reg - mn); m_reg = mn;
            if (hi == 0) al_l[r32] = alpha; asm volatile("s_waitcnt lgkmcnt(0)" ::: "memory");
#pragma unroll
            for (int dd = 0; dd < 4; ++dd)
#pragma unroll
                for (int r = 0; r < 16; ++r) o[dd][r] *= al_l[crow(r, hi)]; }
        float ps = 0.f;
#pragma unroll
        for (int r = 0; r < 16; ++r) { p0[r] = __builtin_amdgcn_exp2f(p0[r] - m_reg); p1[r] = __builtin_amdgcn_exp2f(p1[r] - m_reg); ps += p0[r] + p1[r]; }
        { auto rrr = __builtin_amdgcn_permlane32_swap(__float_as_uint(ps), __float_as_uint(ps), false, false); ps = __uint_as_float(rrr[0]) + __uint_as_float(rrr[1]); }
        l_reg = l_reg * alpha + ps;
        bf16x8 pa0, pa1, pa2, pa3;
#define AT_PK4(P, BASE, OUT) do { unsigned a0 = cvtpk(P[BASE + 0], P[BASE + 1]), a1 = cvtpk(P[BASE + 2], P[BASE + 3]); \
        unsigned b0 = cvtpk(P[BASE + 4], P[BASE + 5]), b1 = cvtpk(P[BASE + 6], P[BASE + 7]); \
        auto r0 = __builtin_amdgcn_permlane32_swap(a0, b0, false, false); auto r1 = __builtin_amdgcn_permlane32_swap(a1, b1, false, false); \
        u32x4 w = {r0[0], r1[0], r0[1], r1[1]}; OUT = __builtin_bit_cast(bf16x8, w); } while (0)
        AT_PK4(p0, 0, pa0); AT_PK4(p0, 8, pa1); AT_PK4(p1, 0, pa2); AT_PK4(p1, 8, pa3);
#undef AT_PK4
        pv_read<1>(vbs, vb); AT_WAIT(8); pv_mma(o[0], va, pa0, pa1, pa2, pa3);
        pv_read<2>(va, vb); AT_WAIT(8); pv_mma(o[1], vbs, pa0, pa1, pa2, pa3);
        pv_read<3>(vbs, vb); AT_WAIT(8); pv_mma(o[2], va, pa0, pa1, pa2, pa3);
        AT_WAIT(0); pv_mma(o[3], vbs, pa0, pa1, pa2, pa3);
        if (j + 1 < NT) AT_SWRITE(b ^ 1);
        __syncthreads();
    }
#undef AT_SLOAD
#undef AT_SWRITE
    if (hi == 0) li_l[r32] = l_reg; asm volatile("s_waitcnt lgkmcnt(0)" ::: "memory");
    { int l2 = lane; asm volatile("" : "+v"(l2)); const int hi2 = l2 >> 5; const unsigned ob = (unsigned)((q0 + wid * 32 + 4 * hi2) * OW + h * 128 + (l2 & 31)) * 2u;
#pragma unroll
      for (int r = 0; r < 16; ++r) { const float rl = __builtin_amdgcn_rcpf(li_l[crow(r, hi2)]);
#pragma unroll
          for (int d0 = 0; d0 < 4; ++d0) *(bf16_t*)((char*)O + ob + (unsigned)(((r & 3) + 8 * (r >> 2)) * OW + d0 * 32) * 2u) = (bf16_t)f2bf(o[d0][r] * rl); } }
    __syncthreads();
}
}
__device__ __forceinline__ void phase_attention(const Frame& F, int reps) {
    for (int uu = F.bid; uu < (T / 256) * 4 * reps; uu += F.G) { const int u = uu % ((T / 256) * 4); att::unit(F, (u >> 2) * 256, u & 3); }
}

__device__ __forceinline__ void phase_norm2_router(const Frame& F, int l, int reps) {
    const float* X = gout(F); bf16_t* XN = wsp<bf16_t>(F, WS_XN); float* AFF = wsp<float>(F, WS_AFF);
    const float* gain = gin(F, I_NFFN) + (size_t)l * DM; const float* wr = gin(F, I_WR) + (size_t)l * DM * NE;
    for (int it = F.tid; it < 8192; it += NTHR) { const int ln = it & 63, q = (it >> 6) & 3, c = (it >> 8) & 3, i = it >> 10; *(LAS f32x4*)(F.lds + (size_t)it * 16) = *(const f32x4*)(wr + (size_t)(i * 256 + ln * 4 + c) * NE + 4 * q); }
    __syncthreads();
    for (int row_ = F.gw; row_ < T * reps; row_ += F.nw) { const int row = row_ % T;
        f32x4 v[8]; float ss = 0.f;
#pragma unroll
        for (int i = 0; i < 8; ++i) { v[i] = *(const f32x4*)(X + (size_t)row * DM + i * 256 + F.lane * 4); ss += v[i][0] * v[i][0] + v[i][1] * v[i][1] + v[i][2] * v[i][2] + v[i][3] * v[i][3]; }
        ss = wave_sum(ss); const float rstd = rsqrtf(ss * (1.0f / DM) + 1e-6f);
        float lg[NE];
#pragma unroll
        for (int e = 0; e < NE; ++e) lg[e] = 0.f;
#pragma unroll
        for (int i = 0; i < 8; ++i) { const f32x4 g = *(const f32x4*)(gain + i * 256 + F.lane * 4); f32x4 xn; xn[0] = v[i][0] * rstd * g[0]; xn[1] = v[i][1] * rstd * g[1]; xn[2] = v[i][2] * rstd * g[2]; xn[3] = v[i][3] * rstd * g[3];
            *(u32x2*)(XN + (size_t)row * DM + i * 256 + F.lane * 4) = pk4(xn);
            int lo_ = F.lane * 16; asm volatile("" : "+v"(lo_), "+v"(lg[0]));
#pragma unroll
            for (int c = 0; c < 4; ++c) {
#pragma unroll
                for (int q = 0; q < 4; ++q) { const f32x4 w = *(const LAS f32x4*)(F.lds + (((i * 4 + c) * 4 + q) * 1024 + lo_)); lg[4 * q] += xn[c] * w[0]; lg[4 * q + 1] += xn[c] * w[1]; lg[4 * q + 2] += xn[c] * w[2]; lg[4 * q + 3] += xn[c] * w[3]; } } }
        float mx = -1e30f;
#pragma unroll
        for (int e = 0; e < NE; ++e) { lg[e] = wave_sum(lg[e]); mx = fmaxf(mx, lg[e]); }
        float den = 0.f;
#pragma unroll
        for (int e = 0; e < NE; ++e) { lg[e] = __expf(lg[e] - mx); den += lg[e]; }
        float mine = 0.f;
#pragma unroll
        for (int e = 0; e < NE; ++e) mine = (F.lane == e) ? lg[e] : mine;
        if (F.lane < NE) AFF[(size_t)F.lane * T + row] = mine / den;
    }
}

__device__ __forceinline__ int block_excl_scan(const Frame& F, int v, LAS int* tmp) {
    int inc = v;
#pragma unroll
    for (int o = 1; o < 64; o <<= 1) { const int n = shi(inc, F.lane - o); if (F.lane >= o) inc += n; }
    __syncthreads();
    if (F.lane == 63) tmp[F.wave] = inc;
    __syncthreads();
    int off = 0;
#pragma unroll
    for (int w = 0; w < NWAVE; ++w) off += (w < F.wave) ? tmp[w] : 0;
    return off + inc - v;
}
__device__ __forceinline__ void phase_topk(const Frame& F) {
    if (F.bid >= NE) return;
    const int e = F.bid; const float* AFF = wsp<float>(F, WS_AFF) + (size_t)e * T; int* SLOT = wsp<int>(F, WS_SLOT) + (size_t)e * T; int* IDX = wsp<int>(F, WS_IDX) + e * CAP; float* GATEV = wsp<float>(F, WS_GATEV) + e * CAP;
    LAS unsigned* hist = (LAS unsigned*)F.lds; LAS int* sel = (LAS int*)(F.lds + 1024); LAS int* tmp = (LAS int*)(F.lds + 1088);
    unsigned u[32];
#pragma unroll
    for (int q = 0; q < 8; ++q) { const f32x4 a = *(const f32x4*)(AFF + F.tid * 32 + q * 4); u[4 * q] = __float_as_uint(a[0]); u[4 * q + 1] = __float_as_uint(a[1]); u[4 * q + 2] = __float_as_uint(a[2]); u[4 * q + 3] = __float_as_uint(a[3]); }
    unsigned prefix = 0u, mask = 0u; int need = CAP;
    for (int round = 0; round < 4; ++round) { const int shift = 24 - 8 * round;
        if (F.tid < 256) hist[F.tid] = 0u;
        __syncthreads();
#pragma unroll
        for (int i = 0; i < 32; ++i) if ((u[i] & mask) == prefix) __hip_atomic_fetch_add(&hist[(u[i] >> shift) & 255u], 1u, __ATOMIC_RELAXED, __HIP_MEMORY_SCOPE_WORKGROUP);
        __syncthreads();
        if (F.wave == 0) { const int c0 = (int)hist[4 * F.lane], c1 = (int)hist[4 * F.lane + 1], c2 = (int)hist[4 * F.lane + 2], c3 = (int)hist[4 * F.lane + 3]; const int tot = c0 + c1 + c2 + c3;
            int suf = tot;
#pragma unroll
            for (int o = 1; o < 64; o <<= 1) { const int n = shi(suf, F.lane + o); if (F.lane + o < 64) suf += n; }
            int run = suf - tot; const int cs[4] = {c0, c1, c2, c3};
#pragma unroll
            for (int b = 3; b >= 0; --b) { if (run < need && need <= run + cs[b]) { sel[0] = 4 * F.lane + b; sel[1] = need - run; } run += cs[b]; } }
        __syncthreads();
        prefix |= ((unsigned)sel[0]) << shift; mask |= 255u << shift; need = sel[1];
        __syncthreads();
    }
    const unsigned thr = prefix; int ngt = 0, neq = 0;
#pragma unroll
    for (int i = 0; i < 32; ++i) { ngt += (u[i] > thr) ? 1 : 0; neq += (u[i] == thr) ? 1 : 0; }
    const int eqp = block_excl_scan(F, neq, tmp);
    int nsel = ngt + max(0, min(neq, need - eqp));
    const int sp = block_excl_scan(F, nsel, tmp);
    int re = eqp, rs = sp;
#pragma unroll
    for (int i = 0; i < 32; ++i) { const int t = F.tid * 32 + i; bool s = u[i] > thr; if (u[i] == thr) { s = re < need; ++re; }
        int slot = -1; if (s) { slot = rs++; if (slot < CAP) { IDX[slot] = t; GATEV[slot] = __uint_as_float(u[i]); } else slot = -1; }
        SLOT[t] = slot; }
}

__device__ __forceinline__ void phase_gather(const Frame& F, int reps) {
    const bf16_t* XN = wsp<bf16_t>(F, WS_XN); bf16_t* XS = wsp<bf16_t>(F, WS_XS); const int* IDX = wsp<int>(F, WS_IDX);
    int vz = 0; asm volatile("" : "+v"(vz));
    static_assert((NE * CAP) % 4 == 0, "gather rows");
    for (int q_ = F.gw; q_ < (NE * CAP / 4) * reps; q_ += F.nw) { const int r0 = (q_ % (NE * CAP / 4)) * 4; int tq[4];
#pragma unroll
        for (int j = 0; j < 4; ++j) tq[j] = __builtin_amdgcn_readfirstlane(IDX[r0 + j + vz]);
        u32x4 v[4][4];
#pragma unroll
        for (int j = 0; j < 4; ++j) { const u32x4* s = (const u32x4*)(XN + (size_t)tq[j] * DM);
#pragma unroll
            for (int i = 0; i < 4; ++i) v[j][i] = s[i * 64 + F.lane]; }
#pragma unroll
        for (int j = 0; j < 4; ++j) { u32x4* d = (u32x4*)(XS + (size_t)(r0 + j) * DM);
#pragma unroll
            for (int i = 0; i < 4; ++i) d[i * 64 + F.lane] = v[j][i]; } }
}

__device__ __forceinline__ int fresh_zero() { int z; asm volatile("v_mov_b32 %0, 0" : "=v"(z)); return z; }
__device__ __forceinline__ int relaunder(int v, int z) { return __builtin_amdgcn_readfirstlane(v + z); }
__device__ __forceinline__ Frame mkframe(const Frame& F0) {
    Frame F = F0; const int z = fresh_zero();
    { const unsigned long long x = (unsigned long long)F0.P; const unsigned lo = (unsigned)relaunder((int)(unsigned)x, z), hi = (unsigned)relaunder((int)(unsigned)(x >> 32), z);
      F.P = (const __attribute__((address_space(4))) Params*)(((unsigned long long)hi << 32) | lo); }
    F.ws = (unsigned char*)(guc_t*)F.P->ws;
    F.lane = (int)__builtin_amdgcn_mbcnt_hi(~0u, __builtin_amdgcn_mbcnt_lo(~0u, (unsigned)z));
    F.wave = relaunder(F0.wave, z); F.bid = relaunder(F0.bid, z); F.G = relaunder(F0.G, z); F.nw = F.G * NWAVE;
    F.tid = F.wave * 64 + F.lane; F.gw = F.bid * NWAVE + F.wave; return F;
}
constexpr int PPL = 16;
constexpr int NPHASE = 1 + DEPTH * PPL;
#ifndef MK_N_LAUNCHES
#define MK_N_LAUNCHES 1
#endif

__global__ void __launch_bounds__(NTHR, 2) hybrid_fwd(Params P) {
    extern __shared__ __attribute__((aligned(16))) unsigned char lds_raw[];
    Frame F0; F0.lds = (LAS unsigned char*)lds_raw; F0.tid = threadIdx.x; F0.lane = F0.tid & 63; F0.wave = __builtin_amdgcn_readfirstlane(F0.tid >> 6);
    F0.G = gridDim.x; F0.bid = blockIdx.x; F0.gw = F0.bid * NWAVE + F0.wave; F0.nw = F0.G * NWAVE; F0.P = (const __attribute__((address_space(4))) Params*)__builtin_amdgcn_kernarg_segment_ptr(); F0.ws = (unsigned char*)(guc_t*)F0.P->ws;
    volatile LAS unsigned* MISC = (volatile LAS unsigned*)(F0.lds + MISC_OFF);
    if (F0.tid < 32) MISC[F0.tid] = 0u;
    __syncthreads();
    XcdBarrier bar; bar.bar = (unsigned*)(F0.ws + WS_CTL) + CW_BAR; bar.x = 0; bar.st = nullptr;
    bar = xcd_barrier_post((unsigned*)(F0.ws + WS_CTL) + CW_BAR, MISC + 8, F0.wave);
#ifndef DUP_MASK
#define DUP_MASK 0u
#endif
#define DUPK(k) ((DUP_MASK >> (k)) & 1u)
#define REP(k) for (int rep_ = 0; rep_ < ((DUPK(k) && l == 0) ? 2 : 1); ++rep_, ({ if (DUPK(k)) __syncthreads(); }))
#ifndef SMALL_MASK
#define SMALL_MASK 15
#endif
#ifndef PH_MASK
#define PH_MASK 0xFFFFFFFFu
#endif
#define IN(k) true
#define INK(kind, k) (((PH_MASK >> (kind)) & 1u) && IN(k))
#define SEAM(k) do { Frame Fb = mkframe(F0); XcdBarrier bb; bb.bar = (unsigned*)(Fb.ws + WS_CTL) + CW_BAR; bb.x = xb_xcc_id(); bb.st = (volatile LAS unsigned*)(Fb.lds + MISC_OFF) + 8; xcd_barrier(bb, Fb.wave); } while (0)

    if (INK(16, 0)) { Frame F = mkframe(F0); phase_rope_table(F); phase_cvt_nm(F, 0); if (DUPK(16)) { __syncthreads(); phase_cvt_nm(F, 0); } phase_norm(F, 0, gin(F, I_NORM_MIX)); if (DUPK(18)) { __syncthreads(); phase_norm(F, 0, gin(F, I_NORM_MIX)); } }
    SEAM(0);
    for (int l = 0; l < DEPTH; ++l) {
        const int pb = 1 + l * PPL;
        if (INK(0, pb + 0)) { const int greps = (DUPK(0) && l == 0) ? 2 : 1; Frame F = mkframe(F0); EpiWin E{F.ws};
            run_gemm(F, E, wsp<bf16_t>(F, WS_XN), DM, wsp<bf16_t>(F, WS_WIN), DM, DM, T / 256, NWIN / 256, (size_t)256 * DM * 2, 0, 0, (size_t)256 * DM * 2, 0, 0, greps); }
        SEAM(pb + 0);
        if (INK(1, pb + 1)) { const int nreps = (DUPK(1) && l == 0) ? 2 : 1; Frame F = mkframe(F0); phase_prep(F, l, nreps); }
        SEAM(pb + 1);
        if (INK(2, pb + 2)) { const int greps = (DUPK(2) && l == 0) ? 2 : 1; Frame F = mkframe(F0);
            if (SMALL_MASK & 1) { EpiLora1 E{gin(F, I_W0) + (size_t)l * 2 * RW, gin(F, I_A0) + (size_t)l * 2 * RW, gin(F, I_KA) + (size_t)l * RW, F.ws};
              run_gemm(F, E, wsp<bf16_t>(F, WS_AL), 512, wsp<bf16_t>(F, WS_WL1), 256, 256, T / 256, 12, (size_t)256 * 512 * 2, 0, 0, (size_t)256 * 256 * 2, 0, 0, greps); }
            if (SMALL_MASK & 2) { EpiLora2 E{gin(F, I_VB) + (size_t)(l > 0 ? l - 1 : 0) * RW, F.ws};
              run_gemm(F, E, wsp<bf16_t>(F, WS_AL) + 256, 512, wsp<bf16_t>(F, WS_WL2), 256, 256, T / 256, l > 0 ? 6 : 3, (size_t)256 * 512 * 2, 0, 0, (size_t)256 * 256 * 2, 0, 0, greps); }
            if (SMALL_MASK & 4) { EpiLru E{gin(F, I_BA) + (size_t)l * 2 * LW, gin(F, I_BX) + (size_t)l * 2 * LW, gin(F, I_LAM) + (size_t)l * 2 * LW, F.ws};
              run_gemm(F, E, wsp<bf16_t>(F, WS_XC), LW, wsp<bf16_t>(F, WS_WLRU), 256, 256, T / 256, 12, (size_t)256 * LW * 2, (size_t)256 * 2, 0, (size_t)256 * 256 * 2, 2, 0, greps); }
            if (SMALL_MASK & 8) { EpiMlaQ E{F.ws};
              run_gemm(F, E, wsp<bf16_t>(F, WS_AM), 384, wsp<bf16_t>(F, WS_WQ), 384, 384, T / 256, 3, (size_t)256 * 384 * 2, 0, 0, (size_t)256 * 384 * 2, 0, 0, greps); }
        }
        SEAM(pb + 2);
        if (INK(3, pb + 3)) { const int nreps = (DUPK(3) && l == 0) ? 2 : 1; Frame F = mkframe(F0); phase_rwkv_local(F, nreps); phase_lru_local(F, nreps); }
        SEAM(pb + 3);
        if (INK(4, pb + 4)) { Frame F = mkframe(F0); if (DUPK(4) && l == 0) { phase_rwkv_carry(F, true); __syncthreads(); } phase_rwkv_carry(F, false); phase_lru_carry(F, 48); if (F.bid >= 51) phase_cvt_moe(F, l, F.bid - 51, F.G - 51, 1, 0); }
        SEAM(pb + 4);
        if (INK(5, pb + 5)) { const int nreps = (DUPK(5) && l == 0) ? 2 : 1; Frame F = mkframe(F0); phase_attention(F, nreps); }
        SEAM(pb + 5);
        if (INK(6, pb + 6)) { const int nreps = (DUPK(6) && l == 0) ? 2 : 1; Frame F = mkframe(F0); phase_rwkv_outfin(F, l, nreps); phase_lru_out(F, (DUPK(19) && l == 0) ? 2 : nreps); }
        SEAM(pb + 6);
        if (INK(8, pb + 8)) { const int greps = 1; Frame F = mkframe(F0);
            if (DUPK(8) && l == 0) {
            { EpiMerge E{F.ws, 0};
              run_gemm(F, E, wsp<bf16_t>(F, WS_YA), RW, wsp<bf16_t>(F, WS_WOA), RW, RW, T / 256, DM / 256, (size_t)256 * RW * 2, 0, 0, (size_t)256 * RW * 2, 0, 0, greps); }
            { EpiMerge E{F.ws, 1};
              run_gemm(F, E, wsp<bf16_t>(F, WS_YB), LW, wsp<bf16_t>(F, WS_WOB), LW, LW, T / 256, DM / 256, (size_t)256 * LW * 2, 0, 0, (size_t)256 * LW * 2, 0, 0, greps); }
            { EpiMerge E{F.ws, 2};
              run_gemm(F, E, wsp<bf16_t>(F, WS_O), OW, wsp<bf16_t>(F, WS_WOC), OW, OW, T / 256, DM / 256, (size_t)256 * OW * 2, 0, 0, (size_t)256 * OW * 2, 0, 0, greps); }
            }
            { EpiMerge E{F.ws, 0};
              run_gemm(F, E, wsp<bf16_t>(F, WS_YA), RW, wsp<bf16_t>(F, WS_WOA), RW, RW, T / 256, DM / 256, (size_t)256 * RW * 2, 0, 0, (size_t)256 * RW * 2, 0, 0, greps); }
            { EpiMerge E{F.ws, 1};
              run_gemm(F, E, wsp<bf16_t>(F, WS_YB), LW, wsp<bf16_t>(F, WS_WOB), LW, LW, T / 256, DM / 256, (size_t)256 * LW * 2, 0, 0, (size_t)256 * LW * 2, 0, 0, greps); }
            { EpiMerge E{F.ws, 2};
              run_gemm(F, E, wsp<bf16_t>(F, WS_O), OW, wsp<bf16_t>(F, WS_WOC), OW, OW, T / 256, DM / 256, (size_t)256 * OW * 2, 0, 0, (size_t)256 * OW * 2, 0, 0, greps); }
        }
        SEAM(pb + 8);
        if (INK(9, pb + 9)) { const int greps = 1; Frame F = mkframe(F0); if (DUPK(9) && l == 0) { EpiWout E{gout(F), wsp<float>(F, WS_HG)}; run_gemm(F, E, wsp<bf16_t>(F, WS_MERGED), DM, wsp<bf16_t>(F, WS_WOUT), DM, DM, T / 256, DM / 256, (size_t)256 * DM * 2, 0, 0, (size_t)256 * DM * 2, 0, 0, greps); }
            EpiWout E{gout(F), gout(F)};
            run_gemm(F, E, wsp<bf16_t>(F, WS_MERGED), DM, wsp<bf16_t>(F, WS_WOUT), DM, DM, T / 256, DM / 256, (size_t)256 * DM * 2, 0, 0, (size_t)256 * DM * 2, 0, 0, greps); }
        SEAM(pb + 9);
        if (INK(10, pb + 10)) { const int nreps = (DUPK(10) && l == 0) ? 2 : 1; Frame F = mkframe(F0); phase_norm2_router(F, l, nreps); }
        SEAM(pb + 10);
        if (INK(11, pb + 11)) { const int nreps = (DUPK(11) && l == 0) ? 2 : 1; Frame F = mkframe(F0); if (DUPK(17) && l == 0) { phase_topk(F); __syncthreads(); } phase_topk(F); __syncthreads(); if (F.bid >= NE) phase_cvt_moe(F, l, F.bid - NE, F.G - NE, nreps, 1); }
        SEAM(pb + 11);
        if (INK(12, pb + 12)) { const int nreps = (DUPK(12) && l == 0) ? 2 : 1; Frame F = mkframe(F0); phase_gather(F, nreps); }
        SEAM(pb + 12);
        if (INK(13, pb + 13)) { const int greps = (DUPK(13) && l == 0) ? 2 : 1; Frame F = mkframe(F0); EpiMoeUp E{F.ws};
            run_gemm(F, E, wsp<bf16_t>(F, WS_XS), DM, wsp<bf16_t>(F, WS_WGU), DM, DM, NE * 8, 8, (size_t)256 * DM * 2, 0, (size_t)2048 * DM * 2, (size_t)256 * DM * 2, 0, 3, greps); }
        SEAM(pb + 13);
        if (INK(14, pb + 14)) { const int greps = (DUPK(14) && l == 0) ? 2 : 1; Frame F = mkframe(F0); EpiMoeDown E{F.ws};
            run_gemm(F, E, wsp<bf16_t>(F, WS_HDN), FF, wsp<bf16_t>(F, WS_WD), FF, FF, NE * 8, 8, (size_t)256 * FF * 2, 0, (size_t)2048 * FF * 2, (size_t)256 * FF * 2, 0, 3, greps); }
        SEAM(pb + 14);
        if (INK(15, pb + 15)) { Frame F = mkframe(F0);
            if (l + 1 < DEPTH) { phase_cvt_nm(F, l + 1); phase_norm(F, 1, gin(F, I_NORM_MIX) + (size_t)(l + 1) * DM); }
            else phase_norm(F, 2, gin(F, I_NFIN));
        }
        if (l + 1 < DEPTH) SEAM(pb + 15);
    }
#undef IN
#undef SEAM
}

extern "C" void kernel_launch(void* const* d_in, const int* in_sizes, int n_in, void* d_out, int out_size, void* d_ws, size_t ws_size, hipStream_t stream) {
    static int grid = 0;
    if (grid == 0) {
        int dev = 0, cus = 0, per_cu = 0;
        if (hipGetDevice(&dev) != hipSuccess || hipDeviceGetAttribute(&cus, hipDeviceAttributeMultiprocessorCount, dev) != hipSuccess) { fprintf(stderr, "kernel_launch: device query failed\n"); grid = -1; return; }
        if (hipFuncSetAttribute((const void*)hybrid_fwd, hipFuncAttributeMaxDynamicSharedMemorySize, LDS_BYTES) != hipSuccess) { fprintf(stderr, "kernel_launch: hipFuncSetAttribute failed\n"); grid = -1; return; }
        if (hipOccupancyMaxActiveBlocksPerMultiprocessor(&per_cu, (const void*)hybrid_fwd, NTHR, LDS_BYTES) != hipSuccess || per_cu < 1) fprintf(stderr, "kernel_launch: occupancy query reports %d\n", per_cu);
        (void)hipGetLastError();
        grid = cus;
        if (n_in != 40 || ws_size < WS_NEED) fprintf(stderr, "kernel_launch: unexpected n_in %d / ws_size %zu (need %zu)\n", n_in, ws_size, (size_t)WS_NEED);
    }
    if (grid < 0) return;
    (void)hipMemsetAsync(d_ws, 0, 65536, stream);
    Params p{};
    for (int i = 0; i < 40; ++i) p.in[i] = (const float*)d_in[i];
    p.out = (float*)d_out; p.ws = (unsigned char*)d_ws;
#if MK_N_LAUNCHES == 1
    p.ph_lo = 0; p.ph_hi = NPHASE;
    hipLaunchKernelGGL(hybrid_fwd, dim3(grid), dim3(NTHR), LDS_BYTES, stream, p);
#else
    for (int k = 0; k < NPHASE; ++k) { p.ph_lo = k; p.ph_hi = k + 1; hipLaunchKernelGGL(hybrid_fwd, dim3(grid), dim3(NTHR), LDS_BYTES, stream, p); }
#endif
    const hipError_t le = hipPeekAtLastError();
    if (le != hipSuccess) fprintf(stderr, "kernel_launch: launch failed: %s\n", hipGetErrorName(le));
}
```

```cpp
#include <hip/hip_runtime.h>
#include <cstdio>
#include <cstdint>

#define LAS __attribute__((address_space(3)))
typedef unsigned short bf16_t;
typedef short bf16x8 __attribute__((ext_vector_type(8)));
typedef short s16x4 __attribute__((ext_vector_type(4)));
typedef float f32x4 __attribute__((ext_vector_type(4)));
typedef float f32x2 __attribute__((ext_vector_type(2)));
typedef float f32x16 __attribute__((ext_vector_type(16)));
typedef unsigned u32x4 __attribute__((ext_vector_type(4)));
typedef unsigned u32x2 __attribute__((ext_vector_type(2)));

constexpr int T = 16384, DM = 2048, DEPTH = 2;
constexpr int RW = 768, NH = 12, HD = 64;
constexpr int LW = 768;
constexpr int RWKV_COLS = 2688, IN_COLS = 10944;
constexpr int H1W = 4864, HGW = 6144, NWIN = H1W + HGW;
constexpr int NE = 16, FF = 1024, CAP = 2048;
constexpr int NCH = 256, CL = 64;
constexpr int NTHR = 512, NWAVE = 8;
constexpr int QW = 768, KVW = 192, OW = 512;
constexpr float QSCALE = 0.07216878364870322f * 1.4426950408889634f;

constexpr size_t MiB = 1u << 20;
constexpr size_t WS_CTL = 0, CTL_BYTES = 1 * MiB;
constexpr size_t WS_COS = 1 * MiB, WS_SIN = 3 * MiB;
constexpr size_t WS_VF = 5 * MiB;
constexpr size_t WS_AFF = 29 * MiB;
constexpr size_t WS_SLOT = 30 * MiB;
constexpr size_t WS_IDX = 31 * MiB;
constexpr size_t WS_GATEV = 31 * MiB + 512 * 1024;
constexpr size_t WS_LA = 32 * MiB, WS_LB = 32 * MiB + 1536 * 1024, WS_LH0 = 35 * MiB;
constexpr size_t WS_W = 37 * MiB;
constexpr size_t WS_WIN = WS_W, WS_WOUT = WS_W + 43 * MiB, WS_WOA = WS_W + 51 * MiB, WS_WOB = WS_W + 54 * MiB, WS_WOC = WS_W + 57 * MiB,
                 WS_WL1 = WS_W + 59 * MiB, WS_WL2 = WS_W + 60 * MiB + 512 * 1024, WS_WLRU = WS_W + 61 * MiB + 256 * 1024, WS_WQ = WS_W + 62 * MiB + 768 * 1024;
constexpr size_t WS_XN = 101 * MiB;
constexpr size_t WS_YA = 101 * MiB, WS_YB = 125 * MiB;
constexpr size_t WS_H1 = 165 * MiB;
constexpr size_t WS_AF = 165 * MiB;
constexpr size_t WS_YF = 213 * MiB;
constexpr size_t WS_HG = 317 * MiB;
constexpr size_t WS_R = 509 * MiB, WS_K = 533 * MiB, WS_V = 557 * MiB, WS_KK = 581 * MiB, WS_E = 605 * MiB  , WS_BV = 653 * MiB  , WS_KD = 701 * MiB  , WS_G = 749 * MiB;
constexpr size_t WS_MERGED = 509 * MiB;
constexpr size_t WS_LOGA = 773 * MiB  , WS_IG = 821 * MiB  , WS_XC = 869 * MiB, WS_GB = 893 * MiB;
constexpr size_t WS_AM = 917 * MiB, WS_KV = 929 * MiB, WS_Q = 935 * MiB, WS_O = 959 * MiB;
constexpr size_t WS_AL = 975 * MiB;
constexpr size_t WS_GT = 991 * MiB;
constexpr size_t WS_WY = 1087 * MiB;
constexpr size_t WS_END_MIX = 1135 * MiB;
constexpr size_t WS_WGU = 165 * MiB, WS_XS = 357 * MiB, WS_HDN = 485 * MiB;
constexpr size_t WS_WD = 581 * MiB;
constexpr size_t WS_SLAB = 773 * MiB;
constexpr size_t WS_NEED = 1136 * MiB;
constexpr size_t SZ24 = 24 * MiB;

constexpr int CW_BAR = 4096;
constexpr int LDS_BYTES = 147456;
constexpr int MISC_OFF = 131072 + 320;

typedef __bf16 bf16x2_t __attribute__((ext_vector_type(2)));
__device__ __forceinline__ unsigned f2bf(float f) { return (unsigned)__builtin_bit_cast(unsigned short, (__bf16)f); }
__device__ __forceinline__ float bf2f(unsigned b) { return __builtin_bit_cast(float, b << 16); }
__device__ __forceinline__ unsigned pk2(float lo, float hi) { const bf16x2_t v = __builtin_convertvector((f32x2){lo, hi}, bf16x2_t); return __builtin_bit_cast(unsigned, v); }
__device__ __forceinline__ unsigned cvtpk(float lo, float hi) { unsigned r; asm volatile("v_cvt_pk_bf16_f32 %0, %1, %2" : "=v"(r) : "v"(lo), "v"(hi)); return r; }
__device__ __forceinline__ float bflo(unsigned w) { return __builtin_bit_cast(float, w << 16); }
__device__ __forceinline__ float bfhi(unsigned w) { return __builtin_bit_cast(float, w & 0xffff0000u); }
__device__ __forceinline__ float sigmoidf_(float x) { return __builtin_amdgcn_rcpf(1.0f + __expf(-x)); }
__device__ __forceinline__ float softplusf_(float z) { return fmaxf(z, 0.f) + __logf(1.0f + __expf(-fabsf(z))); }
__device__ __forceinline__ unsigned vzero() { unsigned z; asm volatile("v_mov_b32 %0, 0" : "=v"(z)); return z; }
__device__ __forceinline__ int lane_now() { int z; asm volatile("v_mov_b32 %0, 0" : "=v"(z)); return (int)__builtin_amdgcn_mbcnt_hi(~0u, __builtin_amdgcn_mbcnt_lo(~0u, (unsigned)z)); }
__device__ __forceinline__ float shx(float v, int o, int lane) { return __builtin_bit_cast(float, __builtin_amdgcn_ds_bpermute((lane ^ o) << 2, __builtin_bit_cast(int, v))); }
__device__ __forceinline__ int shi(int v, int src) { return __builtin_amdgcn_ds_bpermute(src << 2, v); }
__device__ __forceinline__ float wave_sum(float v) { const int lane = lane_now();
#pragma unroll
    for (int o = 32; o >= 1; o >>= 1) v += shx(v, o, lane);
    return v;
}

#define XB_TMO      128
#define XB_XCNT(j)  (256  + 64 * (j))
#define XB_XSUB(j)  (1280 + 64 * (j))
#define XB_XGEN(j)  (2304 + 64 * (j))
#define XB_TOP      3328
#define XB_TOPGEN   3392
#define XCD_BAR_WORDS 3456
#define XB_SPIN_CAP (1u << 22)
__device__ __forceinline__ unsigned xb_ld(unsigned* p)              { return __hip_atomic_load(p, __ATOMIC_RELAXED, __HIP_MEMORY_SCOPE_AGENT); }
__device__ __forceinline__ unsigned xb_add(unsigned* p, unsigned v) { return __hip_atomic_fetch_add(p, v, __ATOMIC_RELAXED, __HIP_MEMORY_SCOPE_AGENT); }
__device__ __forceinline__ unsigned xb_xcc_id() { return (unsigned)__builtin_amdgcn_s_getreg((3 << 11) | 20) & 0xFu; }
#define XB_SPIN(cond, bar) do { unsigned _sp = 0; while (cond) { __builtin_amdgcn_s_sleep(1); \
    if ((++_sp & 255u) == 0u) { if (xb_ld(&(bar)[XB_TMO])) break; if (_sp > XB_SPIN_CAP) { atomicAdd(&(bar)[XB_TMO], 1u); break; } } } } while (0)
struct XcdBarrier { unsigned* bar; unsigned x; volatile LAS unsigned* st; };
__device__ __forceinline__ bool xb_leader(int wave) { int z; asm volatile("v_mov_b32 %0, 0" : "=v"(z)); const unsigned l = __builtin_amdgcn_mbcnt_hi(~0u, __builtin_amdgcn_mbcnt_lo(~0u, (unsigned)z)); return (l | (unsigned)(wave + z)) == 0u; }
__device__ __forceinline__ XcdBarrier xcd_barrier_post(unsigned* bar, volatile LAS unsigned* st, int wave) {
    XcdBarrier b; b.bar = bar; b.x = xb_xcc_id(); b.st = st;
    if (xb_leader(wave)) (void)xb_add(&bar[XB_XCNT(b.x)], 1u);
    return b;
}
__device__ __forceinline__ void xcd_barrier_complete(unsigned* bar, unsigned x, unsigned& nloc, unsigned& nx) {
    const unsigned G = gridDim.x * gridDim.y * gridDim.z;
    unsigned sum, cnt, mine, sp = 0u;
    for (;;) {
        sum = 0u; cnt = 0u; mine = 0u;
#pragma unroll
        for (unsigned j = 0; j < 16; ++j) { const unsigned c = xb_ld(&bar[XB_XCNT(j)]); sum += c; cnt += (c > 0u) ? 1u : 0u; mine = (j == x) ? c : mine; }
        if (sum == G) break;
        __builtin_amdgcn_s_sleep(1);
        if ((++sp & 255u) == 0u) { if (xb_ld(&bar[XB_TMO])) break; if (sp > XB_SPIN_CAP) { atomicAdd(&bar[XB_TMO], 1u); break; } }
    }
    nloc = mine > 0u ? mine : 1u; nx = cnt > 0u ? cnt : 1u;
}
__device__ __forceinline__ void xcd_barrier(const XcdBarrier& b, int wave) {
    asm volatile("s_waitcnt vmcnt(0)" ::: "memory");
    __syncthreads();
    if (xb_leader(wave)) {
        unsigned* bar = b.bar;
        __builtin_amdgcn_s_waitcnt(0);
        unsigned nloc = b.st[0], nx = b.st[1];
        if (nloc == 0u) { xcd_barrier_complete(bar, b.x, nloc, nx); b.st[0] = nloc; b.st[1] = nx; }
        const unsigned old = xb_add(&bar[XB_XSUB(b.x)], 1u);
        const unsigned gen = old / nloc;
        if (old + 1u == (gen + 1u) * nloc) {
            __builtin_amdgcn_fence(__ATOMIC_RELEASE, "agent");
            asm volatile("s_waitcnt vmcnt(0)" ::: "memory");
            const unsigned og = xb_add(&bar[XB_TOP], 1u);
            const unsigned tg = og / nx;
            if (og + 1u == (tg + 1u) * nx) xb_add(&bar[XB_TOPGEN], 1u);
            else XB_SPIN(xb_ld(&bar[XB_TOPGEN]) == tg, bar);
            __builtin_amdgcn_fence(__ATOMIC_ACQUIRE, "agent");
            xb_add(&bar[XB_XGEN(b.x)], 1u);
            asm volatile("s_waitcnt vmcnt(0)" ::: "memory");
        } else {
            XB_SPIN(xb_ld(&bar[XB_XGEN(b.x)]) == gen, bar);
            __builtin_amdgcn_fence(__ATOMIC_ACQUIRE, "agent");
            asm volatile("s_waitcnt vmcnt(0)" ::: "memory");
        }
    }
    __syncthreads();
}

namespace pg8 {
constexpr int BM = 256, BK = 64, HALF = 128, HTB = HALF * BK * 2, STAGE_BYTES = 8 * HTB, NXCD = 8, WGM = 8;
__host__ __device__ __forceinline__ int lds_byte(int r, int c) { const int st = (r >> 4) * 2 + (c >> 5), rr = r & 15, cc = c & 31, ob = rr * 64 + cc * 2; return st * 1024 + (ob ^ (((ob >> 9) & 1) << 5)); }
__host__ __device__ __forceinline__ void stage_rc(int b, int& R, int& C) { const int st = b / 1024, sb = b % 1024, swz = sb ^ (((sb >> 9) & 1) << 5); R = (st >> 1) * 16 + swz / 64; C = (st & 1) * 32 + (swz % 64) / 2; }
__host__ __device__ __forceinline__ int perm32(int rho) { const int n = rho >> 4, i = rho & 15; return 8 * (i >> 2) + 4 * n + (i & 3); }

struct Unit { int pm, pn; const char* a; const char* b; };
template <class AddrF> struct Order {
    int nM, nN, nwg, G, c, reps; AddrF F;
    __device__ void init(int nM_, int nN_, int G_, int c_, const AddrF& f, int reps_ = 1) { nM = nM_; nN = nN_; nwg = nM * nN; G = G_; c = c_; F = f; reps = reps_; }
    __device__ bool next(int i, Unit& u) const {
        const long L = (long)i * G + c; if (L >= (long)nwg * reps) return false;
        int wgid = (int)(L % nwg); { const int q = nwg / NXCD, r = nwg % NXCD, xcd = wgid % NXCD, off = wgid / NXCD; wgid = (xcd < r ? xcd * (q + 1) : r * (q + 1) + (xcd - r) * q) + off; }
        const int nig = WGM * nN, gid = wgid / nig, fm = gid * WGM, gsz = (nM - fm) < WGM ? (nM - fm) : WGM;
        u.pm = fm + ((wgid % nig) % gsz); u.pn = (wgid % nig) / gsz; u.a = F.a(u.pm, u.pn); u.b = F.b(u.pm, u.pn); return true;
    }
};
struct Gemm { int K; int lda; int ldb; };

template <class Epi, class Sched, bool ALIGN_EPI = true, bool SP2 = true>
__device__ __forceinline__ void gemm_phase(LAS unsigned char* lds, const Gemm g, const Sched& S, const Epi& E, int tid, int wid) {
    const int lane = tid & 63, wr = wid >> 2, wc = wid & 3, fr = lane & 15, fq = lane >> 4;
    const int K = g.K, nt = K / BK;
    unsigned voffA[2], voffB[2];
#pragma unroll
    for (int i = 0; i < 2; ++i) { int R, C; stage_rc(tid * 16 + i * 8192, R, C); const int Rb = Epi::PERM ? ((R & ~31) + perm32(R & 31)) : R;
        voffA[i] = (unsigned)(R * g.lda + C) * 2u; voffB[i] = (unsigned)(Rb * g.ldb + C) * 2u; }
    const size_t kstep = (size_t)(BK * 2);
    const size_t hstepA = (size_t)HALF * g.lda * 2, hstepB = (size_t)HALF * g.ldb * 2;
    const unsigned ldsw = (unsigned)wid * 1024u;
    const int aoff = lds_byte(wr * 64 + fr, fq * 8), boff = lds_byte(wc * 32 + fr, fq * 8);
#define PG8_SA(b, h) (((b) * 2 + (h)) * HTB)
#define PG8_SB(b, h) ((4 + (b) * 2 + (h)) * HTB)
#define PG8_STAGE(bufoff, gbase, voff) do { _Pragma("unroll") for (int _i = 0; _i < 2; ++_i) \
        __builtin_amdgcn_global_load_lds((const unsigned*)((const char*)(gbase) + (voff)[_i]), (LAS unsigned*)(lds + (bufoff) + ldsw + _i * 8192), 16, 0, 0); } while (0)
#define PG8_LDA(dst, b, h) do { _Pragma("unroll") for (int m = 0; m < 4; ++m) _Pragma("unroll") for (int k = 0; k < 2; ++k) dst[m][k] = *(const LAS bf16x8*)(lds + PG8_SA(b, h) + aoff + m * 2048 + k * 1024); } while (0)
#define PG8_LDB(dst, b, h) do { _Pragma("unroll") for (int n = 0; n < 2; ++n) _Pragma("unroll") for (int k = 0; k < 2; ++k) dst[n][k] = *(const LAS bf16x8*)(lds + PG8_SB(b, h) + boff + n * 2048 + k * 1024); } while (0)
#define PG8_MMA(ai, bj, At, Bt) do { __builtin_amdgcn_s_setprio(1); _Pragma("unroll") for (int m = 0; m < 4; ++m) _Pragma("unroll") for (int n = 0; n < 2; ++n) _Pragma("unroll") for (int k = 0; k < 2; ++k) \
        acc[ai][bj][m][n] = __builtin_amdgcn_mfma_f32_16x16x32_bf16(Bt[n][k], At[m][k], acc[ai][bj][m][n], 0, 0, 0); __builtin_amdgcn_s_setprio(0); } while (0)
#define PG8_WAIT_V(n) asm volatile("s_waitcnt vmcnt(" #n ")" ::: "memory")
#define PG8_WAIT_L(n) asm volatile("s_waitcnt lgkmcnt(" #n ")" ::: "memory")
#define PG8_BAR __builtin_amdgcn_s_barrier()
#define PG8_SCHED __builtin_amdgcn_sched_barrier(0)
    Unit cur, nxt; int ui = 0;
    if (!S.next(0, cur)) return;
    f32x4 acc[2][2][4][2];
#pragma unroll
    for (int a = 0; a < 2; ++a)
#pragma unroll
        for (int b = 0; b < 2; ++b)
#pragma unroll
            for (int m = 0; m < 4; ++m)
#pragma unroll
                for (int n = 0; n < 2; ++n) acc[a][b][m][n] = (f32x4){0.f, 0.f, 0.f, 0.f};
    bf16x8 At[4][2], B0[2][2], B1[2][2];
    const char* cA = cur.a; const char* cB = cur.b;
    if constexpr (SP2) {
        PG8_STAGE(PG8_SB(0, 0), cB, voffB); PG8_STAGE(PG8_SB(0, 1), cB + hstepB, voffB); PG8_STAGE(PG8_SA(0, 0), cA, voffA); PG8_STAGE(PG8_SA(0, 1), cA + hstepA, voffA);
        if (wr == 1) PG8_BAR;
        PG8_WAIT_V(2); PG8_BAR;
        PG8_STAGE(PG8_SB(1, 0), cB + kstep, voffB); PG8_STAGE(PG8_SA(1, 0), cA + kstep, voffA); PG8_STAGE(PG8_SB(1, 1), cB + hstepB + kstep, voffB);
        PG8_WAIT_V(6); PG8_BAR;
    } else {
        PG8_STAGE(PG8_SB(0, 0), cB, voffB); PG8_STAGE(PG8_SA(0, 0), cA, voffA); PG8_STAGE(PG8_SB(0, 1), cB + hstepB, voffB); PG8_STAGE(PG8_SA(0, 1), cA + hstepA, voffA);
        if (wr == 1) PG8_BAR;
        PG8_WAIT_V(4); PG8_BAR;
        PG8_STAGE(PG8_SB(1, 0), cB + kstep, voffB); PG8_STAGE(PG8_SA(1, 0), cA + kstep, voffA); PG8_STAGE(PG8_SB(1, 1), cB + hstepB + kstep, voffB);
        PG8_WAIT_V(6); PG8_BAR;
    }
    for (;;) {
        const bool has_next = S.next(ui + 1, nxt);
        const char* nA = has_next ? nxt.a : cA; const char* nB = has_next ? nxt.b : cB;
#pragma unroll 1
        for (int t = 0; t < nt; t += 2) {
            const bool last = (t == nt - 2);
            const char* a1 = cA + (size_t)(t + 1) * kstep;
            const char* a2 = last ? nA : cA + (size_t)(t + 2) * kstep; const char* b2 = last ? nB : cB + (size_t)(t + 2) * kstep;
            const char* a3 = a2 + kstep; const char* b3 = b2 + kstep;
            if constexpr (SP2) {
            PG8_LDB(B0, 0, 0); PG8_LDB(B1, 0, 1); PG8_SCHED; PG8_LDA(At, 0, 0); PG8_STAGE(PG8_SA(1, 1), a1 + hstepA, voffA);
            PG8_WAIT_V(8); PG8_WAIT_L(0); PG8_BAR; PG8_MMA(0, 0, At, B0); PG8_MMA(0, 1, At, B1); PG8_BAR; PG8_SCHED;
            PG8_LDA(At, 0, 1); PG8_STAGE(PG8_SB(0, 0), b2, voffB); PG8_STAGE(PG8_SB(0, 1), b2 + hstepB, voffB); PG8_STAGE(PG8_SA(0, 0), a2, voffA);
            PG8_WAIT_V(8); PG8_WAIT_L(0); PG8_BAR; PG8_MMA(1, 0, At, B0); PG8_MMA(1, 1, At, B1); PG8_BAR; PG8_SCHED;
            PG8_LDB(B0, 1, 0); PG8_LDB(B1, 1, 1); PG8_SCHED; PG8_LDA(At, 1, 0); PG8_STAGE(PG8_SA(0, 1), a2 + hstepA, voffA);
            PG8_WAIT_V(8); PG8_WAIT_L(0); PG8_BAR; PG8_MMA(0, 0, At, B0); PG8_MMA(0, 1, At, B1); PG8_BAR; PG8_SCHED;
            PG8_LDA(At, 1, 1); PG8_STAGE(PG8_SB(1, 0), b3, voffB); PG8_STAGE(PG8_SB(1, 1), b3 + hstepB, voffB); PG8_STAGE(PG8_SA(1, 0), a3, voffA);
            PG8_WAIT_V(8); PG8_WAIT_L(0); PG8_BAR; PG8_MMA(1, 0, At, B0); PG8_MMA(1, 1, At, B1); PG8_BAR; PG8_SCHED;
            } else {
            PG8_LDB(B0, 0, 0); PG8_SCHED; PG8_LDA(At, 0, 0); PG8_STAGE(PG8_SA(1, 1), a1 + hstepA, voffA);
            PG8_WAIT_L(8); PG8_BAR; PG8_WAIT_L(0); PG8_MMA(0, 0, At, B0); PG8_BAR; PG8_SCHED;
            PG8_LDB(B1, 0, 1); PG8_STAGE(PG8_SB(0, 0), b2, voffB);
            PG8_BAR; PG8_WAIT_L(0); PG8_MMA(0, 1, At, B1); PG8_BAR;
            PG8_LDA(At, 0, 1); PG8_STAGE(PG8_SA(0, 0), a2, voffA);
            PG8_BAR; PG8_WAIT_L(0); PG8_MMA(1, 0, At, B0); PG8_BAR; PG8_SCHED;
            PG8_STAGE(PG8_SB(0, 1), b2 + hstepB, voffB);
            PG8_WAIT_V(6); PG8_BAR; PG8_MMA(1, 1, At, B1); PG8_BAR;
            PG8_LDB(B0, 1, 0); PG8_SCHED; PG8_LDA(At, 1, 0); PG8_STAGE(PG8_SA(0, 1), a2 + hstepA, voffA);
            PG8_WAIT_L(8); PG8_BAR; PG8_WAIT_L(0); PG8_MMA(0, 0, At, B0); PG8_BAR; PG8_SCHED;
            PG8_LDB(B1, 1, 1); PG8_STAGE(PG8_SB(1, 0), b3, voffB);
            PG8_BAR; PG8_WAIT_L(0); PG8_MMA(0, 1, At, B1); PG8_BAR;
            PG8_LDA(At, 1, 1); PG8_STAGE(PG8_SA(1, 0), a3, voffA);
            PG8_BAR; PG8_WAIT_L(0); PG8_MMA(1, 0, At, B0); PG8_BAR; PG8_SCHED;
            PG8_STAGE(PG8_SB(1, 1), b3 + hstepB, voffB);
            PG8_WAIT_V(6); PG8_BAR; PG8_MMA(1, 1, At, B1); PG8_BAR;
            }
        }
        if constexpr (ALIGN_EPI) { if (wr == 0) PG8_BAR; }
        E(acc, cur, wr, wc, fr, fq);
        if (!has_next) break;
#pragma unroll
        for (int a = 0; a < 2; ++a)
#pragma unroll
            for (int b = 0; b < 2; ++b)
#pragma unroll
                for (int m = 0; m < 4; ++m)
#pragma unroll
                    for (int n = 0; n < 2; ++n) acc[a][b][m][n] = (f32x4){0.f, 0.f, 0.f, 0.f};
        cur = nxt; cA = nA; cB = nB; ++ui;
        if constexpr (ALIGN_EPI) { if (wr == 1) PG8_BAR; }
    }
    PG8_WAIT_V(0);
    if constexpr (!ALIGN_EPI) { if (wr == 0) PG8_BAR; }
    PG8_BAR;
#undef PG8_SA
#undef PG8_SB
#undef PG8_STAGE
#undef PG8_LDA
#undef PG8_LDB
#undef PG8_MMA
#undef PG8_WAIT_V
#undef PG8_WAIT_L
#undef PG8_BAR
#undef PG8_SCHED
}
}

struct Params { const float* in[40]; float* out; unsigned char* ws; int ph_lo, ph_hi; };
enum { I_X = 0, I_POS, I_NORM_MIX, I_W_IN, I_MU, I_W0, I_W2, I_A0, I_A2, I_G2, I_KK, I_KA, I_RK, I_LNW, I_LNB, I_VDN, I_VUP, I_VB,
       I_CONVW, I_CONVB, I_WA, I_BA, I_WX, I_BX, I_LAM, I_QN, I_KVN, I_WUQ, I_WUK, I_WUV, I_WOR, I_WOL, I_WOM, I_WOUT, I_NFFN, I_WR, I_WG, I_WU, I_WDN, I_NFIN };
struct Frame {
    LAS unsigned char* lds; int tid, lane, wave, G, bid; int gw, nw;
    const __attribute__((address_space(4))) Params* P; unsigned char* ws;
};
template <class Tp> __device__ __forceinline__ Tp* wsp(const Frame& F, size_t off) { return (Tp*)(F.ws + off); }
typedef __attribute__((address_space(1))) const float gcf_t; typedef __attribute__((address_space(1))) float gf_t; typedef __attribute__((address_space(1))) unsigned char guc_t;
__device__ __forceinline__ const float* gin(const Frame& F, int i) { return (const float*)(gcf_t*)F.P->in[i]; }
__device__ __forceinline__ float* gout(const Frame& F) { return (float*)(gf_t*)F.P->out; }
template <class Tp> __device__ __forceinline__ Tp* opaque(Tp* p) { unsigned long long x = (unsigned long long)p; unsigned lo = (unsigned)x, hi = (unsigned)(x >> 32); asm volatile("" : "+v"(lo), "+v"(hi));
    lo = __builtin_amdgcn_readfirstlane(lo); hi = __builtin_amdgcn_readfirstlane(hi);
    typedef __attribute__((address_space(1))) char gchar_t; gchar_t* g = (gchar_t*)(((unsigned long long)hi << 32) | lo); return (Tp*)g; }

__device__ __forceinline__ void unpack8(const u32x4 w, float (&f)[8]) {
    f[0] = bflo(w.x); f[1] = bfhi(w.x); f[2] = bflo(w.y); f[3] = bfhi(w.y); f[4] = bflo(w.z); f[5] = bfhi(w.z); f[6] = bflo(w.w); f[7] = bfhi(w.w);
}
__device__ __forceinline__ u32x4 pack8(const float (&f)[8]) { u32x4 w; w.x = pk2(f[0], f[1]); w.y = pk2(f[2], f[3]); w.z = pk2(f[4], f[5]); w.w = pk2(f[6], f[7]); return w; }

struct CvtJob { const float* src; bf16_t* dst; int lds_; int Ks; int N; int ldd; int Kd; int koff; int rblock; int rstride; };
__device__ __forceinline__ void cvt_load(const Frame& F, const CvtJob& J, int t, f32x4 (&v)[2]) {
    const int tk = J.Kd >> 6; const int kt = t % tk, ntl = t / tk; const int k0 = kt * 64, n0 = ntl * 64; const int kr = F.tid >> 4, nq = F.tid & 15;
#pragma unroll
    for (int h = 0; h < 2; ++h) { const int k = k0 + kr + 32 * h, ks = k - J.koff, n = n0 + nq * 4; v[h] = (f32x4){0.f, 0.f, 0.f, 0.f};
        if (ks >= 0 && ks < J.Ks && n < J.N) v[h] = *(const f32x4*)(J.src + (size_t)ks * J.lds_ + n); }
}
__device__ __forceinline__ void cvt_finish(const Frame& F, const CvtJob& J, int t, const f32x4 (&v)[2]) {
    LAS float* tile = (LAS float*)F.lds;
    const int tk = J.Kd >> 6; const int kt = t % tk, ntl = t / tk; const int k0 = kt * 64, n0 = ntl * 64;
    { const int kr = F.tid >> 4, nq = F.tid & 15;
#pragma unroll
      for (int h = 0; h < 2; ++h) { LAS float* d = tile + (kr + 32 * h) * 65 + nq * 4; d[0] = v[h][0]; d[1] = v[h][1]; d[2] = v[h][2]; d[3] = v[h][3]; } }
    __syncthreads();
    { const int n = F.tid >> 3, kq = F.tid & 7; float f[8];
#pragma unroll
      for (int i = 0; i < 8; ++i) f[i] = tile[(kq * 8 + i) * 65 + n];
      const int nn = n0 + n;
      if (nn < J.N) { const int drow = (nn / J.rblock) * J.rstride + (nn % J.rblock); *(u32x4*)(J.dst + (size_t)drow * J.ldd + k0 + kq * 8) = pack8(f); } }
    __syncthreads();
}
__device__ __forceinline__ void cvt_tile(const Frame& F, const CvtJob& J, int t) { f32x4 v[2]; cvt_load(F, J, t, v); cvt_finish(F, J, t, v); }
__device__ __forceinline__ int cvt_ntiles(const CvtJob& J) { return ((J.N + 63) >> 6) * (J.Kd >> 6); }

__device__ __forceinline__ CvtJob nm_job(const Frame& F, int l, int j) {
    CvtJob J; J.rblock = 1 << 30; J.rstride = 0; J.koff = 0;
    bf16_t* WIN = wsp<bf16_t>(F, WS_WIN);
    if (j == 0) { J.src = gin(F, I_W_IN) + (size_t)l * DM * IN_COLS; J.lds_ = IN_COLS; J.Ks = DM; J.N = 4800; J.dst = WIN; J.ldd = DM; J.Kd = DM; }
    else if (j == 1) { J.src = gin(F, I_W_IN) + (size_t)l * DM * IN_COLS + 4800; J.lds_ = IN_COLS; J.Ks = DM; J.N = 6144; J.dst = WIN + (size_t)H1W * DM; J.ldd = DM; J.Kd = DM; }
    else if (j == 2) { J.src = gin(F, I_VDN) + (size_t)(l > 0 ? l - 1 : 0) * DM * 32; J.lds_ = 32; J.Ks = l > 0 ? DM : 0; J.N = 32; J.dst = WIN + (size_t)4800 * DM; J.ldd = DM; J.Kd = DM; }
    else if (j == 3) { J.src = gin(F, I_VDN); J.lds_ = 32; J.Ks = 0; J.N = 32; J.dst = WIN + (size_t)4832 * DM; J.ldd = DM; J.Kd = DM; }
    else if (j < 8) { const int i = j - 4, d = i & 1; J.src = (i < 2 ? gin(F, I_W2) : gin(F, I_A2)) + (size_t)(l * 2 + d) * 64 * RW; J.lds_ = RW; J.Ks = 64; J.N = RW;
        J.dst = wsp<bf16_t>(F, WS_WL1) + (size_t)i * RW * 256; J.ldd = 256; J.Kd = 256; J.koff = 64 * i; }
    else if (j == 8) { J.src = gin(F, I_G2) + (size_t)l * 128 * RW; J.lds_ = RW; J.Ks = 128; J.N = RW; J.dst = wsp<bf16_t>(F, WS_WL2); J.ldd = 256; J.Kd = 256; }
    else if (j == 9) { J.src = gin(F, I_VUP) + (size_t)(l > 0 ? l - 1 : 0) * 32 * RW; J.lds_ = RW; J.Ks = l > 0 ? 32 : 0; J.N = RW; J.dst = wsp<bf16_t>(F, WS_WL2) + (size_t)RW * 256; J.ldd = 256; J.Kd = 256; J.koff = 128; }
    else if (j < 34) { const int q = j - 10, gp = q >> 3, b = (q >> 2) & 1, kind = q & 3, blk = 2 * gp + b, d = kind & 1;
        J.src = (kind < 2 ? gin(F, I_WA) : gin(F, I_WX)) + (size_t)((l * 2 + d) * 6 + blk) * 128 * 128; J.lds_ = 128; J.Ks = 128; J.N = 128;
        J.dst = wsp<bf16_t>(F, WS_WLRU) + (size_t)(gp * 1024 + b * 512 + kind * 128) * 256; J.ldd = 256; J.Kd = 256; J.koff = b * 128; }
    else if (j == 34) { J.src = gin(F, I_WOR) + (size_t)l * RW * DM; J.lds_ = DM; J.Ks = RW; J.N = DM; J.dst = wsp<bf16_t>(F, WS_WOA); J.ldd = RW; J.Kd = RW; }
    else if (j == 35) { J.src = gin(F, I_WOL) + (size_t)l * LW * DM; J.lds_ = DM; J.Ks = LW; J.N = DM; J.dst = wsp<bf16_t>(F, WS_WOB); J.ldd = LW; J.Kd = LW; }
    else { J.src = gin(F, I_WOUT) + (size_t)l * DM * DM; J.lds_ = DM; J.Ks = DM; J.N = DM; J.dst = wsp<bf16_t>(F, WS_WOUT); J.ldd = DM; J.Kd = DM; }
    return J;
}
constexpr int NM_JOBS = 37;

struct NmCur { int j, cum0, nt; CvtJob J; };
__device__ __forceinline__ void nm_seek(const Frame& F, int l, NmCur& c, int g) {
    while (c.j < NM_JOBS && g >= c.cum0 + c.nt) { c.cum0 += c.nt; ++c.j; if (c.j < NM_JOBS) { c.J = nm_job(F, l, c.j); c.nt = cvt_ntiles(c.J); } }
}
__device__ __forceinline__ void phase_cvt_nm(const Frame& F, int l) {
    NmCur cl; cl.j = 0; cl.cum0 = 0; cl.J = nm_job(F, l, 0); cl.nt = cvt_ntiles(cl.J);
    NmCur cf = cl;
    f32x4 cv[2], c1[2];
    cv[0] = cv[1] = c1[0] = c1[1] = (f32x4){0.f, 0.f, 0.f, 0.f};
    { nm_seek(F, l, cl, F.bid); if (cl.j < NM_JOBS) cvt_load(F, cl.J, F.bid - cl.cum0, cv); }
    { nm_seek(F, l, cl, F.bid + F.G); if (cl.j < NM_JOBS) cvt_load(F, cl.J, F.bid + F.G - cl.cum0, c1); }
    for (int g = F.bid; ; g += F.G) {
        nm_seek(F, l, cf, g); if (cf.j >= NM_JOBS) break;
        f32x4 c2[2]; c2[0] = c1[0]; c2[1] = c1[1];
        { nm_seek(F, l, cl, g + 2 * F.G); if (cl.j < NM_JOBS) cvt_load(F, cl.J, g + 2 * F.G - cl.cum0, c2); }
        cvt_finish(F, cf.J, g - cf.cum0, cv); cv[0] = c1[0]; cv[1] = c1[1]; c1[0] = c2[0]; c1[1] = c2[1];
    }
    { const float* wuq = gin(F, I_WUQ) + (size_t)l * 384 * 768; const float* wuk = gin(F, I_WUK) + (size_t)l * 128 * 512; bf16_t* WQ = wsp<bf16_t>(F, WS_WQ);
      for (int o = F.bid * NTHR + F.tid; o < 4 * 64 * 384; o += F.G * NTHR) { const int i = o % 384, hc = o / 384, h = hc >> 6, cc = hc & 63, g = cc >> 5, ii = cc & 31; const int js = (ii < 16) ? (16 * g + ii) : (32 + 16 * g + ii - 16);
          WQ[(size_t)(h * 192 + 128 + cc) * 384 + i] = (bf16_t)f2bf(wuq[(size_t)i * 768 + h * 192 + 128 + js]); }
      for (int wt = F.gw; wt < 4 * 8 * 6; wt += F.nw) {
          const int hcb = wt / 6, ib = wt % 6, h = hcb >> 3, cb = hcb & 7, i = ib * 64 + F.lane;
          const float* a = wuq + (size_t)i * 768 + h * 192; const float* b = wuk + (size_t)(cb * 16) * 512 + h * 128;
          float acc[16];
#pragma unroll
          for (int j = 0; j < 16; ++j) acc[j] = 0.f;
#pragma unroll 1
          for (int d = 0; d < 128; d += 4) { const f32x4 av = *(const f32x4*)(a + d);
#pragma unroll
              for (int j = 0; j < 16; ++j) { const f32x4 bv = *(const f32x4*)(b + (size_t)j * 512 + d); acc[j] += av[0] * bv[0] + av[1] * bv[1] + av[2] * bv[2] + av[3] * bv[3]; } }
#pragma unroll
          for (int j = 0; j < 16; ++j) WQ[(size_t)(h * 192 + cb * 16 + j) * 384 + i] = (bf16_t)f2bf(acc[j]); } }
    { const float* wuv = gin(F, I_WUV) + (size_t)l * 128 * 512; const float* wom = gin(F, I_WOM) + (size_t)l * 512 * DM; bf16_t* WOC = wsp<bf16_t>(F, WS_WOC);
      for (int bt = F.bid; bt < 4 * 4 * 8; bt += F.G) { const int nb = bt & 3, hcb = bt >> 2, h = hcb >> 3, cb = hcb & 7, n = nb * 512 + F.tid;
          const float* a = wuv + (size_t)(cb * 16) * 512 + h * 128; const float* b = wom + (size_t)(h * 128) * DM + n;
          float acc[16];
#pragma unroll
          for (int j = 0; j < 16; ++j) acc[j] = 0.f;
#pragma unroll 1
          for (int d = 0; d < 128; d += 4) { float bv[4];
#pragma unroll
              for (int e = 0; e < 4; ++e) bv[e] = b[(size_t)(d + e) * DM];
#pragma unroll
              for (int j = 0; j < 16; ++j) { const f32x4 av = *(const f32x4*)(a + (size_t)j * 512 + d); acc[j] += av[0] * bv[0] + av[1] * bv[1] + av[2] * bv[2] + av[3] * bv[3]; } }
          u32x4 w0, w1; w0.x = pk2(acc[0], acc[1]); w0.y = pk2(acc[2], acc[3]); w0.z = pk2(acc[4], acc[5]); w0.w = pk2(acc[6], acc[7]); w1.x = pk2(acc[8], acc[9]); w1.y = pk2(acc[10], acc[11]); w1.z = pk2(acc[12], acc[13]); w1.w = pk2(acc[14], acc[15]);
          u32x4* dst = (u32x4*)(WOC + (size_t)n * 512 + h * 128 + cb * 16); dst[0] = w0; dst[1] = w1; } }
}

__device__ __forceinline__ CvtJob moe_job(const Frame& F, int l, int job) {
    const int e = job / 3, kind = job % 3; CvtJob J; J.koff = 0;
    if (kind < 2) { J.src = (kind == 0 ? gin(F, I_WG) : gin(F, I_WU)) + (size_t)(l * NE + e) * DM * FF; J.lds_ = FF; J.Ks = DM; J.N = FF;
        J.dst = wsp<bf16_t>(F, WS_WGU) + (size_t)e * 2048 * DM + (size_t)kind * 16 * DM; J.ldd = DM; J.Kd = DM; J.rblock = 16; J.rstride = 32; }
    else { J.src = gin(F, I_WDN) + (size_t)(l * NE + e) * FF * DM; J.lds_ = DM; J.Ks = FF; J.N = DM; J.dst = wsp<bf16_t>(F, WS_WD) + (size_t)e * DM * FF; J.ldd = FF; J.Kd = FF; J.rblock = 1 << 30; J.rstride = 0; }
    return J;
}
__device__ __forceinline__ int moe_job_of(int which, int jj) { return which == 0 ? 3 * jj + 2 : 3 * (jj >> 1) + (jj & 1); }
__device__ __forceinline__ void phase_cvt_moe(const Frame& F, int l, int bid, int nblk, int reps, int which) {
    const int NJ = (which == 0 ? 16 : 32) * 512; const int NT_ = NJ * reps; if (bid >= NT_) return;
    f32x4 cv[2], c1[2]; { const int t = bid % NJ; const CvtJob J = moe_job(F, l, moe_job_of(which, t >> 9)); cvt_load(F, J, t & 511, cv); }
    c1[0] = cv[0]; c1[1] = cv[1];
    if (bid + nblk < NT_) { const int t = (bid + nblk) % NJ; const CvtJob J = moe_job(F, l, moe_job_of(which, t >> 9)); cvt_load(F, J, t & 511, c1); }
    for (int t_ = bid; t_ < NT_; t_ += nblk) { const int t = t_ % NJ; const CvtJob J = moe_job(F, l, moe_job_of(which, t >> 9));
        f32x4 c2[2]; c2[0] = c1[0]; c2[1] = c1[1];
        if (t_ + 2 * nblk < NT_) { const int t2 = (t_ + 2 * nblk) % NJ; const CvtJob J2 = moe_job(F, l, moe_job_of(which, t2 >> 9)); cvt_load(F, J2, t2 & 511, c2); }
        cvt_finish(F, J, t & 511, cv); cv[0] = c1[0]; cv[1] = c1[1]; c1[0] = c2[0]; c1[1] = c2[1]; }
}

__device__ __forceinline__ void phase_rope_table(const Frame& F) {
    const int* pos = (const int*)gin(F, I_POS); float* C = wsp<float>(F, WS_COS); float* S = wsp<float>(F, WS_SIN);
    for (int o = F.bid * NTHR + F.tid; o < T * 32; o += F.G * NTHR) { const int t = o >> 5, j = o & 31;
        const float inv = powf(10000.0f, -(float)(2 * j) / 64.0f); const float ang = (float)pos[t] * inv; float s, c; sincosf(ang, &s, &c); C[o] = c; S[o] = s; }
}

__device__ __forceinline__ void phase_norm(const Frame& F, int mode, const float* gain) {
    float* X = gout(F); bf16_t* XN = wsp<bf16_t>(F, WS_XN);
    const int* SLOT = wsp<int>(F, WS_SLOT); const bf16_t* SLAB = wsp<bf16_t>(F, WS_SLAB);
    for (int row = F.gw; row < T; row += F.nw) {
        f32x4 v[8]; const float* src = (mode == 0 ? gin(F, I_X) : X) + (size_t)row * DM;
#pragma unroll
        for (int i = 0; i < 8; ++i) v[i] = *(const f32x4*)(src + i * 256 + F.lane * 4);
        if (mode != 0) {
            const int myslot = SLOT[(F.lane & 15) * T + row];
            unsigned m = (unsigned)(__ballot(myslot >= 0) & 0xFFFFull);
            while (m) { const int e0 = __builtin_ctz(m); m &= m - 1; const bool two = m != 0; const int e1 = two ? __builtin_ctz(m) : e0; if (two) m &= m - 1;
                const int s0 = __builtin_amdgcn_readlane(myslot, e0), s1 = __builtin_amdgcn_readlane(myslot, e1);
                const bf16_t* r0 = SLAB + ((size_t)e0 * CAP + s0) * DM; const bf16_t* r1 = SLAB + ((size_t)e1 * CAP + s1) * DM;
                u32x2 w0[8], w1[8];
#pragma unroll
                for (int i = 0; i < 8; ++i) { w0[i] = *(const u32x2*)(r0 + i * 256 + F.lane * 4); w1[i] = *(const u32x2*)(r1 + i * 256 + F.lane * 4); }
#pragma unroll
                for (int i = 0; i < 8; ++i) { v[i][0] += bflo(w0[i].x); v[i][1] += bfhi(w0[i].x); v[i][2] += bflo(w0[i].y); v[i][3] += bfhi(w0[i].y); }
                if (two) {
#pragma unroll
                    for (int i = 0; i < 8; ++i) { v[i][0] += bflo(w1[i].x); v[i][1] += bfhi(w1[i].x); v[i][2] += bflo(w1[i].y); v[i][3] += bfhi(w1[i].y); } } }
        }
        float ss = 0.f;
#pragma unroll
        for (int i = 0; i < 8; ++i) ss += v[i][0] * v[i][0] + v[i][1] * v[i][1] + v[i][2] * v[i][2] + v[i][3] * v[i][3];
        ss = wave_sum(ss); const float rstd = rsqrtf(ss * (1.0f / DM) + 1e-6f);
        if (mode != 2) {
#pragma unroll
            for (int i = 0; i < 8; ++i) *(f32x4*)(X + (size_t)row * DM + i * 256 + F.lane * 4) = v[i];
#pragma unroll
            for (int i = 0; i < 8; ++i) { const f32x4 g = *(const f32x4*)(gain + i * 256 + F.lane * 4); u32x2 w; w.x = pk2(v[i][0] * rstd * g[0], v[i][1] * rstd * g[1]); w.y = pk2(v[i][2] * rstd * g[2], v[i][3] * rstd * g[3]);
                *(u32x2*)(XN + (size_t)row * DM + i * 256 + F.lane * 4) = w; }
        } else {
#pragma unroll
            for (int i = 0; i < 8; ++i) { const f32x4 g = *(const f32x4*)(gain + i * 256 + F.lane * 4); f32x4 o; o[0] = v[i][0] * rstd * g[0]; o[1] = v[i][1] * rstd * g[1]; o[2] = v[i][2] * rstd * g[2]; o[3] = v[i][3] * rstd * g[3];
                *(f32x4*)(X + (size_t)row * DM + i * 256 + F.lane * 4) = o; }
        }
    }
}

struct AddrLin { const char* A; const char* B; size_t am, an, bm, bn; int ash, bsh;
    __device__ __forceinline__ const char* a(int pm, int pn) const { return A + (size_t)pm * am + (size_t)(pn >> ash) * an; }
    __device__ __forceinline__ const char* b(int pm, int pn) const { return B + (size_t)(pm >> bsh) * bm + (size_t)pn * bn; } };
typedef pg8::Order<AddrLin> OrderL;
#define EPI_ARGS const f32x4 (&acc)[2][2][4][2], const pg8::Unit& u, int wr, int wc, int fr, int fq
#define EPI_ROWS _Pragma("unroll") for (int ai = 0; ai < 2; ++ai) _Pragma("unroll") for (int m = 0; m < 4; ++m, ({ asm volatile("" ::: "memory"); }))
#define EPI_ROW (u.pm * 256 + ai * 128 + wr * 64 + m * 16 + fr)
__device__ __forceinline__ u32x2 pk4(const f32x4 v) { u32x2 w; w.x = pk2(v[0], v[1]); w.y = pk2(v[2], v[3]); return w; }
__device__ __forceinline__ f32x4 up4(const u32x2 w) { return (f32x4){bflo(w.x), bfhi(w.x), bflo(w.y), bfhi(w.y)}; }

struct EpiWin { static constexpr bool PERM = true; unsigned char* ws;
    __device__ __forceinline__ void operator()(EPI_ARGS) const { bf16_t* H1 = (bf16_t*)(ws + WS_H1); bf16_t* HG = (bf16_t*)(ws + WS_HG);
        const bool gates = u.pn >= 19; bf16_t* base = gates ? HG : H1; const int ldc = gates ? HGW : H1W; const int colt = (gates ? u.pn - 19 : u.pn) * 256 + wc * 32 + 8 * fq;
        EPI_ROWS { bf16_t* rowp = base + (size_t)EPI_ROW * ldc + colt;
#pragma unroll
            for (int bj = 0; bj < 2; ++bj) { f32x4 v0 = acc[ai][bj][m][0], v1 = acc[ai][bj][m][1];
                if (gates) {
#pragma unroll
                    for (int i = 0; i < 4; ++i) { v0[i] = sigmoidf_(v0[i]); v1[i] = sigmoidf_(v1[i]); } }
                u32x4 w; w.x = pk2(v0[0], v0[1]); w.y = pk2(v0[2], v0[3]); w.z = pk2(v1[0], v1[1]); w.w = pk2(v1[2], v1[3]);
                *(u32x4*)(rowp + bj * 128) = w; } }
    } };

struct EpiLora1 { static constexpr bool PERM = false; const float* w0; const float* a0; const float* ka; unsigned char* ws;
    __device__ __forceinline__ void operator()(EPI_ARGS) const {
        const bf16_t* KK = (const bf16_t*)(ws + WS_KK); const bf16_t* K = (const bf16_t*)(ws + WS_K); bf16_t* E = (bf16_t*)(ws + WS_E); bf16_t* BV = (bf16_t*)(ws + WS_BV); bf16_t* KD = (bf16_t*)(ws + WS_KD);
        const int seg = u.pn / 3; const int j0 = (u.pn % 3) * 256 + wc * 32 + 4 * fq;
        if (seg < 2) { const float* w0s = w0 + seg * RW; bf16_t* Es = E + (size_t)seg * T * RW;
            EPI_ROWS { const size_t ro = (size_t)EPI_ROW * RW;
#pragma unroll
                for (int bj = 0; bj < 2; ++bj)
#pragma unroll
                    for (int n = 0; n < 2; ++n) { const int j = j0 + bj * 128 + n * 16; const f32x4 v = acc[ai][bj][m][n]; f32x4 o; const f32x4 b = *(const f32x4*)(w0s + j);
#pragma unroll
                        for (int i = 0; i < 4; ++i) { const float z = b[i] + v[i]; o[i] = -0.6065306597126334f * sigmoidf_(z); }
                        *(u32x2*)(Es + ro + j) = pk4(o); } }
        } else { const int d = seg - 2; const float* a0s = a0 + d * RW; bf16_t* BVs = BV + (size_t)d * T * RW; bf16_t* KDs = KD + (size_t)d * T * RW;
            f32x4 bq[4], kaq[4];
#pragma unroll
            for (int x_ = 0; x_ < 4; ++x_) { const int j = j0 + (x_ >> 1) * 128 + (x_ & 1) * 16; bq[x_] = *(const f32x4*)(a0s + j); kaq[x_] = *(const f32x4*)(ka + j); }
            const size_t row0 = (size_t)u.pm * 256 + wr * 64 + fr; u32x2 kkq[2][4], kq_[2][4];
#define EL_LD(rr, b_) do { const size_t ro_ = (row0 + ((rr) >> 2) * 128 + ((rr) & 3) * 16) * RW; _Pragma("unroll") for (int x_ = 0; x_ < 4; ++x_) { const int j_ = j0 + (x_ >> 1) * 128 + (x_ & 1) * 16; kkq[b_][x_] = *(const u32x2*)(KK + ro_ + j_); kq_[b_][x_] = *(const u32x2*)(K + ro_ + j_); } } while (0)
            EL_LD(0, 0);
#pragma unroll
            for (int rr = 0; rr < 8; ++rr) { const int ai = rr >> 2, m = rr & 3; const size_t ro = (row0 + ai * 128 + m * 16) * RW;
                if (rr < 7) EL_LD(rr + 1, (rr + 1) & 1);
#pragma unroll
                for (int x_ = 0; x_ < 4; ++x_) { const int bj = x_ >> 1, n = x_ & 1; const int j = j0 + bj * 128 + n * 16; const f32x4 v = acc[ai][bj][m][n]; f32x4 o, o2; const f32x4 kk = up4(kkq[rr & 1][x_]), k = up4(kq_[rr & 1][x_]);
#pragma unroll
                    for (int i = 0; i < 4; ++i) { const float a = sigmoidf_(bq[x_][i] + v[i]); o[i] = a * kk[i]; o2[i] = k[i] * (1.0f + (a - 1.0f) * kaq[x_][i]); }
                    *(u32x2*)(BVs + ro + j) = pk4(o); *(u32x2*)(KDs + ro + j) = pk4(o2); } }
#undef EL_LD
        }
    } };

struct EpiLora2 { static constexpr bool PERM = false; const float* vb; unsigned char* ws;
    __device__ __forceinline__ void operator()(EPI_ARGS) const { bf16_t* G = (bf16_t*)(ws + WS_G); bf16_t* V = (bf16_t*)(ws + WS_V); const bf16_t* VF = (const bf16_t*)(ws + WS_VF);
        const int seg = u.pn / 3; const int j0 = (u.pn % 3) * 256 + wc * 32 + 4 * fq; const size_t row0 = (size_t)u.pm * 256 + wr * 64 + fr;
        if (seg == 0) {
            EPI_ROWS { const size_t ro = (size_t)EPI_ROW * RW;
#pragma unroll
                for (int x_ = 0; x_ < 4; ++x_) *(u32x2*)(G + ro + j0 + (x_ >> 1) * 128 + (x_ & 1) * 16) = pk4(acc[ai][x_ >> 1][m][x_ & 1]); }
        } else { f32x4 bq[4]; u32x2 vq[2][4], fq_[2][4];
#pragma unroll
            for (int x_ = 0; x_ < 4; ++x_) bq[x_] = *(const f32x4*)(vb + j0 + (x_ >> 1) * 128 + (x_ & 1) * 16);
#define E2_LD(rr, b_) do { const size_t ro_ = (row0 + ((rr) >> 2) * 128 + ((rr) & 3) * 16) * RW; _Pragma("unroll") for (int x_ = 0; x_ < 4; ++x_) { const int j_ = j0 + (x_ >> 1) * 128 + (x_ & 1) * 16; vq[b_][x_] = *(const u32x2*)(V + ro_ + j_); fq_[b_][x_] = *(const u32x2*)(VF + ro_ + j_); } } while (0)
            E2_LD(0, 0);
#pragma unroll
            for (int rr = 0; rr < 8; ++rr) { const int ai = rr >> 2, m = rr & 3; const size_t ro = (row0 + ai * 128 + m * 16) * RW;
                if (rr < 7) E2_LD(rr + 1, (rr + 1) & 1);
#pragma unroll
                for (int x_ = 0; x_ < 4; ++x_) { const int j = j0 + (x_ >> 1) * 128 + (x_ & 1) * 16; const f32x4 v = acc[ai][x_ >> 1][m][x_ & 1]; const f32x4 vv = up4(vq[rr & 1][x_]), vf = up4(fq_[rr & 1][x_]); f32x4 o;
#pragma unroll
                    for (int i = 0; i < 4; ++i) { const float g = sigmoidf_(bq[x_][i] + v[i]); o[i] = vv[i] + (vf[i] - vv[i]) * g; }
                    *(u32x2*)(V + ro + j) = pk4(o); } }
#undef E2_LD
        }
    } };

struct EpiLru { static constexpr bool PERM = false; const float* ba; const float* bx; const float* lam; unsigned char* ws;
    __device__ __forceinline__ void operator()(EPI_ARGS) const { bf16_t* LOGA = (bf16_t*)(ws + WS_LOGA); bf16_t* IG = (bf16_t*)(ws + WS_IG);
        const int gp = u.pn >> 2, q = u.pn & 3, b = q >> 1;
        f32x4 bias[2][2], sp8[2][2];
#pragma unroll
        for (int bj = 0; bj < 2; ++bj)
#pragma unroll
            for (int n = 0; n < 2; ++n) { const int kind = (q & 1) * 2 + bj, d = kind & 1; const int ch = (2 * gp + b) * 128 + wc * 32 + n * 16 + 4 * fq;
                bias[bj][n] = *(const f32x4*)((kind < 2 ? ba : bx) + d * LW + ch); const f32x4 lm = *(const f32x4*)(lam + d * LW + ch);
#pragma unroll
                for (int i = 0; i < 4; ++i) sp8[bj][n][i] = -8.0f * softplusf_(-lm[i]); }
        EPI_ROWS { const size_t ro = (size_t)EPI_ROW * LW;
#pragma unroll
            for (int bj = 0; bj < 2; ++bj)
#pragma unroll
                for (int n = 0; n < 2; ++n) { const int kind = (q & 1) * 2 + bj, d = kind & 1; const int ch = (2 * gp + b) * 128 + wc * 32 + n * 16 + 4 * fq; const f32x4 v = acc[ai][bj][m][n]; f32x4 o;
#pragma unroll
                    for (int i = 0; i < 4; ++i) { const float sg = sigmoidf_(v[i] + bias[bj][n][i]); o[i] = kind < 2 ? sg * sp8[bj][n][i] : sg; }
                    *(u32x2*)((kind < 2 ? LOGA : IG) + (size_t)d * T * LW + ro + ch) = pk4(o); } }
    } };

struct EpiMlaQ { static constexpr bool PERM = false; unsigned char* ws;
    __device__ __forceinline__ void operator()(EPI_ARGS) const { const float* COS = (const float*)(ws + WS_COS); const float* SIN = (const float*)(ws + WS_SIN); bf16_t* Q = (bf16_t*)(ws + WS_Q);
        EPI_ROWS { const int row = EPI_ROW; bf16_t* rowp = Q + (size_t)row * QW;
#pragma unroll
            for (int bj = 0; bj < 2; ++bj) { const int gb = u.pn * 256 + bj * 128 + wc * 32; const int cc = gb % 192;
                if (cc < 128) {
#pragma unroll
                    for (int n = 0; n < 2; ++n) { f32x4 v = acc[ai][bj][m][n]; v[0] *= QSCALE; v[1] *= QSCALE; v[2] *= QSCALE; v[3] *= QSCALE; *(u32x2*)(rowp + gb + n * 16 + 4 * fq) = pk4(v); }
                } else { const int g = (cc - 128) >> 5; const int j = 16 * g + 4 * fq; const f32x4 c = *(const f32x4*)(COS + (size_t)row * 32 + j), s = *(const f32x4*)(SIN + (size_t)row * 32 + j);
                    const f32x4 x1 = acc[ai][bj][m][0], x2 = acc[ai][bj][m][1]; f32x4 o1, o2;
#pragma unroll
                    for (int i = 0; i < 4; ++i) { o1[i] = (x1[i] * c[i] - x2[i] * s[i]) * QSCALE; o2[i] = (x1[i] * s[i] + x2[i] * c[i]) * QSCALE; }
                    *(u32x2*)(rowp + gb + 4 * fq) = pk4(o1); *(u32x2*)(rowp + gb + 16 + 4 * fq) = pk4(o2); } } }
    } };

struct EpiMerge { static constexpr bool PERM = true; unsigned char* ws; int step;
    __device__ __forceinline__ void operator()(EPI_ARGS) const { const bf16_t* HG = (const bf16_t*)(ws + WS_HG); bf16_t* MG = (bf16_t*)(ws + WS_MERGED);
        const int c0 = u.pn * 256 + wc * 32 + 8 * fq; const size_t row0 = (size_t)u.pm * 256 + wr * 64 + fr;
        u32x4 gq[2][2], pq[2][2];
#define EM_LD(rr, b_) do { const size_t row_ = row0 + ((rr) >> 2) * 128 + ((rr) & 3) * 16; _Pragma("unroll") for (int x_ = 0; x_ < 2; ++x_) { const int c_ = c0 + x_ * 128; \
            gq[b_][x_] = *(const u32x4*)(HG + row_ * HGW + step * DM + c_); pq[b_][x_] = step > 0 ? *(const u32x4*)(MG + row_ * DM + c_) : (u32x4){0u, 0u, 0u, 0u}; } } while (0)
        EM_LD(0, 0);
#pragma unroll
        for (int rr = 0; rr < 8; ++rr) { const int ai = rr >> 2, m = rr & 3; const size_t row = row0 + ai * 128 + m * 16;
            if (rr < 7) EM_LD(rr + 1, (rr + 1) & 1);
#pragma unroll
            for (int bj = 0; bj < 2; ++bj) { float g[8], p[8]; unpack8(gq[rr & 1][bj], g); unpack8(pq[rr & 1][bj], p); const f32x4 v0 = acc[ai][bj][m][0], v1 = acc[ai][bj][m][1]; float o[8];
#pragma unroll
                for (int i = 0; i < 4; ++i) { o[i] = v0[i] * g[i] + p[i]; o[4 + i] = v1[i] * g[4 + i] + p[4 + i]; }
                *(u32x4*)(MG + row * DM + c0 + bj * 128) = pack8(o); } }
#undef EM_LD
    } };

struct EpiWout { static constexpr bool PERM = false; float* X; float* Y;
    __device__ __forceinline__ void operator()(EPI_ARGS) const {
        const int c0 = u.pn * 256 + wc * 32 + 4 * fq; const size_t row0 = (size_t)u.pm * 256 + wr * 64 + fr;
        f32x4 xq[2][4];
#define EW_LD(rr, b_) do { const float* rp_ = X + (row0 + ((rr) >> 2) * 128 + ((rr) & 3) * 16) * DM + c0; _Pragma("unroll") for (int x_ = 0; x_ < 4; ++x_) xq[b_][x_] = *(const f32x4*)(rp_ + (x_ >> 1) * 128 + (x_ & 1) * 16); } while (0)
        EW_LD(0, 0);
#pragma unroll
        for (int rr = 0; rr < 8; ++rr) { const int ai = rr >> 2, m = rr & 3; float* rowq = Y + (row0 + ai * 128 + m * 16) * DM + c0;
            if (rr < 7) EW_LD(rr + 1, (rr + 1) & 1);
#pragma unroll
            for (int x_ = 0; x_ < 4; ++x_) *(f32x4*)(rowq + (x_ >> 1) * 128 + (x_ & 1) * 16) = xq[rr & 1][x_] + acc[ai][x_ >> 1][m][x_ & 1]; }
#undef EW_LD
    } };

struct EpiMoeUp { static constexpr bool PERM = false; unsigned char* ws;
    __device__ __forceinline__ void operator()(EPI_ARGS) const { bf16_t* HDN = (bf16_t*)(ws + WS_HDN);
        EPI_ROWS { bf16_t* rowp = HDN + (size_t)EPI_ROW * FF;
#pragma unroll
            for (int bj = 0; bj < 2; ++bj) { const int gb = u.pn * 256 + bj * 128 + wc * 32; const int jb = (gb >> 5) * 16 + 4 * fq; const f32x4 g = acc[ai][bj][m][0], uu = acc[ai][bj][m][1]; f32x4 o;
#pragma unroll
                for (int i = 0; i < 4; ++i) o[i] = g[i] * sigmoidf_(g[i]) * uu[i];
                *(u32x2*)(rowp + jb) = pk4(o); } }
    } };

struct EpiMoeDown { static constexpr bool PERM = true; unsigned char* ws;
    __device__ __forceinline__ void operator()(EPI_ARGS) const { const float* GATEV = (const float*)(ws + WS_GATEV); bf16_t* SLAB = (bf16_t*)(ws + WS_SLAB);
        const int c0 = u.pn * 256 + wc * 32 + 8 * fq; const size_t row0 = (size_t)u.pm * 256 + wr * 64 + fr; float gvv[8];
#pragma unroll
        for (int rr = 0; rr < 8; ++rr) gvv[rr] = GATEV[row0 + (rr >> 2) * 128 + (rr & 3) * 16];
#pragma unroll
        for (int rr = 0; rr < 8; ++rr) { const int ai = rr >> 2, m = rr & 3; const float gv = gvv[rr]; bf16_t* rowp = SLAB + (row0 + ai * 128 + m * 16) * DM + c0;
#pragma unroll
            for (int bj = 0; bj < 2; ++bj) { const f32x4 v0 = acc[ai][bj][m][0], v1 = acc[ai][bj][m][1];
                u32x4 w; w.x = pk2(v0[0] * gv, v0[1] * gv); w.y = pk2(v0[2] * gv, v0[3] * gv); w.z = pk2(v1[0] * gv, v1[1] * gv); w.w = pk2(v1[2] * gv, v1[3] * gv);
                *(u32x4*)(rowp + bj * 128) = w; } }
    } };

template <class Epi> __device__ __forceinline__ void run_gemm(const Frame& F, const Epi& E, const void* A, int lda, const void* B, int ldb, int K, int nM, int nN,
                                                              size_t am, size_t an, size_t bm, size_t bn, int ash, int bsh, int reps = 1) {
    AddrLin ad; ad.A = (const char*)A; ad.B = (const char*)B; ad.am = am; ad.an = an; ad.bm = bm; ad.bn = bn; ad.ash = ash; ad.bsh = bsh;
    OrderL S; S.init(nM, nN, F.G, F.bid, ad, reps);
    pg8::Gemm g; g.K = K; g.lda = lda; g.ldb = ldb;
    pg8::gemm_phase<Epi, OrderL, true, true>(F.lds, g, S, E, F.tid, F.wave);
}

__device__ __forceinline__ void ldrow8(const bf16_t* H, int t, int col, float (&f)[8]) {
    if (t < 0 || t >= T) {
#pragma unroll
        for (int i = 0; i < 8; ++i) f[i] = 0.f;
    } else unpack8(*(const u32x4*)(H + (size_t)t * H1W + col), f);
}
__device__ __forceinline__ u32x4 ldraw8(const bf16_t* H, int t, int col) { return (t < 0 || t >= T) ? (u32x4){0u, 0u, 0u, 0u} : *(const u32x4*)(H + (size_t)t * H1W + col); }
__device__ __forceinline__ void ldf8(const float* p, float (&f)[8]) { const f32x4 a = *(const f32x4*)p, b = *(const f32x4*)(p + 4); f[0] = a[0]; f[1] = a[1]; f[2] = a[2]; f[3] = a[3]; f[4] = b[0]; f[5] = b[1]; f[6] = b[2]; f[7] = b[3]; }
__device__ __forceinline__ float tanh_fast(float x) { return 1.0f - 2.0f * __builtin_amdgcn_rcpf(1.0f + __expf(2.0f * x)); }
__device__ __forceinline__ float gelu_tanh(float x) { const float u = 0.7978845608028654f * (x + 0.044715f * x * x * x); return x * __builtin_amdgcn_rcpf(1.0f + __expf(-2.0f * u)); }

__device__ __forceinline__ void phase_prep(const Frame& F, int l, int reps) {
    const bf16_t* H1 = wsp<bf16_t>(F, WS_H1);
    const float* mu = gin(F, I_MU) + (size_t)l * 2 * RWKV_COLS; const float* k_k = gin(F, I_KK) + l * RW;
    const float* cw = gin(F, I_CONVW) + (size_t)l * 4 * LW; const float* cb = gin(F, I_CONVB) + l * LW;
    const float* qn = gin(F, I_QN) + l * 384; const float* kvn = gin(F, I_KVN) + l * 128;
    bf16_t* R = wsp<bf16_t>(F, WS_R); bf16_t* K = wsp<bf16_t>(F, WS_K); bf16_t* V = wsp<bf16_t>(F, WS_V); bf16_t* VF = wsp<bf16_t>(F, WS_VF); bf16_t* KK = wsp<bf16_t>(F, WS_KK);
    bf16_t* AL = wsp<bf16_t>(F, WS_AL); bf16_t* XC = wsp<bf16_t>(F, WS_XC); bf16_t* GB = wsp<bf16_t>(F, WS_GB); bf16_t* AM = wsp<bf16_t>(F, WS_AM); bf16_t* KV = wsp<bf16_t>(F, WS_KV);
    const float* COS = wsp<float>(F, WS_COS); const float* SIN = wsp<float>(F, WS_SIN);
    const int lane = F.lane;
    for (int t_ = F.gw; t_ < T * reps; t_ += F.nw) { const int t = t_ % T;
        u32x4 rwp[6], rwv[6], rwn[6];
#pragma unroll
        for (int it = 0; it < 6; ++it) { const int q = it * 64 + lane; const int col = q < 336 ? q * 8 : 0; rwp[it] = ldraw8(H1, t, col); rwv[it] = ldraw8(H1, t - 1, col); rwn[it] = ldraw8(H1, t + 1, col); }
#pragma unroll
        for (int it = 0; it < 6; ++it) { const int q = it * 64 + lane; const bool on = q < 336; const int col = on ? q * 8 : 0;
            float p[8], pv[8], nx[8], m0[8], m1[8], o[8];
            unpack8(rwp[it], p); unpack8(rwv[it], pv); unpack8(rwn[it], nx); ldf8(mu + col, m0); ldf8(mu + RWKV_COLS + col, m1);
#pragma unroll
            for (int i = 0; i < 8; ++i) o[i] = p[i] + m0[i] * (pv[i] - p[i]) + m1[i] * (nx[i] - p[i]);
            const bool isk = on && col >= 768 && col < 1536; const int j = isk ? col - 768 : 0;
            float kw[8], x[8]; ldf8(k_k + j, kw); float ss = 0.f;
#pragma unroll
            for (int i = 0; i < 8; ++i) { x[i] = o[i] * kw[i]; ss += x[i] * x[i]; }
            ss += shx(ss, 1, lane); ss += shx(ss, 2, lane); ss += shx(ss, 4, lane);
            if (on) {
                if (col < 768) *(u32x4*)(R + (size_t)t * RW + col) = pack8(o);
                else if (col < 1536) { *(u32x4*)(K + (size_t)t * RW + j) = pack8(o); const float inv = 1.0f / fmaxf(sqrtf(ss), 1e-12f);
#pragma unroll
                    for (int i = 0; i < 8; ++i) x[i] *= inv;
                    *(u32x4*)(KK + (size_t)t * RW + j) = pack8(x); }
                else if (col < 2304) { const u32x4 w = pack8(o); *(u32x4*)(V + (size_t)t * RW + col - 1536) = w; if (l == 0) *(u32x4*)(VF + (size_t)t * RW + col - 1536) = w; }
                else { const int ac = col - 2304;
                    if (ac < 128) {
#pragma unroll
                        for (int i = 0; i < 8; ++i) o[i] = tanh_fast(o[i]);
                    } else if (ac >= 256) {
#pragma unroll
                        for (int i = 0; i < 8; ++i) o[i] = sigmoidf_(o[i]);
                    }
                    *(u32x4*)(AL + (size_t)t * 512 + ac) = pack8(o); }
            } }
        if (lane < 16) { u32x4 w = (u32x4){0u, 0u, 0u, 0u}; if (lane < 4 && l > 0) w = *(const u32x4*)(H1 + (size_t)t * H1W + 4800 + lane * 8); *(u32x4*)(AL + (size_t)t * 512 + 384 + lane * 8) = w; }
        u32x4 lr0[2], lr1[2], lr2[2], lr3[2], lgb[2], mq, mk;
#pragma unroll
        for (int it = 0; it < 2; ++it) { const int q = it * 64 + lane; const int c = q < 96 ? q * 8 : 0; lr0[it] = ldraw8(H1, t - 1, 2688 + c); lr1[it] = ldraw8(H1, t, 2688 + c); lr2[it] = ldraw8(H1, t + 1, 2688 + c); lr3[it] = ldraw8(H1, t + 2, 2688 + c); lgb[it] = ldraw8(H1, t, 3456 + c); }
        mq = ldraw8(H1, lane < 48 ? t : -1, 4224 + (lane < 48 ? lane * 8 : 0)); mk = ldraw8(H1, lane < 24 ? t : -1, 4608 + (lane < 24 ? lane * 8 : 0));
#pragma unroll
        for (int it = 0; it < 2; ++it) { const int q = it * 64 + lane;
            if (q < 96) { const int c = q * 8; float a0[8], a1[8], a2[8], a3[8], w0[8], w1[8], w2[8], w3[8], b[8], o[8];
                unpack8(lr0[it], a0); unpack8(lr1[it], a1); unpack8(lr2[it], a2); unpack8(lr3[it], a3);
                ldf8(cw + c, w0); ldf8(cw + LW + c, w1); ldf8(cw + 2 * LW + c, w2); ldf8(cw + 3 * LW + c, w3); ldf8(cb + c, b);
#pragma unroll
                for (int i = 0; i < 8; ++i) o[i] = b[i] + w0[i] * a0[i] + w1[i] * a1[i] + w2[i] * a2[i] + w3[i] * a3[i];
                *(u32x4*)(XC + (size_t)t * LW + c) = pack8(o);
                unpack8(lgb[it], a0);
#pragma unroll
                for (int i = 0; i < 8; ++i) o[i] = gelu_tanh(a0[i]);
                *(u32x4*)(GB + (size_t)t * LW + c) = pack8(o); } }
        { float p[8]; float ss = 0.f; const bool on = lane < 48; unpack8(mq, p);
#pragma unroll
          for (int i = 0; i < 8; ++i) ss += p[i] * p[i];
          ss = wave_sum(ss); const float rstd = rsqrtf(ss * (1.0f / 384.0f) + 1e-6f);
          if (on) { float g[8]; ldf8(qn + lane * 8, g);
#pragma unroll
              for (int i = 0; i < 8; ++i) p[i] = p[i] * rstd * g[i];
              *(u32x4*)(AM + (size_t)t * 384 + lane * 8) = pack8(p); } }
        { float p[8]; float ss = 0.f; const bool on = lane < 24; unpack8(mk, p);
          if (lane < 16) {
#pragma unroll
              for (int i = 0; i < 8; ++i) ss += p[i] * p[i]; }
          ss = wave_sum(ss); const float rstd = rsqrtf(ss * (1.0f / 128.0f) + 1e-6f);
          float oth[8];
#pragma unroll
          for (int i = 0; i < 8; ++i) oth[i] = shx(p[i], 4, lane);
          if (lane < 16) { float g[8]; ldf8(kvn + lane * 8, g);
#pragma unroll
              for (int i = 0; i < 8; ++i) p[i] = p[i] * rstd * g[i];
              *(u32x4*)(KV + (size_t)t * KVW + lane * 8) = pack8(p); }
          else if (lane < 24) { const int i4 = lane - 16, ii = i4 & 3; float c[8], s[8], o[8]; ldf8(COS + (size_t)t * 32 + ii * 8, c); ldf8(SIN + (size_t)t * 32 + ii * 8, s);
              if (i4 < 4) {
#pragma unroll
                  for (int i = 0; i < 8; ++i) o[i] = p[i] * c[i] - oth[i] * s[i];
                  *(u32x4*)(KV + (size_t)t * KVW + 128 + 32 * (ii >> 1) + 8 * (ii & 1)) = pack8(o);
              } else {
#pragma unroll
                  for (int i = 0; i < 8; ++i) o[i] = oth[i] * s[i] + p[i] * c[i];
                  *(u32x4*)(KV + (size_t)t * KVW + 128 + 32 * (ii >> 1) + 16 + 8 * (ii & 1)) = pack8(o);
              } } }
    }
}

__device__ __forceinline__ float ldbf(const bf16_t* p) { return bf2f((unsigned)*p); }
__device__ __forceinline__ void phase_lru_local(const Frame& F, int reps) {
    const bf16_t* LOGA = wsp<bf16_t>(F, WS_LOGA); const bf16_t* IG = wsp<bf16_t>(F, WS_IG); const bf16_t* XC = wsp<bf16_t>(F, WS_XC);
    float* LA = wsp<float>(F, WS_LA); float* LB = wsp<float>(F, WS_LB);
    for (int idx_ = F.bid * NTHR + F.tid; idx_ < 2 * NCH * LW * reps; idx_ += F.G * NTHR) { const int idx = idx_ % (2 * NCH * LW); const int ch = idx % LW, c = (idx / LW) % NCH, d = idx / (LW * NCH);
        float asum = 0.f, h = 0.f; const bf16_t* la = LOGA + (size_t)d * T * LW + ch; const bf16_t* ig = IG + (size_t)d * T * LW + ch;
        for (int s = 0; s < CL; ++s) { const int t = d == 0 ? c * CL + s : c * CL + CL - 1 - s; const float l_ = ldbf(la + (size_t)t * LW);
            const float a = __expf(l_), b = sqrtf(fmaxf(1.0f - a * a, 0.f)) * ldbf(ig + (size_t)t * LW) * ldbf(XC + (size_t)t * LW + ch); h = a * h + b; asum += l_; }
        LA[idx] = __expf(asum); LB[idx] = h; }
}
__device__ __forceinline__ void phase_lru_carry(const Frame& F, int bid0) {
    const float* LA = wsp<float>(F, WS_LA); const float* LB = wsp<float>(F, WS_LB); float* LH0 = wsp<float>(F, WS_LH0);
    const int idx = (F.bid - bid0) * NTHR + F.tid; if (idx < 0 || idx >= 2 * LW) return; const int ch = idx % LW, d = idx / LW; float h = 0.f;
    for (int k = 0; k < NCH; ++k) { const int c = d == 0 ? k : NCH - 1 - k; const int o = (d * NCH + c) * LW + ch; LH0[o] = h; h = LA[o] * h + LB[o]; }
}
__device__ __forceinline__ void phase_lru_out(const Frame& F, int reps) {
    const bf16_t* LOGA = wsp<bf16_t>(F, WS_LOGA); const bf16_t* IG = wsp<bf16_t>(F, WS_IG); const bf16_t* XC = wsp<bf16_t>(F, WS_XC); const bf16_t* GB = wsp<bf16_t>(F, WS_GB);
    const float* LH0 = wsp<float>(F, WS_LH0); bf16_t* YB = wsp<bf16_t>(F, WS_YB);
    for (int idx_ = (F.G - 1 - F.bid) * NTHR + F.tid; idx_ < NCH * LW * reps; idx_ += F.G * NTHR) { const int idx = idx_ % (NCH * LW); const int ch = idx % LW, c = idx / LW; float hf[CL];
        { float h = LH0[(0 * NCH + c) * LW + ch]; int o0 = c * CL * LW + ch; asm volatile("" : "+v"(o0)); const bf16_t* pl = LOGA + o0; const bf16_t* pi = IG + o0; const bf16_t* px = XC + o0;
#pragma unroll
          for (int s = 0; s < CL; ++s) { const float l_ = ldbf(pl + s * LW); const float a = __expf(l_), b = sqrtf(fmaxf(1.0f - a * a, 0.f)) * ldbf(pi + s * LW) * ldbf(px + s * LW); h = a * h + b; hf[s] = h; } }
        { float h = LH0[(1 * NCH + c) * LW + ch]; int o0 = c * CL * LW + ch; asm volatile("" : "+v"(o0)); const bf16_t* pl = LOGA + (size_t)T * LW + o0; const bf16_t* pi = IG + (size_t)T * LW + o0; const bf16_t* px = XC + o0; const bf16_t* pg = GB + o0; bf16_t* py = YB + o0;
#pragma unroll
          for (int sg = CL - 8; sg >= 0; sg -= 8) { float lv[8], iv[8], xv[8], gv[8];
#pragma unroll
              for (int q = 0; q < 8; ++q) { lv[q] = ldbf(pl + (sg + q) * LW); iv[q] = ldbf(pi + (sg + q) * LW); xv[q] = ldbf(px + (sg + q) * LW); gv[q] = ldbf(pg + (sg + q) * LW); }
#pragma unroll
              for (int q = 7; q >= 0; --q) { const int s = sg + q; const float a = __expf(lv[q]), b = sqrtf(fmaxf(1.0f - a * a, 0.f)) * iv[q] * xv[q]; h = a * h + b;
                  py[s * LW] = (bf16_t)f2bf((hf[s] + h) * gv[q]); } } } }
}

namespace wy {
constexpr int RS = 144, MSZ = 64 * RS;
constexpr int O_KK = 0, O_BT = MSZ, O_KT = 2 * MSZ, O_RT = 3 * MSZ, O_BH = 4 * MSZ, O_KH = 5 * MSZ, O_V = 6 * MSZ, O_KKT = 7 * MSZ, O_AKB = 8 * MSZ, O_ABR = 9 * MSZ, O_AT = 10 * MSZ, O_A = 11 * MSZ, O_S12 = 12 * MSZ,
              O_TOT = O_S12, O_GAM = 13 * MSZ, O_END = O_GAM + 256;
constexpr int O_D = O_BT, O_DT = O_KT, O_UT = O_KK, O_M32 = O_AT, O_M32T = O_S12, O_M64T = O_BT, O_P = O_KT, O_Q = O_A, O_ZY = O_KKT, O_X1 = O_AKB;
static_assert(O_END <= 131072, "wy lds");
__device__ __forceinline__ int crow(int r, int hi) { return (r & 3) + 8 * (r >> 2) + 4 * hi; }
__device__ __forceinline__ f32x16 tile_mm(const LAS char* Aop, int m0, const LAS char* Bop, int n0, int lane) {
    f32x16 acc = (f32x16)(0.f); const int r = lane & 31, hh = lane >> 5;
#pragma unroll
    for (int ks = 0; ks < 4; ++ks) { const bf16x8 a = *(const LAS bf16x8*)(Aop + (m0 + r) * RS + (ks * 16 + hh * 8) * 2), b = *(const LAS bf16x8*)(Bop + (n0 + r) * RS + (ks * 16 + hh * 8) * 2);
        acc = __builtin_amdgcn_mfma_f32_32x32x16_bf16(a, b, acc, 0, 0, 0); }
    return acc;
}
__device__ __forceinline__ void store_t_bf16(LAS char* dst, const f32x16& c, int m0, int n0, int lane) {
    LAS char* p = dst + (n0 + (lane & 31)) * RS + (m0 + 4 * (lane >> 5)) * 2;
#pragma unroll
    for (int g = 0; g < 4; ++g) { u32x2 w; w.x = pk2(c[4 * g], c[4 * g + 1]); w.y = pk2(c[4 * g + 2], c[4 * g + 3]); *(LAS u32x2*)(p + 16 * g) = w; }
}
__device__ __forceinline__ void store_n_bf16(LAS char* dst, const f32x16& c, int m0, int n0, int lane) {
    LAS char* p = dst + (m0 + 4 * (lane >> 5)) * RS + (n0 + (lane & 31)) * 2;
#pragma unroll
    for (int r = 0; r < 16; ++r) *(LAS bf16_t*)(p + ((r & 3) + 8 * (r >> 2)) * RS) = (bf16_t)f2bf(c[r]);
}
__device__ __forceinline__ f32x16 load_acc_from_t(const LAS char* xt, int m0, int n0, int lane) {
    f32x16 v; const LAS char* p = xt + (n0 + (lane & 31)) * RS + (m0 + 4 * (lane >> 5)) * 2;
#pragma unroll
    for (int g = 0; g < 4; ++g) { const f32x4 t4 = up4(*(const LAS u32x2*)(p + 16 * g)); v[4 * g] = t4[0]; v[4 * g + 1] = t4[1]; v[4 * g + 2] = t4[2]; v[4 * g + 3] = t4[3]; }
    return v;
}
}

__device__ __forceinline__ void phase_rwkv_local(const Frame& F, int reps) {
    using namespace wy;
    const bf16_t* E = wsp<bf16_t>(F, WS_E); const bf16_t* BV = wsp<bf16_t>(F, WS_BV); const bf16_t* KKg = wsp<bf16_t>(F, WS_KK); const bf16_t* KD = wsp<bf16_t>(F, WS_KD); const bf16_t* V = wsp<bf16_t>(F, WS_V); const bf16_t* R = wsp<bf16_t>(F, WS_R);
    bf16_t* AF = wsp<bf16_t>(F, WS_AF); float* GT = wsp<float>(F, WS_GT); bf16_t* WY = wsp<bf16_t>(F, WS_WY); float* YF = wsp<float>(F, WS_YF);
    LAS char* L = (LAS char*)F.lds;
    for (int task_ = F.bid; task_ < 2 * NH * NCH * reps; task_ += F.G) { const int task = task_ % (2 * NH * NCH); const int c = task % NCH, hd = task / NCH, h = hd % NH, d = hd / NH;
        int tid = F.tid; asm volatile("" : "+v"(tid)); const int lane = tid & 63, wv = F.wave;
        { const int j = tid & 63, sb = tid >> 6; float ev[8], bb[8], kkv[8], kv[8], rv[8], vv[8], lg[8];
          const size_t od = (size_t)d * T * RW;
#pragma unroll
          for (int q = 0; q < 8; ++q) { const int s_ = 8 * sb + q; const int tt = d == 0 ? c * CL + s_ : c * CL + CL - 1 - s_; const size_t o = (size_t)tt * RW + h * HD + j;
              ev[q] = ldbf(E + od + o); bb[q] = ldbf(BV + od + o); kkv[q] = ldbf(KKg + o); kv[q] = ldbf(KD + od + o); rv[q] = ldbf(R + o); vv[q] = ldbf(V + o); }
          float run = 0.f;
#pragma unroll
          for (int q = 0; q < 8; ++q) { run += ev[q]; lg[q] = run; }
          LAS float* tot = (LAS float*)(L + O_TOT); tot[sb * 64 + j] = run;
          __syncthreads();
          float offs = 0.f, total = 0.f;
#pragma unroll
          for (int q = 0; q < 8; ++q) { const float t_ = tot[q * 64 + j]; total += t_; offs += (q < sb) ? t_ : 0.f; }
          float fkk[8], fbh[8], fkh[8];
#pragma unroll
          for (int q = 0; q < 8; ++q) { const int s_ = 8 * sb + q; const float lgq = lg[q] + offs; const float gi = __expf(-lgq), gl = __expf(total - lgq);
              fkk[q] = kkv[q] * __expf(lgq - ev[q]); fbh[q] = bb[q] * gl; fkh[q] = kv[q] * gl;
              *(LAS bf16_t*)(L + O_KK + s_ * RS + j * 2) = (bf16_t)f2bf(fkk[q]); *(LAS bf16_t*)(L + O_BT + s_ * RS + j * 2) = (bf16_t)f2bf(bb[q] * gi);
              *(LAS bf16_t*)(L + O_KT + s_ * RS + j * 2) = (bf16_t)f2bf(kv[q] * gi); *(LAS bf16_t*)(L + O_RT + s_ * RS + j * 2) = (bf16_t)f2bf(rv[q] * __expf(lgq)); }
          *(LAS u32x4*)(L + O_BH + j * RS + sb * 16) = pack8(fbh); *(LAS u32x4*)(L + O_KH + j * RS + sb * 16) = pack8(fkh);
          *(LAS u32x4*)(L + O_V + j * RS + sb * 16) = pack8(vv); *(LAS u32x4*)(L + O_KKT + j * RS + sb * 16) = pack8(fkk);
          if (sb == 0) ((LAS float*)(L + O_GAM))[j] = __expf(total);
        }
        __syncthreads();
        const int M0 = 32 * (wv & 1), N0 = 32 * ((wv >> 1) & 1), hh = lane >> 5, ln = lane & 31;
        f32x16 akr = (f32x16)(0.f);
        if (wv < 4) {
            { f32x16 cc = tile_mm(L + O_BT, M0, L + O_KK, N0, lane);
#pragma unroll
              for (int r = 0; r < 16; ++r) cc[r] = (M0 + crow(r, hh) < N0 + ln) ? cc[r] : 0.f;
              store_t_bf16(L + O_AT, cc, M0, N0, lane); store_n_bf16(L + O_A, cc, M0, N0, lane); }
            { f32x16 cc = tile_mm(L + O_KK, M0, L + O_KT, N0, lane);
#pragma unroll
              for (int r = 0; r < 16; ++r) cc[r] = (N0 + ln < M0 + crow(r, hh)) ? cc[r] : 0.f;
              store_t_bf16(L + O_AKB, cc, M0, N0, lane); }
        } else {
            { f32x16 cc = tile_mm(L + O_BT, M0, L + O_RT, N0, lane);
#pragma unroll
              for (int r = 0; r < 16; ++r) cc[r] = (M0 + crow(r, hh) <= N0 + ln) ? cc[r] : 0.f;
              store_t_bf16(L + O_ABR, cc, M0, N0, lane); }
            { akr = tile_mm(L + O_KT, M0, L + O_RT, N0, lane);
#pragma unroll
              for (int r = 0; r < 16; ++r) akr[r] = (M0 + crow(r, hh) <= N0 + ln) ? akr[r] : 0.f; }
        }
        __syncthreads();
        if (wv == 0) {
            const int b = lane >> 4, r = lane & 15; float x[16];
#pragma unroll
            for (int t = 0; t < 16; ++t) { const LAS char* cp = L + O_AT + (16 * b + t) * RS + 32 * b; float c[16]; { float f[8]; unpack8(*(const LAS u32x4*)cp, f);
#pragma unroll
                    for (int i = 0; i < 8; ++i) c[i] = f[i]; unpack8(*(const LAS u32x4*)(cp + 16), f);
#pragma unroll
                    for (int i = 0; i < 8; ++i) c[8 + i] = f[i]; }
                float a = (t == r) ? 1.f : 0.f;
#pragma unroll
                for (int q = 0; q < t; ++q) a -= x[q] * c[q];
                x[t] = a; }
            LAS char* dp = L + O_D + (16 * b + r) * RS;
#pragma unroll
            for (int q = 0; q < 8; ++q) { const unsigned z0_ = vzero(); u32x4 w = (u32x4){z0_, z0_, z0_, z0_}; if (q == 2 * b) { float f[8];
#pragma unroll
                    for (int i = 0; i < 8; ++i) f[i] = x[i]; w = pack8(f); }
                if (q == 2 * b + 1) { float f[8];
#pragma unroll
                    for (int i = 0; i < 8; ++i) f[i] = x[8 + i]; w = pack8(f); }
                *(LAS u32x4*)(dp + 16 * q) = w; }
        } else if (wv == 1) {
            const int b = lane >> 4, r = lane & 15; float y[16];
#pragma unroll
            for (int t = 15; t >= 0; --t) { const LAS char* cp = L + O_A + (16 * b + t) * RS + 32 * b; float c[16]; { float f[8]; unpack8(*(const LAS u32x4*)cp, f);
#pragma unroll
                    for (int i = 0; i < 8; ++i) c[i] = f[i]; unpack8(*(const LAS u32x4*)(cp + 16), f);
#pragma unroll
                    for (int i = 0; i < 8; ++i) c[8 + i] = f[i]; }
                float a = (t == r) ? 1.f : 0.f;
#pragma unroll
                for (int q = t + 1; q < 16; ++q) a -= y[q] * c[q];
                y[t] = a; }
            LAS char* dp = L + O_DT + (16 * b + r) * RS;
#pragma unroll
            for (int q = 0; q < 8; ++q) { const unsigned z0_ = vzero(); u32x4 w = (u32x4){z0_, z0_, z0_, z0_}; if (q == 2 * b) { float f[8];
#pragma unroll
                    for (int i = 0; i < 8; ++i) f[i] = y[i]; w = pack8(f); }
                if (q == 2 * b + 1) { float f[8];
#pragma unroll
                    for (int i = 0; i < 8; ++i) f[i] = y[8 + i]; w = pack8(f); }
                *(LAS u32x4*)(dp + 16 * q) = w; }
        }
        __syncthreads();
        if (wv < 4) { f32x16 cc = (f32x16)(0.f);
            if (M0 == N0) { cc = tile_mm(L + O_A, M0, L + O_DT, N0, lane);
#pragma unroll
                for (int r = 0; r < 16; ++r) cc[r] = (((M0 + crow(r, hh)) ^ (N0 + ln)) & 16) ? cc[r] : 0.f; }
            store_t_bf16(L + O_UT, cc, M0, N0, lane); }
        __syncthreads();
        if (wv < 4) { f32x16 cc = tile_mm(L + O_D, M0, L + O_UT, N0, lane); const f32x16 dd = load_acc_from_t(L + O_DT, M0, N0, lane);
#pragma unroll
            for (int r = 0; r < 16; ++r) cc[r] = dd[r] - cc[r];
            store_n_bf16(L + O_M32, cc, M0, N0, lane); store_t_bf16(L + O_M32T, cc, M0, N0, lane); }
        __syncthreads();
        if (wv < 4) { f32x16 cc = (f32x16)(0.f);
            if (M0 == 0 && N0 == 32) cc = tile_mm(L + O_A, M0, L + O_M32T, N0, lane);
            store_t_bf16(L + O_UT, cc, M0, N0, lane); }
        __syncthreads();
        if (wv < 4) { f32x16 cc = tile_mm(L + O_M32, M0, L + O_UT, N0, lane); const f32x16 mm_ = load_acc_from_t(L + O_M32T, M0, N0, lane);
#pragma unroll
            for (int r = 0; r < 16; ++r) cc[r] = mm_[r] - cc[r];
            store_t_bf16(L + O_M64T, cc, M0, N0, lane); }
        __syncthreads();
        { const f32x16 cc = tile_mm(L + (wv < 4 ? O_KKT : O_AKB), M0, L + O_M64T, N0, lane);
          store_n_bf16(L + (wv < 4 ? O_P : O_Q), cc, M0, N0, lane); }
        __syncthreads();
        if (wv < 4) {
            { const f32x16 cc = tile_mm(L + O_P, M0, L + O_ABR, N0, lane);
              const LAS char* rp = L + O_RT + (N0 + ln) * RS + (M0 + 4 * hh) * 2; bf16_t* wp = WY + (size_t)task * 4096 + (N0 + ln) * 64 + M0 + 4 * hh;
#pragma unroll
              for (int g = 0; g < 4; ++g) { const f32x4 rt = up4(*(const LAS u32x2*)(rp + 16 * g)); u32x2 w; w.x = pk2(rt[0] - cc[4 * g], rt[1] - cc[4 * g + 1]); w.y = pk2(rt[2] - cc[4 * g + 2], rt[3] - cc[4 * g + 3]);
                  *(u32x2*)(wp + 8 * g) = w; } }
            { f32x16 cc = tile_mm(L + O_P, M0, L + O_BH, N0, lane);
              const float gm = ((const LAS float*)(L + O_GAM))[N0 + ln];
#pragma unroll
              for (int r = 0; r < 16; ++r) cc[r] = ((M0 + crow(r, hh) == N0 + ln) ? gm : 0.f) - cc[r];
              const int J = M0 >> 5, Jp = N0 >> 5;
#pragma unroll
              for (int s2 = 0; s2 < 2; ++s2) { u32x4 w; w.x = pk2(cc[8 * s2], cc[8 * s2 + 1]); w.y = pk2(cc[8 * s2 + 2], cc[8 * s2 + 3]); w.z = pk2(cc[8 * s2 + 4], cc[8 * s2 + 5]); w.w = pk2(cc[8 * s2 + 6], cc[8 * s2 + 7]);
                  *(u32x4*)(AF + (size_t)task * 4096 + (size_t)((((Jp * 2 + J) * 2 + s2) * 64 + lane) * 8)) = w; } }
        } else {
            { f32x16 cc = tile_mm(L + O_Q, M0, L + O_ABR, N0, lane);
#pragma unroll
              for (int r = 0; r < 16; ++r) cc[r] = akr[r] - cc[r];
              store_t_bf16(L + O_ZY, cc, M0, N0, lane); }
            { f32x16 cc = tile_mm(L + O_Q, M0, L + O_BH, N0, lane);
              const LAS char* kp = L + O_KH + (N0 + ln) * RS + (M0 + 4 * hh) * 2;
#pragma unroll
              for (int g = 0; g < 4; ++g) { const f32x4 kh = up4(*(const LAS u32x2*)(kp + 16 * g)); cc[4 * g] = kh[0] - cc[4 * g]; cc[4 * g + 1] = kh[1] - cc[4 * g + 1]; cc[4 * g + 2] = kh[2] - cc[4 * g + 2]; cc[4 * g + 3] = kh[3] - cc[4 * g + 3]; }
              store_t_bf16(L + O_X1, cc, M0, N0, lane); }
        }
        __syncthreads();
        if (wv < 4) { const f32x16 cc = tile_mm(L + O_X1, M0, L + O_V, N0, lane);
            float* gp = GT + (size_t)task * 4096 + (size_t)(((N0 >> 5) * 2 + (M0 >> 5)) * 16) * 64 + lane;
#pragma unroll
            for (int r = 0; r < 16; ++r) gp[r * 64] = cc[r];
        } else { const f32x16 cc = tile_mm(L + O_V, M0, L + O_ZY, N0, lane);
            const int s_ = N0 + ln; const int tt = d == 0 ? c * CL + s_ : c * CL + CL - 1 - s_; float* yp = YF + (size_t)d * T * RW + (size_t)tt * RW + h * HD + M0 + 4 * hh;
#pragma unroll
            for (int g = 0; g < 4; ++g) *(f32x4*)(yp + 8 * g) = (f32x4){cc[4 * g], cc[4 * g + 1], cc[4 * g + 2], cc[4 * g + 3]}; }
        __syncthreads();
    }
}

__device__ __forceinline__ void phase_rwkv_carry(const Frame& F, bool dry) {
    if (F.bid >= 48) return;
    const int hd = F.bid >> 1, I = F.bid & 1, d = hd / NH, lane = F.lane, wv = F.wave;
    const bf16_t* AF = wsp<bf16_t>(F, WS_AF); float* GT = wsp<float>(F, WS_GT);
    LAS char* ring = (LAS char*)F.lds;
    const bool ld = wv >= 1 && wv <= 4;
#define RC_DMA(k_, sl_) do { const int c_ = d == 0 ? (k_) : NCH - 1 - (k_); const size_t tix_ = (size_t)hd * NCH + c_; \
        _Pragma("unroll") for (int i_ = 0; i_ < 4; ++i_) { const int p_ = (wv - 1) * 4 + i_; \
            const char* g_ = p_ < 8 ? (const char*)AF + tix_ * 8192 + p_ * 1024 : (const char*)GT + tix_ * 16384 + I * 8192 + (p_ - 8) * 1024; \
            __builtin_amdgcn_global_load_lds((const unsigned*)(g_ + lane * 16), (LAS unsigned*)(ring + (sl_) * 16384 + p_ * 1024), 16, 0, 0); } } while (0)
#define RC_BAR() do { asm volatile("" ::: "memory"); __builtin_amdgcn_sched_barrier(0); __builtin_amdgcn_s_barrier(); __builtin_amdgcn_sched_barrier(0); asm volatile("" ::: "memory"); } while (0)
    constexpr int RC_NS = 6;
    if (ld) { RC_DMA(0, 0); RC_DMA(1, 1); RC_DMA(2, 2); RC_DMA(3, 3); RC_DMA(4, 4); asm volatile("s_waitcnt vmcnt(16)" ::: "memory"); }
    RC_BAR();
    bf16x8 bfr[2][2];
#pragma unroll
    for (int J = 0; J < 2; ++J)
#pragma unroll
        for (int s = 0; s < 2; ++s) bfr[J][s] = (bf16x8)(0);
    int cur = 0;
#pragma unroll 1
    for (int k = 0; k < NCH; ++k) {
        const int nx2 = cur == 0 ? RC_NS - 1 : cur - 1;
        if (ld) { if (k + RC_NS - 1 < NCH) { RC_DMA(k + RC_NS - 1, nx2); asm volatile("s_waitcnt vmcnt(16)" ::: "memory"); } else asm volatile("s_waitcnt vmcnt(0)" ::: "memory"); }
        if (wv == 0) {
            const int c = d == 0 ? k : NCH - 1 - k; const size_t tix = (size_t)hd * NCH + c;
            const LAS char* sl = ring + cur * 16384;
            u32x4 a[8]; f32x16 nw[2];
#pragma unroll
            for (int f_ = 0; f_ < 8; ++f_) a[f_] = *(const LAS u32x4*)(sl + (f_ * 64 + lane) * 16);
#pragma unroll
            for (int Jp = 0; Jp < 2; ++Jp)
#pragma unroll
                for (int r = 0; r < 16; ++r) nw[Jp][r] = *(const LAS float*)(sl + 8192 + ((Jp * 16 + r) * 64 + lane) * 4);
#pragma unroll
            for (int Jp = 0; Jp < 2; ++Jp)
#pragma unroll
                for (int J = 0; J < 2; ++J)
#pragma unroll
                    for (int s = 0; s < 2; ++s) nw[Jp] = __builtin_amdgcn_mfma_f32_32x32x16_bf16(__builtin_bit_cast(bf16x8, a[(Jp * 2 + J) * 2 + s]), bfr[J][s], nw[Jp], 0, 0, 0);
            u32x4* sp = (u32x4*)((char*)(dry ? wsp<float>(F, WS_XN) + (tix & 2047) * 4096 : GT + tix * 4096) + I * 8192);
#pragma unroll
            for (int J = 0; J < 2; ++J)
#pragma unroll
                for (int s = 0; s < 2; ++s) { u32x4 w; w.x = pk2(nw[J][8 * s + 0], nw[J][8 * s + 1]); w.y = pk2(nw[J][8 * s + 2], nw[J][8 * s + 3]); w.z = pk2(nw[J][8 * s + 4], nw[J][8 * s + 5]); w.w = pk2(nw[J][8 * s + 6], nw[J][8 * s + 7]);
                    bfr[J][s] = __builtin_bit_cast(bf16x8, w); sp[(2 * J + s) * 64 + lane] = w; }
        }
        RC_BAR();
        cur = cur == RC_NS - 1 ? 0 : cur + 1;
    }
#undef RC_DMA
#undef RC_BAR
}

__device__ __forceinline__ float half_swap_sum(float v) { auto r = __builtin_amdgcn_permlane32_swap(__float_as_uint(v), __float_as_uint(v), false, false); return __uint_as_float(r[0]) + __uint_as_float(r[1]); }
__device__ __forceinline__ void phase_rwkv_outfin(const Frame& F, int l, int reps) {
    const float* GT = wsp<float>(F, WS_GT); const bf16_t* WY = wsp<bf16_t>(F, WS_WY); const float* YF = wsp<float>(F, WS_YF);
    const bf16_t* R = wsp<bf16_t>(F, WS_R); const bf16_t* KD = wsp<bf16_t>(F, WS_KD); const bf16_t* V = wsp<bf16_t>(F, WS_V); const bf16_t* G = wsp<bf16_t>(F, WS_G); bf16_t* YA = wsp<bf16_t>(F, WS_YA);
    const float* rk = gin(F, I_RK) + l * RW; const float* lw = gin(F, I_LNW) + l * RW; const float* lb = gin(F, I_LNB) + l * RW;
    for (int task_ = F.gw; task_ < NH * NCH * reps; task_ += F.nw) { const int task = task_ % (NH * NCH); const int c = task % NCH, h = task / NCH;
        int lane = F.lane; asm volatile("" : "+v"(lane)); const int ln = lane & 31, hh = lane >> 5;
        f32x16 acc[2][2];
#pragma unroll
        for (int mb = 0; mb < 2; ++mb)
#pragma unroll
            for (int nb = 0; nb < 2; ++nb) acc[mb][nb] = (f32x16)(0.f);
#pragma unroll
        for (int d = 0; d < 2; ++d) { const int hd = d * NH + h; const int cs = d == 0 ? c - 1 : c + 1;
            if (cs >= 0 && cs < NCH) { const float* S0 = GT + ((size_t)hd * NCH + cs) * 4096; const bf16_t* wy = WY + ((size_t)hd * NCH + c) * 4096;
                bf16x8 af[2][4], bfr[2][4];
#pragma unroll
                for (int mb = 0; mb < 2; ++mb)
#pragma unroll
                    for (int ks = 0; ks < 4; ++ks) { af[mb][ks] = *(const bf16x8*)((const char*)S0 + mb * 8192 + (ks * 64 + lane) * 16);
                        const int p = mb * 32 + ln; const int srow = d == 0 ? p : CL - 1 - p; const bf16_t* wr = wy + srow * 64 + ks * 16 + 4 * hh;
                        const u32x2 w0 = *(const u32x2*)wr, w1 = *(const u32x2*)(wr + 8); bfr[mb][ks] = __builtin_bit_cast(bf16x8, (u32x4){w0.x, w0.y, w1.x, w1.y}); }
#pragma unroll
                for (int mb = 0; mb < 2; ++mb)
#pragma unroll
                    for (int nb = 0; nb < 2; ++nb)
#pragma unroll
                        for (int ks = 0; ks < 4; ++ks) acc[mb][nb] = __builtin_amdgcn_mfma_f32_32x32x16_bf16(af[mb][ks], bfr[nb][ks], acc[mb][nb], 0, 0, 0); } }
        LAS char* slab = (LAS char*)(F.lds + F.wave * 9216);
        const int fr_ = lane >> 4, fc_ = lane & 15, br_ = lane >> 3, bc_ = lane & 7;
#define OF_LDF(dst, base, t0) do { _Pragma("unroll") for (int k_ = 0; k_ < 8; ++k_) dst[k_] = *(const u32x4*)((base) + (size_t)((t0) + k_ * 4 + fr_) * RW + h * HD + fc_ * 4); } while (0)
#define OF_STF(src) do { _Pragma("unroll") for (int k_ = 0; k_ < 8; ++k_) *(LAS u32x4*)(slab + (k_ * 4 + fr_) * 272 + fc_ * 16) = src[k_]; } while (0)
#define OF_LDB(dst, base, t0) do { _Pragma("unroll") for (int k_ = 0; k_ < 4; ++k_) dst[k_] = *(const u32x4*)((base) + (size_t)((t0) + k_ * 8 + br_) * RW + h * HD + bc_ * 8); } while (0)
#define OF_STB(src, off) do { _Pragma("unroll") for (int k_ = 0; k_ < 4; ++k_) *(LAS u32x4*)(slab + (off) + (k_ * 8 + br_) * 144 + bc_ * 16) = src[k_]; } while (0)
#define OF_RDF(mb_, g_) (*(const LAS f32x4*)(slab + ln * 272 + ((mb_) * 32 + 8 * (g_) + 4 * hh) * 4))
#define OF_RDB(off, mb_, g_) up4(*(const LAS u32x2*)(slab + (off) + ln * 144 + ((mb_) * 32 + 8 * (g_) + 4 * hh) * 2))
#pragma unroll
        for (int nb = 0; nb < 2; ++nb) { const int t0 = c * CL + nb * 32;
            u32x4 fa[8], fb[8], ba[4], bb[4];
            OF_LDF(fa, YF, t0); OF_LDF(fb, YF + (size_t)T * RW, t0);
            float s1 = 0.f, sb = 0.f;
            OF_STF(fa); OF_LDB(ba, KD, t0); OF_LDB(bb, KD + (size_t)T * RW, t0);
#pragma unroll
            for (int mb = 0; mb < 2; ++mb)
#pragma unroll
                for (int g = 0; g < 4; ++g) { const f32x4 y0 = OF_RDF(mb, g);
#pragma unroll
                    for (int e = 0; e < 4; ++e) acc[mb][nb][4 * g + e] += y0[e]; }
            OF_STF(fb);
#pragma unroll
            for (int mb = 0; mb < 2; ++mb)
#pragma unroll
                for (int g = 0; g < 4; ++g) { const f32x4 y1 = OF_RDF(mb, g);
#pragma unroll
                    for (int e = 0; e < 4; ++e) { const float y = acc[mb][nb][4 * g + e] + y1[e]; acc[mb][nb][4 * g + e] = y; s1 += y; } }
            OF_STB(ba, 0); OF_STB(bb, 4608); OF_LDB(ba, R, t0); OF_LDB(bb, V, t0);
            f32x4 ks[2][4];
#pragma unroll
            for (int mb = 0; mb < 2; ++mb)
#pragma unroll
                for (int g = 0; g < 4; ++g) { const f32x4 k0 = OF_RDB(0, mb, g), k1 = OF_RDB(4608, mb, g); ks[mb][g] = k0 + k1; }
            OF_STB(ba, 0); OF_STB(bb, 4608); OF_LDB(ba, G, t0);
            u32x2 vraw[2][4];
#pragma unroll
            for (int mb = 0; mb < 2; ++mb)
#pragma unroll
                for (int g = 0; g < 4; ++g) { const int j = h * HD + 4 * hh + mb * 32 + 8 * g; const f32x4 rr = OF_RDB(0, mb, g), rkk = *(const f32x4*)(rk + j); vraw[mb][g] = *(const LAS u32x2*)(slab + 4608 + ln * 144 + (mb * 32 + 8 * g + 4 * hh) * 2);
#pragma unroll
                    for (int e = 0; e < 4; ++e) sb += rr[e] * ks[mb][g][e] * rkk[e]; }
            const float mu = half_swap_sum(s1) * (1.0f / 64.0f), bon = half_swap_sum(sb);
            float s2 = 0.f;
#pragma unroll
            for (int mb = 0; mb < 2; ++mb)
#pragma unroll
                for (int r = 0; r < 16; ++r) { const float dl = acc[mb][nb][r] - mu; s2 += dl * dl; }
            const float rstd = rsqrtf(half_swap_sum(s2) * (1.0f / 64.0f) + 64e-5f);
            OF_STB(ba, 0);
            f32x4 ovv[2][4];
#pragma unroll
            for (int mb = 0; mb < 2; ++mb)
#pragma unroll
                for (int g = 0; g < 4; ++g) { const int j = h * HD + 4 * hh + mb * 32 + 8 * g; const f32x4 vv = up4(vraw[mb][g]), gg = OF_RDB(0, mb, g), w4 = *(const f32x4*)(lw + j), b4 = *(const f32x4*)(lb + j);
#pragma unroll
                    for (int e = 0; e < 4; ++e) ovv[mb][g][e] = ((acc[mb][nb][4 * g + e] - mu) * rstd * w4[e] + b4[e] + bon * vv[e]) * gg[e]; }
#pragma unroll
            for (int mb = 0; mb < 2; ++mb)
#pragma unroll
                for (int g = 0; g < 4; ++g) *(LAS u32x2*)(slab + 4608 + ln * 144 + (mb * 32 + 8 * g + 4 * hh) * 2) = pk4(ovv[mb][g]);
#pragma unroll
            for (int k_ = 0; k_ < 4; ++k_) *(u32x4*)(YA + (size_t)(t0 + k_ * 8 + br_) * RW + h * HD + bc_ * 8) = *(const LAS u32x4*)(slab + 4608 + (k_ * 8 + br_) * 144 + bc_ * 16);
        }
#undef OF_LDF
#undef OF_STF
#undef OF_LDB
#undef OF_STB
#undef OF_RDF
#undef OF_RDB
    }
}

namespace att {
constexpr int KN_B = 16384, KR_B = 8192, V_B = 16384, BUF_B = KN_B + KR_B + V_B;
constexpr int SCR_OFF = 2 * BUF_B;
constexpr float THR2 = 10.0f;
__device__ __forceinline__ int crow(int r, int hi) { return (r & 3) + 8 * (r >> 2) + 4 * hi; }
__device__ __forceinline__ int kn_off(int row, int colB) { return row * 256 + (colB ^ ((row & 15) << 4)); }
__device__ __forceinline__ int kr_off(int row, int chunk) { return row * 128 + ((chunk ^ ((row >> 1) & 7)) << 4); }
__device__ __forceinline__ int v_st(int k, int c) { const int kk = (k & ~0xC) | ((k & 4) << 1) | ((k & 8) >> 1); return ((kk >> 3) * 4 + (c >> 5)) * 512 + ((kk & 7) * 32 + (c & 31)) * 2; }
__device__ __forceinline__ int v_rd_base(int lane) { return ((lane & 3) << 3) | (((lane >> 2) & 3) << 6) | (((lane >> 4) & 1) << 5) | (((lane >> 5) & 1) << 8); }
constexpr int v_rd_off(int d0, int ks, int half) { return d0 * 512 + ks * 4096 + half * 2048; }
template <int OFF> __device__ __forceinline__ s16x4 tr_read(int vb) { s16x4 r; asm volatile("ds_read_b64_tr_b16 %0, %1 offset:%2" : "=&v"(r) : "v"(vb), "i"(OFF) : "memory"); return r; }
template <int OFF> __device__ __forceinline__ bf16x8 lds128(int a) { bf16x8 r; asm volatile("ds_read_b128 %0, %1 offset:%2" : "=v"(r) : "v"(a), "i"(OFF) : "memory"); return r; }
#define AT_WAIT(n) do { asm volatile("s_waitcnt lgkmcnt(" #n ")" ::: "memory"); __builtin_amdgcn_sched_barrier(0); } while (0)
struct VSet { s16x4 l0, h0, l1, h1, l2, h2, l3, h3; };
template <int D0> __device__ __forceinline__ void pv_read(VSet& v, int vb) {
    v.l0 = tr_read<v_rd_off(D0, 0, 0)>(vb); v.h0 = tr_read<v_rd_off(D0, 0, 1)>(vb); v.l1 = tr_read<v_rd_off(D0, 1, 0)>(vb); v.h1 = tr_read<v_rd_off(D0, 1, 1)>(vb);
    v.l2 = tr_read<v_rd_off(D0, 2, 0)>(vb); v.h2 = tr_read<v_rd_off(D0, 2, 1)>(vb); v.l3 = tr_read<v_rd_off(D0, 3, 0)>(vb); v.h3 = tr_read<v_rd_off(D0, 3, 1)>(vb); }
__device__ __forceinline__ void pv_mma(f32x16& od, const VSet& v, bf16x8 pa0, bf16x8 pa1, bf16x8 pa2, bf16x8 pa3) {
#define ATT_PK(L, H) (bf16x8){L[0], L[1], L[2], L[3], H[0], H[1], H[2], H[3]}
    od = __builtin_amdgcn_mfma_f32_32x32x16_bf16(pa0, ATT_PK(v.l0, v.h0), od, 0, 0, 0);
    od = __builtin_amdgcn_mfma_f32_32x32x16_bf16(pa1, ATT_PK(v.l1, v.h1), od, 0, 0, 0);
    od = __builtin_amdgcn_mfma_f32_32x32x16_bf16(pa2, ATT_PK(v.l2, v.h2), od, 0, 0, 0);
    od = __builtin_amdgcn_mfma_f32_32x32x16_bf16(pa3, ATT_PK(v.l3, v.h3), od, 0, 0, 0);
#undef ATT_PK
}
template <int D0> __device__ __forceinline__ void pv_one(f32x16& od, int vb, bf16x8 pa0, bf16x8 pa1, bf16x8 pa2, bf16x8 pa3) {
    const s16x4 l0 = tr_read<v_rd_off(D0, 0, 0)>(vb), h0 = tr_read<v_rd_off(D0, 0, 1)>(vb), l1 = tr_read<v_rd_off(D0, 1, 0)>(vb), h1 = tr_read<v_rd_off(D0, 1, 1)>(vb);
    const s16x4 l2 = tr_read<v_rd_off(D0, 2, 0)>(vb), h2 = tr_read<v_rd_off(D0, 2, 1)>(vb), l3 = tr_read<v_rd_off(D0, 3, 0)>(vb), h3 = tr_read<v_rd_off(D0, 3, 1)>(vb);
    asm volatile("s_waitcnt lgkmcnt(0)" ::: "memory"); __builtin_amdgcn_sched_barrier(0);
#define ATT_PK(L, H) (bf16x8){L[0], L[1], L[2], L[3], H[0], H[1], H[2], H[3]}
    od = __builtin_amdgcn_mfma_f32_32x32x16_bf16(pa0, ATT_PK(l0, h0), od, 0, 0, 0);
    od = __builtin_amdgcn_mfma_f32_32x32x16_bf16(pa1, ATT_PK(l1, h1), od, 0, 0, 0);
    od = __builtin_amdgcn_mfma_f32_32x32x16_bf16(pa2, ATT_PK(l2, h2), od, 0, 0, 0);
    od = __builtin_amdgcn_mfma_f32_32x32x16_bf16(pa3, ATT_PK(l3, h3), od, 0, 0, 0);
#undef ATT_PK
}
__device__ __forceinline__ void unit(const Frame& F, int q0, int h) {
    const bf16_t* Q = wsp<bf16_t>(F, WS_Q); const bf16_t* KV = wsp<bf16_t>(F, WS_KV); bf16_t* O = wsp<bf16_t>(F, WS_O);
    LAS char* lds = (LAS char*)F.lds;
    const int tid = F.tid, wid = F.wave, lane = F.lane, r32 = lane & 31, hi = lane >> 5;
    LAS float* scr = (LAS float*)(lds + SCR_OFF) + wid * 64; LAS float* li_l = scr; LAS float* al_l = scr + 32;
    float m_reg = -1e30f, l_reg = 0.f; f32x16 o[4]; o[0] = (f32x16)(0.f); o[1] = o[0]; o[2] = o[0]; o[3] = o[0];
    bf16x8 qr[12];
    { const bf16_t* qw = Q + (size_t)(q0 + wid * 32 + r32) * QW + h * 192 + hi * 8;
#pragma unroll
      for (int d0 = 0; d0 < 12; ++d0) qr[d0] = *(const bf16x8*)(qw + d0 * 16); }
    const int sr = tid >> 4, sc = (tid & 15) * 8, rr = tid >> 3, rc = tid & 7;
    const int kn0 = kn_off(sr, sc * 2), kn1 = kn_off(32 + sr, sc * 2), vs0 = v_st(sr, sc), vs1 = v_st(32 + sr, sc), kro = kr_off(rr, rc);
    const int vb0 = (int)(uintptr_t)(LAS char*)(F.lds + KN_B + KR_B) + v_rd_base(lane);
    const int lds0 = (int)(uintptr_t)(LAS char*)F.lds;
    u32x4 g0, g1, g2;
    const unsigned so0 = (unsigned)(sr * KVW + sc) * 2u, so2 = (unsigned)(rr * KVW + 128 + rc * 8) * 2u;
#define AT_SLOAD(k0) do { const char* kvb = (const char*)KV + (size_t)(k0) * KVW * 2; g0 = *(const u32x4*)(kvb + so0); g1 = *(const u32x4*)(kvb + so0 + 32u * KVW * 2u); g2 = *(const u32x4*)(kvb + so2); } while (0)
#define AT_SWRITE(b) do { LAS char* bb = lds + (b) * BUF_B; *(LAS u32x4*)(bb + kn0) = g0; *(LAS u32x4*)(bb + kn1) = g1; *(LAS u32x4*)(bb + KN_B + kro) = g2; *(LAS u32x4*)(bb + KN_B + KR_B + vs0) = g0; *(LAS u32x4*)(bb + KN_B + KR_B + vs1) = g1; } while (0)
    constexpr int NT = T / 64;
    AT_SLOAD(0); AT_SWRITE(0); __syncthreads();
    for (int j = 0; j < NT; ++j) {
        const int b = j & 1; const LAS char* kb = lds + b * BUF_B;
        if (j + 1 < NT) AT_SLOAD((j + 1) * 64);
        f32x16 p0 = (f32x16)(0.f), p1 = (f32x16)(0.f);
        __builtin_amdgcn_sched_barrier(0);
#pragma unroll
        for (int d0 = 0; d0 < 8; ++d0) { const int cb = (d0 * 16 + hi * 8) * 2;
            const bf16x8 k0 = *(const LAS bf16x8*)(kb + kn_off(r32, cb)), k1 = *(const LAS bf16x8*)(kb + kn_off(32 + r32, cb));
            p0 = __builtin_amdgcn_mfma_f32_32x32x16_bf16(k0, qr[d0], p0, 0, 0, 0); p1 = __builtin_amdgcn_mfma_f32_32x32x16_bf16(k1, qr[d0], p1, 0, 0, 0); }
#pragma unroll
        for (int d0 = 0; d0 < 4; ++d0) { const int ch = d0 * 2 + hi;
            const bf16x8 k0 = *(const LAS bf16x8*)(kb + KN_B + kr_off(r32, ch)), k1 = *(const LAS bf16x8*)(kb + KN_B + kr_off(32 + r32, ch));
            p0 = __builtin_amdgcn_mfma_f32_32x32x16_bf16(k0, qr[8 + d0], p0, 0, 0, 0); p1 = __builtin_amdgcn_mfma_f32_32x32x16_bf16(k1, qr[8 + d0], p1, 0, 0, 0); }
        __builtin_amdgcn_sched_group_barrier(0x100, 6, 0);
#pragma unroll
        for (int i_ = 0; i_ < 9; ++i_) { __builtin_amdgcn_sched_group_barrier(0x008, 2, 0); __builtin_amdgcn_sched_group_barrier(0x100, 2, 0); }
        __builtin_amdgcn_sched_group_barrier(0x008, 6, 0);
        __builtin_amdgcn_sched_barrier(0);
        const int vb = vb0 + b * BUF_B; VSet va, vbs; pv_read<0>(va, vb);
        float pmax = p0[0];
#pragma unroll
        for (int r = 1; r < 16; ++r) pmax = fmaxf(pmax, p0[r]);
#pragma unroll
        for (int r = 0; r < 16; ++r) pmax = fmaxf(pmax, p1[r]);
        { auto rrr = __builtin_amdgcn_permlane32_swap(__float_as_uint(pmax), __float_as_uint(pmax), false, false); pmax = fmaxf(__uint_as_float(rrr[0]), __uint_as_float(rrr[1])); }
        float alpha = 1.f;
        if (!__all(pmax - m_reg <= THR2)) { const float mn = fmaxf(m_reg, pmax); alpha = __builtin_amdgcn_exp2f(m_reg - mn); m_reg = mn;
            if (hi == 0) al_l[r32] = alpha; asm volatile("s_waitcnt lgkmcnt(0)" ::: "memory");
#pragma unroll
            for (int dd = 0; dd < 4; ++dd)
#pragma unroll
                for (int r = 0; r < 16; ++r) o[dd][r] *= al_l[crow(r, hi)]; }
        float ps = 0.f;
#pragma unroll
        for (int r = 0; r < 16; ++r) { p0[r] = __builtin_amdgcn_exp2f(p0[r] - m_reg); p1[r] = __builtin_amdgcn_exp2f(p1[r] - m_reg); ps += p0[r] + p1[r]; }
        { auto rrr = __builtin_amdgcn_permlane32_swap(__float_as_uint(ps), __float_as_uint(ps), false, false); ps = __uint_as_float(rrr[0]) + __uint_as_float(rrr[1]); }
        l_reg = l_reg * alpha + ps;
        bf16x8 pa0, pa1, pa2, pa3;
#define AT_PK4(P, BASE, OUT) do { unsigned a0 = cvtpk(P[BASE + 0], P[BASE + 1]), a1 = cvtpk(P[BASE + 2], P[BASE + 3]); \
        unsigned b0 = cvtpk(P[BASE + 4], P[BASE + 5]), b1 = cvtpk(P[BASE + 6], P[BASE + 7]); \
        auto r0 = __builtin_amdgcn_permlane32_swap(a0, b0, false, false); auto r1 = __builtin_amdgcn_permlane32_swap(a1, b1, false, false); \
        u32x4 w = {r0[0], r1[0], r0[1], r1[1]}; OUT = __builtin_bit_cast(bf16x8, w); } while (0)
        AT_PK4(p0, 0, pa0); AT_PK4(p0, 8, pa1); AT_PK4(p1, 0, pa2); AT_PK4(p1, 8, pa3);
#undef AT_PK4
        pv_read<1>(vbs, vb); AT_WAIT(8); pv_mma(o[0], va, pa0, pa1, pa2, pa3);
        pv_read<2>(va, vb); AT_WAIT(8); pv_mma(o[1], vbs, pa0, pa1, pa2, pa3);
        pv_read<3>(vbs, vb); AT_WAIT(8); pv_mma(o[2], va, pa0, pa1, pa2, pa3);
        AT_WAIT(0); pv_mma(o[3], vbs, pa0, pa1, pa2, pa3);
        if (j + 1 < NT) AT_SWRITE(b ^ 1);
        __syncthreads();
    }
#undef AT_SLOAD
#undef AT_SWRITE
    if (hi == 0) li_l[r32] = l_reg; asm volatile("s_waitcnt lgkmcnt(0)" ::: "memory");
    { int l2 = lane; asm volatile("" : "+v"(l2)); const int hi2 = l2 >> 5; const unsigned ob = (unsigned)((q0 + wid * 32 + 4 * hi2) * OW + h * 128 + (l2 & 31)) * 2u;
#pragma unroll
      for (int r = 0; r < 16; ++r) { const float rl = __builtin_amdgcn_rcpf(li_l[crow(r, hi2)]);
#pragma unroll
          for (int d0 = 0; d0 < 4; ++d0) *(bf16_t*)((char*)O + ob + (unsigned)(((r & 3) + 8 * (r >> 2)) * OW + d0 * 32) * 2u) = (bf16_t)f2bf(o[d0][r] * rl); } }
    __syncthreads();
}
}
__device__ __forceinline__ void phase_attention(const Frame& F, int reps) {
    for (int uu = F.bid; uu < (T / 256) * 4 * reps; uu += F.G) { const int u = uu % ((T / 256) * 4); att::unit(F, (u >> 2) * 256, u & 3); }
}

__device__ __forceinline__ void phase_norm2_router(const Frame& F, int l, int reps) {
    const float* X = gout(F); bf16_t* XN = wsp<bf16_t>(F, WS_XN); float* AFF = wsp<float>(F, WS_AFF);
    const float* gain = gin(F, I_NFFN) + (size_t)l * DM; const float* wr = gin(F, I_WR) + (size_t)l * DM * NE;
    for (int it = F.tid; it < 8192; it += NTHR) { const int ln = it & 63, q = (it >> 6) & 3, c = (it >> 8) & 3, i = it >> 10; *(LAS f32x4*)(F.lds + (size_t)it * 16) = *(const f32x4*)(wr + (size_t)(i * 256 + ln * 4 + c) * NE + 4 * q); }
    __syncthreads();
    for (int row_ = F.gw; row_ < T * reps; row_ += F.nw) { const int row = row_ % T;
        f32x4 v[8]; float ss = 0.f;
#pragma unroll
        for (int i = 0; i < 8; ++i) { v[i] = *(const f32x4*)(X + (size_t)row * DM + i * 256 + F.lane * 4); ss += v[i][0] * v[i][0] + v[i][1] * v[i][1] + v[i][2] * v[i][2] + v[i][3] * v[i][3]; }
        ss = wave_sum(ss); const float rstd = rsqrtf(ss * (1.0f / DM) + 1e-6f);
        float lg[NE];
#pragma unroll
        for (int e = 0; e < NE; ++e) lg[e] = 0.f;
#pragma unroll
        for (int i = 0; i < 8; ++i) { const f32x4 g = *(const f32x4*)(gain + i * 256 + F.lane * 4); f32x4 xn; xn[0] = v[i][0] * rstd * g[0]; xn[1] = v[i][1] * rstd * g[1]; xn[2] = v[i][2] * rstd * g[2]; xn[3] = v[i][3] * rstd * g[3];
            *(u32x2*)(XN + (size_t)row * DM + i * 256 + F.lane * 4) = pk4(xn);
            int lo_ = F.lane * 16; asm volatile("" : "+v"(lo_), "+v"(lg[0]));
#pragma unroll
            for (int c = 0; c < 4; ++c) {
#pragma unroll
                for (int q = 0; q < 4; ++q) { const f32x4 w = *(const LAS f32x4*)(F.lds + (((i * 4 + c) * 4 + q) * 1024 + lo_)); lg[4 * q] += xn[c] * w[0]; lg[4 * q + 1] += xn[c] * w[1]; lg[4 * q + 2] += xn[c] * w[2]; lg[4 * q + 3] += xn[c] * w[3]; } } }
        float mx = -1e30f;
#pragma unroll
        for (int e = 0; e < NE; ++e) { lg[e] = wave_sum(lg[e]); mx = fmaxf(mx, lg[e]); }
        float den = 0.f;
#pragma unroll
        for (int e = 0; e < NE; ++e) { lg[e] = __expf(lg[e] - mx); den += lg[e]; }
        float mine = 0.f;
#pragma unroll
        for (int e = 0; e < NE; ++e) mine = (F.lane == e) ? lg[e] : mine;
        if (F.lane < NE) AFF[(size_t)F.lane * T + row] = mine / den;
    }
}

__device__ __forceinline__ int block_excl_scan(const Frame& F, int v, LAS int* tmp) {
    int inc = v;
#pragma unroll
    for (int o = 1; o < 64; o <<= 1) { const int n = shi(inc, F.lane - o); if (F.lane >= o) inc += n; }
    __syncthreads();
    if (F.lane == 63) tmp[F.wave] = inc;
    __syncthreads();
    int off = 0;
#pragma unroll
    for (int w = 0; w < NWAVE; ++w) off += (w < F.wave) ? tmp[w] : 0;
    return off + inc - v;
}
__device__ __forceinline__ void phase_topk(const Frame& F) {
    if (F.bid >= NE) return;
    const int e = F.bid; const float* AFF = wsp<float>(F, WS_AFF) + (size_t)e * T; int* SLOT = wsp<int>(F, WS_SLOT) + (size_t)e * T; int* IDX = wsp<int>(F, WS_IDX) + e * CAP; float* GATEV = wsp<float>(F, WS_GATEV) + e * CAP;
    LAS unsigned* hist = (LAS unsigned*)F.lds; LAS int* sel = (LAS int*)(F.lds + 1024); LAS int* tmp = (LAS int*)(F.lds + 1088);
    unsigned u[32];
#pragma unroll
    for (int q = 0; q < 8; ++q) { const f32x4 a = *(const f32x4*)(AFF + F.tid * 32 + q * 4); u[4 * q] = __float_as_uint(a[0]); u[4 * q + 1] = __float_as_uint(a[1]); u[4 * q + 2] = __float_as_uint(a[2]); u[4 * q + 3] = __float_as_uint(a[3]); }
    unsigned prefix = 0u, mask = 0u; int need = CAP;
    for (int round = 0; round < 4; ++round) { const int shift = 24 - 8 * round;
        if (F.tid < 256) hist[F.tid] = 0u;
        __syncthreads();
#pragma unroll
        for (int i = 0; i < 32; ++i) if ((u[i] & mask) == prefix) __hip_atomic_fetch_add(&hist[(u[i] >> shift) & 255u], 1u, __ATOMIC_RELAXED, __HIP_MEMORY_SCOPE_WORKGROUP);
        __syncthreads();
        if (F.wave == 0) { const int c0 = (int)hist[4 * F.lane], c1 = (int)hist[4 * F.lane + 1], c2 = (int)hist[4 * F.lane + 2], c3 = (int)hist[4 * F.lane + 3]; const int tot = c0 + c1 + c2 + c3;
            int suf = tot;
#pragma unroll
            for (int o = 1; o < 64; o <<= 1) { const int n = shi(suf, F.lane + o); if (F.lane + o < 64) suf += n; }
            int run = suf - tot; const int cs[4] = {c0, c1, c2, c3};
#pragma unroll
            for (int b = 3; b >= 0; --b) { if (run < need && need <= run + cs[b]) { sel[0] = 4 * F.lane + b; sel[1] = need - run; } run += cs[b]; } }
        __syncthreads();
        prefix |= ((unsigned)sel[0]) << shift; mask |= 255u << shift; need = sel[1];
        __syncthreads();
    }
    const unsigned thr = prefix; int ngt = 0, neq = 0;
#pragma unroll
    for (int i = 0; i < 32; ++i) { ngt += (u[i] > thr) ? 1 : 0; neq += (u[i] == thr) ? 1 : 0; }
    const int eqp = block_excl_scan(F, neq, tmp);
    int nsel = ngt + max(0, min(neq, need - eqp));
    const int sp = block_excl_scan(F, nsel, tmp);
    int re = eqp, rs = sp;
#pragma unroll
    for (int i = 0; i < 32; ++i) { const int t = F.tid * 32 + i; bool s = u[i] > thr; if (u[i] == thr) { s = re < need; ++re; }
        int slot = -1; if (s) { slot = rs++; if (slot < CAP) { IDX[slot] = t; GATEV[slot] = __uint_as_float(u[i]); } else slot = -1; }
        SLOT[t] = slot; }
}

__device__ __forceinline__ void phase_gather(const Frame& F, int reps) {
    const bf16_t* XN = wsp<bf16_t>(F, WS_XN); bf16_t* XS = wsp<bf16_t>(F, WS_XS); const int* IDX = wsp<int>(F, WS_IDX);
    int vz = 0; asm volatile("" : "+v"(vz));
    static_assert((NE * CAP) % 4 == 0, "gather rows");
    for (int q_ = F.gw; q_ < (NE * CAP / 4) * reps; q_ += F.nw) { const int r0 = (q_ % (NE * CAP / 4)) * 4; int tq[4];
#pragma unroll
        for (int j = 0; j < 4; ++j) tq[j] = __builtin_amdgcn_readfirstlane(IDX[r0 + j + vz]);
        u32x4 v[4][4];
#pragma unroll
        for (int j = 0; j < 4; ++j) { const u32x4* s = (const u32x4*)(XN + (size_t)tq[j] * DM);
#pragma unroll
            for (int i = 0; i < 4; ++i) v[j][i] = s[i * 64 + F.lane]; }
#pragma unroll
        for (int j = 0; j < 4; ++j) { u32x4* d = (u32x4*)(XS + (size_t)(r0 + j) * DM);
#pragma unroll
            for (int i = 0; i < 4; ++i) d[i * 64 + F.lane] = v[j][i]; } }
}

__device__ __forceinline__ int fresh_zero() { int z; asm volatile("v_mov_b32 %0, 0" : "=v"(z)); return z; }
__device__ __forceinline__ int relaunder(int v, int z) { return __builtin_amdgcn_readfirstlane(v + z); }
__device__ __forceinline__ Frame mkframe(const Frame& F0) {
    Frame F = F0; const int z = fresh_zero();
    { const unsigned long long x = (unsigned long long)F0.P; const unsigned lo = (unsigned)relaunder((int)(unsigned)x, z), hi = (unsigned)relaunder((int)(unsigned)(x >> 32), z);
      F.P = (const __attribute__((address_space(4))) Params*)(((unsigned long long)hi << 32) | lo); }
    F.ws = (unsigned char*)(guc_t*)F.P->ws;
    F.lane = (int)__builtin_amdgcn_mbcnt_hi(~0u, __builtin_amdgcn_mbcnt_lo(~0u, (unsigned)z));
    F.wave = relaunder(F0.wave, z); F.bid = relaunder(F0.bid, z); F.G = relaunder(F0.G, z); F.nw = F.G * NWAVE;
    F.tid = F.wave * 64 + F.lane; F.gw = F.bid * NWAVE + F.wave; return F;
}
constexpr int PPL = 16;
constexpr int NPHASE = 1 + DEPTH * PPL;
#ifndef MK_N_LAUNCHES
#define MK_N_LAUNCHES 1
#endif

__global__ void __launch_bounds__(NTHR, 2) hybrid_fwd(Params P) {
    extern __shared__ __attribute__((aligned(16))) unsigned char lds_raw[];
    Frame F0; F0.lds = (LAS unsigned char*)lds_raw; F0.tid = threadIdx.x; F0.lane = F0.tid & 63; F0.wave = __builtin_amdgcn_readfirstlane(F0.tid >> 6);
    F0.G = gridDim.x; F0.bid = blockIdx.x; F0.gw = F0.bid * NWAVE + F0.wave; F0.nw = F0.G * NWAVE; F0.P = (const __attribute__((address_space(4))) Params*)__builtin_amdgcn_kernarg_segment_ptr(); F0.ws = (unsigned char*)(guc_t*)F0.P->ws;
    volatile LAS unsigned* MISC = (volatile LAS unsigned*)(F0.lds + MISC_OFF);
    if (F0.tid < 32) MISC[F0.tid] = 0u;
    __syncthreads();
    XcdBarrier bar; bar.bar = (unsigned*)(F0.ws + WS_CTL) + CW_BAR; bar.x = 0; bar.st = nullptr;
    bar = xcd_barrier_post((unsigned*)(F0.ws + WS_CTL) + CW_BAR, MISC + 8, F0.wave);
#ifndef DUP_MASK
#define DUP_MASK 0u
#endif
#define DUPK(k) ((DUP_MASK >> (k)) & 1u)
#define REP(k) for (int rep_ = 0; rep_ < ((DUPK(k) && l == 0) ? 2 : 1); ++rep_, ({ if (DUPK(k)) __syncthreads(); }))
#ifndef SMALL_MASK
#define SMALL_MASK 15
#endif
#ifndef PH_MASK
#define PH_MASK 0xFFFFFFFFu
#endif
#define IN(k) true
#define INK(kind, k) (((PH_MASK >> (kind)) & 1u) && IN(k))
#define SEAM(k) do { Frame Fb = mkframe(F0); XcdBarrier bb; bb.bar = (unsigned*)(Fb.ws + WS_CTL) + CW_BAR; bb.x = xb_xcc_id(); bb.st = (volatile LAS unsigned*)(Fb.lds + MISC_OFF) + 8; xcd_barrier(bb, Fb.wave); } while (0)

    if (INK(16, 0)) { Frame F = mkframe(F0); phase_rope_table(F); phase_cvt_nm(F, 0); if (DUPK(16)) { __syncthreads(); phase_cvt_nm(F, 0); } phase_norm(F, 0, gin(F, I_NORM_MIX)); if (DUPK(18)) { __syncthreads(); phase_norm(F, 0, gin(F, I_NORM_MIX)); } }
    SEAM(0);
    for (int l = 0; l < DEPTH; ++l) {
        const int pb = 1 + l * PPL;
        if (INK(0, pb + 0)) { const int greps = (DUPK(0) && l == 0) ? 2 : 1; Frame F = mkframe(F0); EpiWin E{F.ws};
            run_gemm(F, E, wsp<bf16_t>(F, WS_XN), DM, wsp<bf16_t>(F, WS_WIN), DM, DM, T / 256, NWIN / 256, (size_t)256 * DM * 2, 0, 0, (size_t)256 * DM * 2, 0, 0, greps); }
        SEAM(pb + 0);
        if (INK(1, pb + 1)) { const int nreps = (DUPK(1) && l == 0) ? 2 : 1; Frame F = mkframe(F0); phase_prep(F, l, nreps); }
        SEAM(pb + 1);
        if (INK(2, pb + 2)) { const int greps = (DUPK(2) && l == 0) ? 2 : 1; Frame F = mkframe(F0);
            if (SMALL_MASK & 1) { EpiLora1 E{gin(F, I_W0) + (size_t)l * 2 * RW, gin(F, I_A0) + (size_t)l * 2 * RW, gin(F, I_KA) + (size_t)l * RW, F.ws};
              run_gemm(F, E, wsp<bf16_t>(F, WS_AL), 512, wsp<bf16_t>(F, WS_WL1), 256, 256, T / 256, 12, (size_t)256 * 512 * 2, 0, 0, (size_t)256 * 256 * 2, 0, 0, greps); }
            if (SMALL_MASK & 2) { EpiLora2 E{gin(F, I_VB) + (size_t)(l > 0 ? l - 1 : 0) * RW, F.ws};
              run_gemm(F, E, wsp<bf16_t>(F, WS_AL) + 256, 512, wsp<bf16_t>(F, WS_WL2), 256, 256, T / 256, l > 0 ? 6 : 3, (size_t)256 * 512 * 2, 0, 0, (size_t)256 * 256 * 2, 0, 0, greps); }
            if (SMALL_MASK & 4) { EpiLru E{gin(F, I_BA) + (size_t)l * 2 * LW, gin(F, I_BX) + (size_t)l * 2 * LW, gin(F, I_LAM) + (size_t)l * 2 * LW, F.ws};
              run_gemm(F, E, wsp<bf16_t>(F, WS_XC), LW, wsp<bf16_t>(F, WS_WLRU), 256, 256, T / 256, 12, (size_t)256 * LW * 2, (size_t)256 * 2, 0, (size_t)256 * 256 * 2, 2, 0, greps); }
            if (SMALL_MASK & 8) { EpiMlaQ E{F.ws};
              run_gemm(F, E, wsp<bf16_t>(F, WS_AM), 384, wsp<bf16_t>(F, WS_WQ), 384, 384, T / 256, 3, (size_t)256 * 384 * 2, 0, 0, (size_t)256 * 384 * 2, 0, 0, greps); }
        }
        SEAM(pb + 2);
        if (INK(3, pb + 3)) { const int nreps = (DUPK(3) && l == 0) ? 2 : 1; Frame F = mkframe(F0); phase_rwkv_local(F, nreps); phase_lru_local(F, nreps); }
        SEAM(pb + 3);
        if (INK(4, pb + 4)) { Frame F = mkframe(F0); if (DUPK(4) && l == 0) { phase_rwkv_carry(F, true); __syncthreads(); } phase_rwkv_carry(F, false); phase_lru_carry(F, 48); if (F.bid >= 51) phase_cvt_moe(F, l, F.bid - 51, F.G - 51, 1, 0); }
        SEAM(pb + 4);
        if (INK(5, pb + 5)) { const int nreps = (DUPK(5) && l == 0) ? 2 : 1; Frame F = mkframe(F0); phase_attention(F, nreps); }
        SEAM(pb + 5);
        if (INK(6, pb + 6)) { const int nreps = (DUPK(6) && l == 0) ? 2 : 1; Frame F = mkframe(F0); phase_rwkv_outfin(F, l, nreps); phase_lru_out(F, (DUPK(19) && l == 0) ? 2 : nreps); }
        SEAM(pb + 6);
        if (INK(8, pb + 8)) { const int greps = 1; Frame F = mkframe(F0);
            if (DUPK(8) && l == 0) {
            { EpiMerge E{F.ws, 0};
              run_gemm(F, E, wsp<bf16_t>(F, WS_YA), RW, wsp<bf16_t>(F, WS_WOA), RW, RW, T / 256, DM / 256, (size_t)256 * RW * 2, 0, 0, (size_t)256 * RW * 2, 0, 0, greps); }
            { EpiMerge E{F.ws, 1};
              run_gemm(F, E, wsp<bf16_t>(F, WS_YB), LW, wsp<bf16_t>(F, WS_WOB), LW, LW, T / 256, DM / 256, (size_t)256 * LW * 2, 0, 0, (size_t)256 * LW * 2, 0, 0, greps); }
            { EpiMerge E{F.ws, 2};
              run_gemm(F, E, wsp<bf16_t>(F, WS_O), OW, wsp<bf16_t>(F, WS_WOC), OW, OW, T / 256, DM / 256, (size_t)256 * OW * 2, 0, 0, (size_t)256 * OW * 2, 0, 0, greps); }
            }
            { EpiMerge E{F.ws, 0};
              run_gemm(F, E, wsp<bf16_t>(F, WS_YA), RW, wsp<bf16_t>(F, WS_WOA), RW, RW, T / 256, DM / 256, (size_t)256 * RW * 2, 0, 0, (size_t)256 * RW * 2, 0, 0, greps); }
            { EpiMerge E{F.ws, 1};
              run_gemm(F, E, wsp<bf16_t>(F, WS_YB), LW, wsp<bf16_t>(F, WS_WOB), LW, LW, T / 256, DM / 256, (size_t)256 * LW * 2, 0, 0, (size_t)256 * LW * 2, 0, 0, greps); }
            { EpiMerge E{F.ws, 2};
              run_gemm(F, E, wsp<bf16_t>(F, WS_O), OW, wsp<bf16_t>(F, WS_WOC), OW, OW, T / 256, DM / 256, (size_t)256 * OW * 2, 0, 0, (size_t)256 * OW * 2, 0, 0, greps); }
        }
        SEAM(pb + 8);
        if (INK(9, pb + 9)) { const int greps = 1; Frame F = mkframe(F0); if (DUPK(9) && l == 0) { EpiWout E{gout(F), wsp<float>(F, WS_HG)}; run_gemm(F, E, wsp<bf16_t>(F, WS_MERGED), DM, wsp<bf16_t>(F, WS_WOUT), DM, DM, T / 256, DM / 256, (size_t)256 * DM * 2, 0, 0, (size_t)256 * DM * 2, 0, 0, greps); }
            EpiWout E{gout(F), gout(F)};
            run_gemm(F, E, wsp<bf16_t>(F, WS_MERGED), DM, wsp<bf16_t>(F, WS_WOUT), DM, DM, T / 256, DM / 256, (size_t)256 * DM * 2, 0, 0, (size_t)256 * DM * 2, 0, 0, greps); }
        SEAM(pb + 9);
        if (INK(10, pb + 10)) { const int nreps = (DUPK(10) && l == 0) ? 2 : 1; Frame F = mkframe(F0); phase_norm2_router(F, l, nreps); }
        SEAM(pb + 10);
        if (INK(11, pb + 11)) { const int nreps = (DUPK(11) && l == 0) ? 2 : 1; Frame F = mkframe(F0); if (DUPK(17) && l == 0) { phase_topk(F); __syncthreads(); } phase_topk(F); __syncthreads(); if (F.bid >= NE) phase_cvt_moe(F, l, F.bid - NE, F.G - NE, nreps, 1); }
        SEAM(pb + 11);
        if (INK(12, pb + 12)) { const int nreps = (DUPK(12) && l == 0) ? 2 : 1; Frame F = mkframe(F0); phase_gather(F, nreps); }
        SEAM(pb + 12);
        if (INK(13, pb + 13)) { const int greps = (DUPK(13) && l == 0) ? 2 : 1; Frame F = mkframe(F0); EpiMoeUp E{F.ws};
            run_gemm(F, E, wsp<bf16_t>(F, WS_XS), DM, wsp<bf16_t>(F, WS_WGU), DM, DM, NE * 8, 8, (size_t)256 * DM * 2, 0, (size_t)2048 * DM * 2, (size_t)256 * DM * 2, 0, 3, greps); }
        SEAM(pb + 13);
        if (INK(14, pb + 14)) { const int greps = (DUPK(14) && l == 0) ? 2 : 1; Frame F = mkframe(F0); EpiMoeDown E{F.ws};
            run_gemm(F, E, wsp<bf16_t>(F, WS_HDN), FF, wsp<bf16_t>(F, WS_WD), FF, FF, NE * 8, 8, (size_t)256 * FF * 2, 0, (size_t)2048 * FF * 2, (size_t)256 * FF * 2, 0, 3, greps); }
        SEAM(pb + 14);
        if (INK(15, pb + 15)) { Frame F = mkframe(F0);
            if (l + 1 < DEPTH) { phase_cvt_nm(F, l + 1); phase_norm(F, 1, gin(F, I_NORM_MIX) + (size_t)(l + 1) * DM); }
            else phase_norm(F, 2, gin(F, I_NFIN));
        }
        if (l + 1 < DEPTH) SEAM(pb + 15);
    }
#undef IN
#undef SEAM
}

extern "C" void kernel_launch(void* const* d_in, const int* in_sizes, int n_in, void* d_out, int out_size, void* d_ws, size_t ws_size, hipStream_t stream) {
    static int grid = 0;
    if (grid == 0) {
        int dev = 0, cus = 0, per_cu = 0;
        if (hipGetDevice(&dev) != hipSuccess || hipDeviceGetAttribute(&cus, hipDeviceAttributeMultiprocessorCount, dev) != hipSuccess) { fprintf(stderr, "kernel_launch: device query failed\n"); grid = -1; return; }
        if (hipFuncSetAttribute((const void*)hybrid_fwd, hipFuncAttributeMaxDynamicSharedMemorySize, LDS_BYTES) != hipSuccess) { fprintf(stderr, "kernel_launch: hipFuncSetAttribute failed\n"); grid = -1; return; }
        if (hipOccupancyMaxActiveBlocksPerMultiprocessor(&per_cu, (const void*)hybrid_fwd, NTHR, LDS_BYTES) != hipSuccess || per_cu < 1) fprintf(stderr, "kernel_launch: occupancy query reports %d\n", per_cu);
        (void)hipGetLastError();
        grid = cus;
        if (n_in != 40 || ws_size < WS_NEED) fprintf(stderr, "kernel_launch: unexpected n_in %d / ws_size %zu (need %zu)\n", n_in, ws_size, (size_t)WS_NEED);
    }
    if (grid < 0) return;
    (void)hipMemsetAsync(d_ws, 0, 65536, stream);
    Params p{};
    for (int i = 0; i < 40; ++i) p.in[i] = (const float*)d_in[i];
    p.out = (float*)d_out; p.ws = (unsigned char*)d_ws;
#if MK_N_LAUNCHES == 1
    p.ph_lo = 0; p.ph_hi = NPHASE;
    hipLaunchKernelGGL(hybrid_fwd, dim3(grid), dim3(NTHR), LDS_BYTES, stream, p);
#else
    for (int k = 0; k < NPHASE; ++k) { p.ph_lo = k; p.ph_hi = k + 1; hipLaunchKernelGGL(hybrid_fwd, dim3(grid), dim3(NTHR), LDS_BYTES, stream, p); }
#endif
    const hipError_t le = hipPeekAtLastError();
    if (le != hipSuccess) fprintf(stderr, "kernel_launch: launch failed: %s\n", hipGetErrorName(le));
}
```
